# Optimizing an MI355X kernel written in HIP

```python
import jax, jax.numpy as jnp
from jax import lax
import numpy as np

D_MODEL = 2048
BATCH = 4
SEQ = 4096
DEPTH = 2

GRID_W = 64
CTX_LEN = 256
N_MIXERS = 2
MLSTM_HEADS = 8
MLSTM_DV = D_MODEL // MLSTM_HEADS
MLSTM_DK = MLSTM_DV // 2
MLSTM_CHUNK = 64
MLSTM_STATE_COLS = 2 * MLSTM_HEADS * MLSTM_DK + MLSTM_HEADS * MLSTM_DV + 4 * MLSTM_HEADS
MLSTM_IN_COLS = MLSTM_STATE_COLS + MLSTM_HEADS * MLSTM_DV
CONV_WIDTH = 3
D_FF = (((8 * D_MODEL) // 3 + 127) // 128) * 128
N_MOD = 9
RMS_EPS = 1e-6
M_INIT = -1e30

kernel_name = "hybrid_mlstm_shortconv_macaron_dit"


def _rmsnorm(x, g):
    xf = x.astype(jnp.float32)
    y = xf * lax.rsqrt(jnp.mean(xf * xf, axis=-1, keepdims=True) + RMS_EPS)
    return (y * g.astype(jnp.float32)).astype(x.dtype)


def _modulate(x, g, shift, scale):
    return _rmsnorm(x, g) * (1.0 + scale) + shift


def _mod_parts(mod, j):
    return mod[..., 3 * j, :], mod[..., 3 * j + 1, :], mod[..., 3 * j + 2, :]


def _swiglu(h, w_in, w_out):
    g, u = jnp.split(h @ w_in, 2, axis=-1)
    return (jax.nn.silu(g) * u) @ w_out


def _mlstm_split(proj, b_gate):
    B, T, cols = proj.shape
    H, DK, DV = MLSTM_HEADS, MLSTM_DK, MLSTM_DV
    heads = lambda a, d: a.reshape(B, T, H, d).transpose(0, 2, 1, 3)
    o0, o1, o2, o3 = H * DK, 2 * H * DK, 2 * H * DK + H * DV, MLSTM_STATE_COLS
    q = heads(proj[..., :o0], DK) * (DK ** -0.5)
    k = heads(proj[..., o0:o1], DK)
    v = heads(proj[..., o1:o2], DV)
    gates = (proj[..., o2:o3] + b_gate.astype(jnp.float32)).reshape(B, T, 4, H).transpose(2, 0, 3, 1)
    o = proj[..., o3:] if cols == MLSTM_IN_COLS else None
    return q, k, v, gates, o


def _mlstm_scan(q, k, v, log_i, log_f, state0, return_h):
    B, H, T, DK = q.shape
    DV = v.shape[-1]
    L = MLSTM_CHUNK
    nc = T // L

    def chunks(a):
        return jnp.moveaxis(a.reshape(a.shape[:2] + (nc, L) + a.shape[3:]), 2, 0)

    xs = (chunks(q), chunks(k), chunks(v), chunks(log_i), chunks(log_f))
    causal = jnp.tril(jnp.ones((L, L), dtype=bool))

    def step(carry, xc):
        C, n, m = carry
        qc, kc, vc, ic, fc = xc
        b = jnp.cumsum(fc, axis=-1)
        b_end = b[..., -1]
        w_end = b_end[..., None] - b + ic
        m_new = jnp.maximum(b_end + m, jnp.max(w_end, axis=-1))
        carry_decay = jnp.exp(b_end + m - m_new)
        w = jnp.exp(w_end - m_new[..., None])[..., None]
        C_new = carry_decay[..., None, None] * C + jnp.einsum('bhld,bhle->bhde', kc * w, vc)
        n_new = carry_decay[..., None] * n + jnp.sum(kc * w, axis=2)
        if not return_h:
            return (C_new, n_new, m_new), None
        d_log = jnp.where(causal, b[..., :, None] - b[..., None, :] + ic[..., None, :], -jnp.inf)
        inter = b + m[..., None]
        m_out = jnp.maximum(inter, jnp.max(d_log, axis=-1))
        s = jnp.einsum('bhsd,bhjd->bhsj', qc, kc) * jnp.exp(d_log - m_out[..., None])
        w_inter = jnp.exp(inter - m_out)[..., None]
        num = jnp.einsum('bhsj,bhje->bhse', s, vc) + w_inter * jnp.einsum('bhsd,bhde->bhse', qc, C)
        den = jnp.sum(s, axis=-1, keepdims=True) + w_inter * jnp.einsum('bhsd,bhd->bhs', qc, n)[..., None]
        h = num / jnp.maximum(jnp.abs(den), jnp.exp(-m_out)[..., None])
        return (C_new, n_new, m_new), h

    state, hs = lax.scan(step, state0, xs)
    if not return_h:
        return None, state
    return jnp.moveaxis(hs, 0, 2).reshape(B, H, T, DV), state


def _mlstm_bidir(q, k, v, gates, state_f0, state_b0, return_h):
    i_f, f_f = gates[0], jax.nn.log_sigmoid(gates[1])
    i_b, f_b = gates[2], jax.nn.log_sigmoid(gates[3])
    flip = lambda a: jnp.flip(a, axis=2)
    h_f, st_f = _mlstm_scan(q, k, v, i_f, f_f, state_f0, return_h)
    h_b, st_b = _mlstm_scan(flip(q), flip(k), flip(v), flip(i_b), flip(f_b), state_b0, return_h)
    h = h_f + flip(h_b) if return_h else None
    return h, st_f, st_b


def _mlstm_out(h, o, norm_g, w_out, dtype):
    B, H, T, DV = h.shape
    h = h.transpose(0, 2, 1, 3)
    hn = h * lax.rsqrt(jnp.mean(h * h, axis=-1, keepdims=True) + RMS_EPS)
    hn = hn * norm_g.astype(jnp.float32).reshape(H, DV)
    y = hn * jax.nn.sigmoid(o.reshape(B, T, H, DV))
    return y.reshape(B, T, H * DV).astype(dtype) @ w_out


def _zero_state(batch):
    H, DK, DV = MLSTM_HEADS, MLSTM_DK, MLSTM_DV
    return (jnp.zeros((batch, H, DK, DV), jnp.float32),
            jnp.zeros((batch, H, DK), jnp.float32),
            jnp.full((batch, H), M_INIT, jnp.float32))


def _conv3(z, w):
    pad = [(0, 0)] * (z.ndim - 2) + [(1, 1), (0, 0)]
    zp = jnp.pad(z, pad)
    return w[0] * zp[..., :-2, :] + w[1] * zp[..., 1:-1, :] + w[2] * zp[..., 2:, :]


def _short_conv(h, w_in, w_conv, w_out, on_grid):
    bg, cg, u = jnp.split(h @ w_in, 3, axis=-1)
    z = cg * u
    if on_grid:
        B, T, D = z.shape
        rows = T // GRID_W
        zc = _conv3(z.reshape(B, rows, GRID_W, D), w_conv).reshape(B, T, D)
    else:
        zc = _conv3(z, w_conv)
    return (bg * zc) @ w_out


def setup_inputs(seed: int = 0) -> dict:
    key = jax.random.key(seed)
    ks = jax.random.split(key, 24)
    D, H = D_MODEL, MLSTM_HEADS
    n_a = len(range(0, DEPTH, N_MIXERS))
    n_b = len(range(1, DEPTH, N_MIXERS))
    nrm = lambda k, shape, fan_in: jax.random.normal(k, shape, jnp.float32) * (fan_in ** -0.5)
    i_bias = 0.5 * jax.random.normal(ks[10], (n_a, 2, H), jnp.float32)
    f_bias = jax.random.uniform(ks[11], (n_a, 2, H), jnp.float32, minval=3.0, maxval=6.0)
    b_gate = jnp.stack([i_bias[:, 0], f_bias[:, 0], i_bias[:, 1], f_bias[:, 1]], axis=1).reshape(n_a, 4 * H)
    return {
        "x": jax.random.normal(ks[0], (BATCH, SEQ, D), jnp.float32),
        "c": jax.random.normal(ks[1], (BATCH, D), jnp.float32),
        "ctx": jax.random.normal(ks[2], (BATCH, CTX_LEN, D), jnp.float32),
        "c_ctx": jax.random.normal(ks[3], (D,), jnp.float32),
        "w_mod": nrm(ks[4], (DEPTH, D, N_MOD * D), D),
        "b_mod": 0.02 * jax.random.normal(ks[5], (DEPTH, N_MOD * D), jnp.float32),
        "norm_g": 1.0 + 0.1 * jax.random.normal(ks[6], (DEPTH, 3, D), jnp.float32),
        "ffn_w_in": nrm(ks[7], (DEPTH, 2, D, 2 * D_FF), D),
        "ffn_w_out": nrm(ks[8], (DEPTH, 2, D_FF, D), D_FF),
        "mlstm_w_in": nrm(ks[9], (n_a, D, MLSTM_IN_COLS), D),
        "mlstm_b_gate": b_gate,
        "mlstm_norm_g": 1.0 + 0.1 * jax.random.normal(ks[12], (n_a, H * MLSTM_DV), jnp.float32),
        "mlstm_w_out": nrm(ks[13], (n_a, H * MLSTM_DV, D), H * MLSTM_DV),
        "conv_w_in": nrm(ks[14], (n_b, D, 3 * D), D),
        "conv_w": nrm(ks[15], (n_b, CONV_WIDTH, D), CONV_WIDTH),
        "conv_w_out": nrm(ks[16], (n_b, D, D), D),
        "final_norm_g": 1.0 + 0.1 * jax.random.normal(ks[17], (D,), jnp.float32),
    }


def reference(x, c, ctx, c_ctx, w_mod, b_mod, norm_g, ffn_w_in, ffn_w_out,
              mlstm_w_in, mlstm_b_gate, mlstm_norm_g, mlstm_w_out,
              conv_w_in, conv_w, conv_w_out, final_norm_g):
    batch = x.shape[0]
    for i in range(DEPTH):
        kind = i % N_MIXERS
        slot = i // N_MIXERS
        ctx_after = any(j % N_MIXERS == 0 for j in range(i + 1, DEPTH))
        ctx_here = (kind == 0) or ctx_after
        mod = (jax.nn.silu(c) @ w_mod[i] + b_mod[i]).reshape(batch, 1, N_MOD, D_MODEL)
        if ctx_here:
            mod_c = (jax.nn.silu(c_ctx) @ w_mod[i] + b_mod[i]).reshape(N_MOD, D_MODEL)

        sh, sc, g = _mod_parts(mod, 0)
        x = x + 0.5 * g * _swiglu(_modulate(x, norm_g[i, 0], sh, sc), ffn_w_in[i, 0], ffn_w_out[i, 0])
        if ctx_here:
            sh_c, sc_c, g_c = _mod_parts(mod_c, 0)
            ctx = ctx + 0.5 * g_c * _swiglu(_modulate(ctx, norm_g[i, 0], sh_c, sc_c), ffn_w_in[i, 0], ffn_w_out[i, 0])

        sh, sc, g = _mod_parts(mod, 1)
        hx = _modulate(x, norm_g[i, 1], sh, sc)
        if ctx_here:
            sh_c, sc_c, g_c = _mod_parts(mod_c, 1)
            hc = _modulate(ctx, norm_g[i, 1], sh_c, sc_c)
        if kind == 0:
            w_in = mlstm_w_in[slot]
            c_cols = MLSTM_IN_COLS if ctx_after else MLSTM_STATE_COLS
            q_c, k_c, v_c, gt_c, o_c = _mlstm_split((hc @ w_in[:, :c_cols]).astype(jnp.float32), mlstm_b_gate[slot])
            h_c, st_f, st_b = _mlstm_bidir(q_c, k_c, v_c, gt_c, _zero_state(batch), _zero_state(batch), ctx_after)
            q_x, k_x, v_x, gt_x, o_x = _mlstm_split((hx @ w_in).astype(jnp.float32), mlstm_b_gate[slot])
            h_x, _, _ = _mlstm_bidir(q_x, k_x, v_x, gt_x, st_f, st_b, True)
            x = x + g * _mlstm_out(h_x, o_x, mlstm_norm_g[slot], mlstm_w_out[slot], x.dtype)
            if ctx_after:
                ctx = ctx + g_c * _mlstm_out(h_c, o_c, mlstm_norm_g[slot], mlstm_w_out[slot], ctx.dtype)
        else:
            x = x + g * _short_conv(hx, conv_w_in[slot], conv_w[slot], conv_w_out[slot], True)
            if ctx_after:
                ctx = ctx + g_c * _short_conv(hc, conv_w_in[slot], conv_w[slot], conv_w_out[slot], False)

        sh, sc, g = _mod_parts(mod, 2)
        x = x + 0.5 * g * _swiglu(_modulate(x, norm_g[i, 2], sh, sc), ffn_w_in[i, 1], ffn_w_out[i, 1])
        if ctx_after:
            sh_c, sc_c, g_c = _mod_parts(mod_c, 2)
            ctx = ctx + 0.5 * g_c * _swiglu(_modulate(ctx, norm_g[i, 2], sh_c, sc_c), ffn_w_in[i, 1], ffn_w_out[i, 1])
    return _rmsnorm(x, final_norm_g)
```

```cpp
#include <hip/hip_runtime.h>
#include <cstdio>
#include <cstdint>

#ifndef PROBE_DUP
#define PROBE_DUP -1
#endif
#ifndef TAILS
#define TAILS 0
#endif
#ifndef MK_PER_PHASE
#define MK_PER_PHASE 0
#endif

constexpr int NWAVES = 8;
constexpr int BATCH = 4, SEQ = 4096, D = 2048, CTXL = 256, NH = 8, DKH = 128, DVH = 256, DFF = 5504;
constexpr int MX = BATCH * SEQ, MC = BATCH * CTXL, MT = MX + MC;
constexpr int NFI = 2 * DFF;
constexpr int NML = 6400, NMLSRC = 6176, NCV = 6144;
constexpr int MODW = 9 * D;
constexpr float RMS_EPS = 1e-6f;

constexpr size_t MiB = 1u << 20;
constexpr size_t WS_CTL = 0, CTL_ZERO_BYTES = 2 * MiB;
constexpr size_t WS_MOD = 1 * MiB;
constexpr size_t WS_WFI = 2 * MiB;
constexpr size_t WS_WFO = 174 * MiB;
constexpr size_t WS_WMI = 260 * MiB;
constexpr size_t WS_WMO = 285 * MiB;
constexpr size_t WS_WCI = 293 * MiB;
constexpr size_t WS_WCO = 317 * MiB;
constexpr size_t WS_X = 326 * MiB;
constexpr size_t WS_HB = 462 * MiB;
constexpr size_t WS_ACT = 530 * MiB;
constexpr size_t WS_QKVO = 713 * MiB;
constexpr size_t WS_GATES = 917 * MiB;
constexpr size_t WS_HF = 920 * MiB, WS_HBW = 984 * MiB;
constexpr size_t WS_MODP = WS_HF;
constexpr size_t WS_CTXP = 1048 * MiB;
constexpr int NBCOL = 45568;
constexpr int BOFF_MI = 0, BOFF_F1 = 6400, BOFF_F2 = 17408, BOFF_CI = 28416, BOFF_F3 = 34560;
constexpr size_t WS_BIASP = 1112 * MiB;
constexpr size_t WS_BIAS = 1142 * MiB;
constexpr size_t WS_GS = 1144 * MiB;
constexpr size_t WS_SS = 1145 * MiB;
constexpr size_t WS_RSTD = 1148 * MiB;
constexpr size_t WS_END = 1149 * MiB;
constexpr int CW_BAR = 4096;

namespace pg8 {
#define PG8_LAS __attribute__((address_space(3)))
typedef unsigned short bf16_t;
typedef short bf16x8 __attribute__((ext_vector_type(8)));
typedef float f32x4 __attribute__((ext_vector_type(4)));
typedef unsigned u32x4 __attribute__((ext_vector_type(4)));
constexpr int BM = 256, BK = 64, HALF = 128, HTB = HALF * BK * 2, STAGE_BYTES = 8 * HTB, NXCD = 8, WGM = 8;

__host__ __device__ __forceinline__ int lds_byte(int r, int c) { const int st = (r >> 4) * 2 + (c >> 5), rr = r & 15, cc = c & 31, ob = rr * 64 + cc * 2; return st * 1024 + (ob ^ (((ob >> 9) & 1) << 5)); }
__host__ __device__ __forceinline__ void stage_rc(int b, int& R, int& C) { const int st = b / 1024, sb = b % 1024, swz = sb ^ (((sb >> 9) & 1) << 5); R = (st >> 1) * 16 + swz / 64; C = (st & 1) * 32 + (swz % 64) / 2; }
__host__ __device__ __forceinline__ int perm32(int rho) { const int n = rho >> 4, i = rho & 15; return 8 * (i >> 2) + 4 * n + (i & 3); }

struct Unit { int pm, pn, k0, nt; };
struct Gemm { const bf16_t* A; const bf16_t* Bt; int M, N, K; };

struct StaticOrder {
    int nM, nN, nwg, G, c, ntk;
    __host__ __device__ void init(int M, int N, int G_, int c_, int K_) { nM = M / BM; nN = N / BM; nwg = nM * nN; G = G_; c = c_; ntk = K_ / BK; }
    __host__ __device__ bool next(int i, Unit& u) const {
        const long L = (long)i * G + c; if (L >= nwg) return false;
        int wgid = (int)L; { const int q = nwg / NXCD, r = nwg % NXCD, xcd = wgid % NXCD, off = wgid / NXCD; wgid = (xcd < r ? xcd * (q + 1) : r * (q + 1) + (xcd - r) * q) + off; }
        const int nig = WGM * nN, gid = wgid / nig, fm = gid * WGM, gsz = (nM - fm) < WGM ? (nM - fm) : WGM;
        u.pm = fm + ((wgid % nig) % gsz); u.pn = (wgid % nig) / gsz; u.k0 = 0; u.nt = ntk; return true;
    }
    __device__ __forceinline__ void a_ready(const Unit&) const {}
    __device__ __forceinline__ void done(const Unit&) const {}
};

typedef __bf16 bf16x2_t __attribute__((ext_vector_type(2)));
typedef float f32x2_t __attribute__((ext_vector_type(2)));
struct SplitKOrder {
    int G, c, pm0;
    __device__ __forceinline__ bool next(int i, Unit& u) const { const long L = (long)i * G + c; if (L >= 256) return false; const int w = (int)L, sl = w & 7, tile = w >> 3;
        u.pm = pm0 + (tile >> 3); u.pn = tile & 7; const int p0 = sl < 5 ? 5 * sl : 25 + 6 * (sl - 5), np = sl < 5 ? 5 : 6; u.k0 = p0 * 128; u.nt = np * 2; return true; }
    __device__ __forceinline__ void a_ready(const Unit&) const {}
    __device__ __forceinline__ void done(const Unit&) const {}
};
__device__ __forceinline__ unsigned cvt_pk_bf16(float lo, float hi) { const f32x2_t v = {lo, hi}; const bf16x2_t b = __builtin_convertvector(v, bf16x2_t); return __builtin_bit_cast(unsigned, b); }
__device__ __forceinline__ float silu_f(float x) { return x * __builtin_amdgcn_rcpf(1.0f + __builtin_amdgcn_exp2f(-1.44269504f * x)); }


struct Fold { const unsigned char* ws; int boff;
    __device__ __forceinline__ const float* rstd() const { return (const float*)(ws + WS_RSTD); }
    __device__ __forceinline__ const float* bias(int bidx) const { return (const float*)(ws + WS_BIAS) + (size_t)bidx * NBCOL + boff; } };
template <bool FOLD> struct EpiSwigluT {
    static constexpr bool PERM = true, AFTER_DRAIN = false;
    bf16_t* O; int ldc; Fold F;
    __device__ __forceinline__ void operator()(const f32x4 (&acc)[2][2][4][2], const Unit& u, int wr, int wc, int fr, int fq) const {
        const int row0 = u.pm * BM + wr * 64 + fr, col0 = u.pn * HALF + wc * 32 + 8 * fq;
        f32x4 bg[2], bu[2];
        if (FOLD) { const int bidx = (u.pm * BM >= MX) ? 5 : (u.pm >> 4); const float* bp = F.bias(bidx) + u.pn * BM + wc * 32 + 8 * fq;
            bg[0] = *(const f32x4*)bp; bg[1] = *(const f32x4*)(bp + 4); bu[0] = *(const f32x4*)(bp + HALF); bu[1] = *(const f32x4*)(bp + HALF + 4); }
#pragma unroll
        for (int ai = 0; ai < 2; ++ai)
#pragma unroll
            for (int m = 0; m < 4; ++m) { const int r = row0 + ai * HALF + m * 16; bf16_t* rowp = O + (size_t)r * ldc + col0;
                f32x4 g0 = acc[ai][0][m][0], g1 = acc[ai][0][m][1], u0 = acc[ai][1][m][0], u1 = acc[ai][1][m][1];
                if (FOLD) { const float rs = F.rstd()[r]; g0 = g0 * rs + bg[0]; g1 = g1 * rs + bg[1]; u0 = u0 * rs + bu[0]; u1 = u1 * rs + bu[1]; }
                u32x4 w; w.x = cvt_pk_bf16(silu_f(g0[0]) * u0[0], silu_f(g0[1]) * u0[1]); w.y = cvt_pk_bf16(silu_f(g0[2]) * u0[2], silu_f(g0[3]) * u0[3]);
                w.z = cvt_pk_bf16(silu_f(g1[0]) * u1[0], silu_f(g1[1]) * u1[1]); w.w = cvt_pk_bf16(silu_f(g1[2]) * u1[2], silu_f(g1[3]) * u1[3]);
                *(u32x4*)rowp = w; }
    }
};
template <bool NEXT, bool HALFC> struct EpiResidT {
    static constexpr bool PERM = false, AFTER_DRAIN = false;
    const float* xin_x; const float* xin_c; unsigned char* ws; int gate_off, nsub;
    __device__ __forceinline__ void operator()(const f32x4 (&acc)[2][2][4][2], const Unit& u, int wr, int wc, int fr, int fq) const {
        const bool isc = (u.pm * BM) >= MX; const int bidx = isc ? 4 : (u.pm >> 4); const float coef = HALFC ? 0.5f : 1.0f;
        float* X = (float*)(ws + WS_X); bf16_t* XS = (bf16_t*)(ws + WS_HB); float* SS = (float*)(ws + WS_SS);
        const float* gv = (const float*)(ws + WS_MOD) + gate_off + (size_t)bidx * MODW; const float* gs = (const float*)(ws + WS_GS) + ((size_t)nsub * 5 + bidx) * D;
        const int col0 = u.pn * BM + wc * 32 + 4 * fq; const int row0 = u.pm * BM + wr * 64 + fr;
        f32x4 gg[2][2], gsv[2][2];
#pragma unroll
        for (int bj = 0; bj < 2; ++bj)
#pragma unroll
            for (int n = 0; n < 2; ++n) { gg[bj][n] = *(const f32x4*)(gv + col0 + bj * HALF + n * 16) * coef; if (NEXT) gsv[bj][n] = *(const f32x4*)(gs + col0 + bj * HALF + n * 16); }
#pragma unroll
        for (int ai = 0; ai < 2; ++ai)
#pragma unroll
            for (int m = 0; m < 4; ++m) { const int r = row0 + ai * HALF + m * 16;
                const float* src = (isc ? xin_c + (size_t)(r - MX) * D : xin_x + (size_t)r * D) + col0; float* dst = X + (size_t)r * D + col0; float sq = 0.f;
#pragma unroll
                for (int bj = 0; bj < 2; ++bj)
#pragma unroll
                    for (int n = 0; n < 2; ++n) { const f32x4 bs = *(const f32x4*)(src + bj * HALF + n * 16); const f32x4 xn = bs + acc[ai][bj][m][n] * gg[bj][n]; *(f32x4*)(dst + bj * HALF + n * 16) = xn;
                        if (NEXT) { const f32x4 y = xn * gsv[bj][n]; typedef unsigned u32x2v __attribute__((ext_vector_type(2))); u32x2v w; w.x = cvt_pk_bf16(y[0], y[1]); w.y = cvt_pk_bf16(y[2], y[3]);
                            *(u32x2v*)(XS + (size_t)r * D + col0 + bj * HALF + n * 16) = w; sq += (xn[0] * xn[0] + xn[1] * xn[1]) + (xn[2] * xn[2] + xn[3] * xn[3]); } }
                if (NEXT) { sq += __shfl_xor(sq, 16); sq += __shfl_xor(sq, 32); if (fq == 0) SS[(size_t)r * 32 + u.pn * 4 + wc] = sq; }
                if (m & 1) asm volatile("" ::: "memory"); }
    }
};
struct EpiPartial {
    static constexpr bool PERM = false, AFTER_DRAIN = false;
    float* P; int row0; size_t slice_stride;
    __device__ __forceinline__ void operator()(const f32x4 (&acc)[2][2][4][2], const Unit& u, int wr, int wc, int fr, int fq) const {
        const int sl = u.k0 < 25 * 128 ? u.k0 / (5 * 128) : 5 + (u.k0 - 25 * 128) / (6 * 128);
        float* base = P + (size_t)sl * slice_stride; const int col0 = u.pn * BM + wc * 32 + 4 * fq, r0 = u.pm * BM - row0 + wr * 64 + fr;
#pragma unroll
        for (int ai = 0; ai < 2; ++ai)
#pragma unroll
            for (int m = 0; m < 4; ++m) { float* rowp = base + (size_t)(r0 + ai * HALF + m * 16) * 2048 + col0;
#pragma unroll
                for (int bj = 0; bj < 2; ++bj)
#pragma unroll
                    for (int n = 0; n < 2; ++n) *(f32x4*)(rowp + bj * HALF + n * 16) = acc[ai][bj][m][n]; }
    }
};
template <bool FOLD> struct EpiMlstmInT {
    static constexpr bool PERM = true, AFTER_DRAIN = false;
    bf16_t* O; float* G; const float* bgate; Fold F;
    __device__ __forceinline__ void operator()(const f32x4 (&acc)[2][2][4][2], const Unit& u, int wr, int wc, int fr, int fq) const {
        const int row0 = u.pm * BM + wr * 64 + fr;
        f32x4 bv[2][2];
#pragma unroll
        for (int bj = 0; bj < 2; ++bj)
#pragma unroll
            for (int n = 0; n < 2; ++n) bv[bj][n] = (f32x4){0.f, 0.f, 0.f, 0.f};
        if (FOLD) { const int bidx = (u.pm * BM >= MX) ? 5 : (u.pm >> 4); const float* bp = F.bias(bidx) + u.pn * BM + wc * 32 + 8 * fq;
#pragma unroll
            for (int bj = 0; bj < 2; ++bj)
#pragma unroll
                for (int n = 0; n < 2; ++n) bv[bj][n] = *(const f32x4*)(bp + bj * HALF + 4 * n); }
        if (u.pn < 24) {
            const int col0 = u.pn * BM + wc * 32 + 8 * fq;
#pragma unroll
            for (int ai = 0; ai < 2; ++ai)
#pragma unroll
                for (int m = 0; m < 4; ++m) { const int r = row0 + ai * HALF + m * 16; bf16_t* rowp = O + (size_t)r * 6144 + col0; const float rs = FOLD ? F.rstd()[r] : 1.0f;
#pragma unroll
                    for (int bj = 0; bj < 2; ++bj) { f32x4 v0 = acc[ai][bj][m][0], v1 = acc[ai][bj][m][1]; if (FOLD) { v0 = v0 * rs + bv[bj][0]; v1 = v1 * rs + bv[bj][1]; }
                        u32x4 w; w.x = cvt_pk_bf16(v0[0], v0[1]); w.y = cvt_pk_bf16(v0[2], v0[3]); w.z = cvt_pk_bf16(v1[0], v1[1]); w.w = cvt_pk_bf16(v1[2], v1[3]);
                        *(u32x4*)(rowp + bj * HALF) = w; } }
        } else if (wc == 0) {
            const f32x4 b0 = *(const f32x4*)(bgate + 8 * fq) + bv[0][0], b1 = *(const f32x4*)(bgate + 8 * fq + 4) + bv[0][1];
#pragma unroll
            for (int ai = 0; ai < 2; ++ai)
#pragma unroll
                for (int m = 0; m < 4; ++m) { const int r = row0 + ai * HALF + m * 16; float* rowp = G + (size_t)r * 32 + 8 * fq; const float rs = FOLD ? F.rstd()[r] : 1.0f;
                    *(f32x4*)rowp = acc[ai][0][m][0] * rs + b0; *(f32x4*)(rowp + 4) = acc[ai][0][m][1] * rs + b1; }
        }
    }
};
template <bool FOLD> struct EpiConvInT {
    static constexpr bool PERM = true, AFTER_DRAIN = false;
    bf16_t* BG; bf16_t* Z; Fold F;
    __device__ __forceinline__ void operator()(const f32x4 (&acc)[2][2][4][2], const Unit& u, int wr, int wc, int fr, int fq) const {
        const int row0 = u.pm * BM + wr * 64 + fr;
        f32x4 bv[2][2];
#pragma unroll
        for (int bj = 0; bj < 2; ++bj)
#pragma unroll
            for (int n = 0; n < 2; ++n) bv[bj][n] = (f32x4){0.f, 0.f, 0.f, 0.f};
        if (FOLD) { const int bidx = (u.pm * BM >= MX) ? 5 : (u.pm >> 4); const float* bp = F.bias(bidx) + u.pn * BM + wc * 32 + 8 * fq;
#pragma unroll
            for (int bj = 0; bj < 2; ++bj)
#pragma unroll
                for (int n = 0; n < 2; ++n) bv[bj][n] = *(const f32x4*)(bp + bj * HALF + 4 * n); }
        if (u.pn < 8) {
            const int col0 = u.pn * BM + wc * 32 + 8 * fq;
#pragma unroll
            for (int ai = 0; ai < 2; ++ai)
#pragma unroll
                for (int m = 0; m < 4; ++m) { const int r = row0 + ai * HALF + m * 16; bf16_t* rowp = BG + (size_t)r * 2048 + col0; const float rs = FOLD ? F.rstd()[r] : 1.0f;
#pragma unroll
                    for (int bj = 0; bj < 2; ++bj) { f32x4 v0 = acc[ai][bj][m][0], v1 = acc[ai][bj][m][1]; if (FOLD) { v0 = v0 * rs + bv[bj][0]; v1 = v1 * rs + bv[bj][1]; }
                        u32x4 w; w.x = cvt_pk_bf16(v0[0], v0[1]); w.y = cvt_pk_bf16(v0[2], v0[3]); w.z = cvt_pk_bf16(v1[0], v1[1]); w.w = cvt_pk_bf16(v1[2], v1[3]);
                        *(u32x4*)(rowp + bj * HALF) = w; } }
        } else {
            const int col0 = (u.pn - 8) * HALF + wc * 32 + 8 * fq;
#pragma unroll
            for (int ai = 0; ai < 2; ++ai)
#pragma unroll
                for (int m = 0; m < 4; ++m) { const int r = row0 + ai * HALF + m * 16; bf16_t* rowp = Z + (size_t)r * 2048 + col0; const float rs = FOLD ? F.rstd()[r] : 1.0f;
                    f32x4 c0 = acc[ai][0][m][0], c1 = acc[ai][0][m][1], u0 = acc[ai][1][m][0], u1 = acc[ai][1][m][1];
                    if (FOLD) { c0 = c0 * rs + bv[0][0]; c1 = c1 * rs + bv[0][1]; u0 = u0 * rs + bv[1][0]; u1 = u1 * rs + bv[1][1]; }
                    const f32x4 v0 = c0 * u0, v1 = c1 * u1;
                    u32x4 w; w.x = cvt_pk_bf16(v0[0], v0[1]); w.y = cvt_pk_bf16(v0[2], v0[3]); w.z = cvt_pk_bf16(v1[0], v1[1]); w.w = cvt_pk_bf16(v1[2], v1[3]);
                    *(u32x4*)rowp = w; }
        }
    }
};

template <class Epi, class Sched, bool ALIGN_EPI = false, bool SP2 = false>
__device__ __forceinline__ void gemm_phase(PG8_LAS unsigned char* lds, const Gemm g, const Sched& S, const Epi& E) {
    const int tid = threadIdx.x, wid = __builtin_amdgcn_readfirstlane(tid >> 6), lane = tid & 63, wr = wid >> 2, wc = wid & 3, fr = lane & 15, fq = lane >> 4;
    const int K = g.K;
    unsigned voffA[2], voffB[2];
#pragma unroll
    for (int i = 0; i < 2; ++i) { int R, C; stage_rc(tid * 16 + i * 8192, R, C); const int Rb = Epi::PERM ? ((R & ~31) + perm32(R & 31)) : R;
        voffA[i] = (unsigned)(R * K + C) * 2u; voffB[i] = (unsigned)(Rb * K + C) * 2u; }
    const size_t kstep = (size_t)(BK * 2);
    const size_t hstep = (size_t)HALF * K * 2;
    const size_t tstep = 2 * hstep;
    const unsigned ldsw = (unsigned)wid * 1024u;
    const int aoff = lds_byte(wr * 64 + fr, fq * 8), boff = lds_byte(wc * 32 + fr, fq * 8);
#define PG8_SA(b, h) (((b) * 2 + (h)) * HTB)
#define PG8_SB(b, h) ((4 + (b) * 2 + (h)) * HTB)
#define PG8_STAGE(bufoff, gbase, voff) do { _Pragma("unroll") for (int _i = 0; _i < 2; ++_i) \
        __builtin_amdgcn_global_load_lds((const unsigned*)((const char*)(gbase) + (voff)[_i]), (PG8_LAS unsigned*)(lds + (bufoff) + ldsw + _i * 8192), 16, 0, 0); } while (0)
#define PG8_LDA(dst, b, h) do { _Pragma("unroll") for (int m = 0; m < 4; ++m) _Pragma("unroll") for (int k = 0; k < 2; ++k) dst[m][k] = *(const PG8_LAS bf16x8*)(lds + PG8_SA(b, h) + aoff + m * 2048 + k * 1024); } while (0)
#define PG8_LDB(dst, b, h) do { _Pragma("unroll") for (int n = 0; n < 2; ++n) _Pragma("unroll") for (int k = 0; k < 2; ++k) dst[n][k] = *(const PG8_LAS bf16x8*)(lds + PG8_SB(b, h) + boff + n * 2048 + k * 1024); } while (0)
#define PG8_MMA(ai, bj, At, Bt) do { __builtin_amdgcn_s_setprio(1); _Pragma("unroll") for (int m = 0; m < 4; ++m) _Pragma("unroll") for (int n = 0; n < 2; ++n) _Pragma("unroll") for (int k = 0; k < 2; ++k) \
        acc[ai][bj][m][n] = __builtin_amdgcn_mfma_f32_16x16x32_bf16(Bt[n][k], At[m][k], acc[ai][bj][m][n], 0, 0, 0); __builtin_amdgcn_s_setprio(0); } while (0)
#define PG8_WAIT_V(n) asm volatile("s_waitcnt vmcnt(" #n ")" ::: "memory")
#define PG8_WAIT_L(n) asm volatile("s_waitcnt lgkmcnt(" #n ")" ::: "memory")
#define PG8_BAR __builtin_amdgcn_s_barrier()
#define PG8_SCHED __builtin_amdgcn_sched_barrier(0)
    Unit cur, nxt; int ui = 0;
    if (!S.next(0, cur)) return;
    f32x4 acc[2][2][4][2];
#pragma unroll
    for (int a = 0; a < 2; ++a)
#pragma unroll
        for (int b = 0; b < 2; ++b)
#pragma unroll
            for (int m = 0; m < 4; ++m)
#pragma unroll
                for (int n = 0; n < 2; ++n) acc[a][b][m][n] = (f32x4){0.f, 0.f, 0.f, 0.f};
    bf16x8 At[4][2], B0[2][2], B1[2][2];
    const char* cA = (const char*)g.A + (size_t)cur.pm * tstep + (size_t)cur.k0 * 2; const char* cB = (const char*)g.Bt + (size_t)cur.pn * tstep + (size_t)cur.k0 * 2;
    S.a_ready(cur);
    if constexpr (SP2) {
        PG8_STAGE(PG8_SB(0, 0), cB, voffB); PG8_STAGE(PG8_SB(0, 1), cB + hstep, voffB); PG8_STAGE(PG8_SA(0, 0), cA, voffA); PG8_STAGE(PG8_SA(0, 1), cA + hstep, voffA);
        if (wr == 1) PG8_BAR;
        PG8_WAIT_V(2); PG8_BAR;
        PG8_STAGE(PG8_SB(1, 0), cB + kstep, voffB); PG8_STAGE(PG8_SA(1, 0), cA + kstep, voffA); PG8_STAGE(PG8_SB(1, 1), cB + hstep + kstep, voffB);
        PG8_WAIT_V(6); PG8_BAR;
    } else {
        PG8_STAGE(PG8_SB(0, 0), cB, voffB); PG8_STAGE(PG8_SA(0, 0), cA, voffA); PG8_STAGE(PG8_SB(0, 1), cB + hstep, voffB); PG8_STAGE(PG8_SA(0, 1), cA + hstep, voffA);
        if (wr == 1) PG8_BAR;
        PG8_WAIT_V(4); PG8_BAR;
        PG8_STAGE(PG8_SB(1, 0), cB + kstep, voffB); PG8_STAGE(PG8_SA(1, 0), cA + kstep, voffA); PG8_STAGE(PG8_SB(1, 1), cB + hstep + kstep, voffB);
        PG8_WAIT_V(6); PG8_BAR;
    }
    for (;;) {
        const bool has_next = S.next(ui + 1, nxt);
        const char* nA = has_next ? (const char*)g.A + (size_t)nxt.pm * tstep + (size_t)nxt.k0 * 2 : cA; const char* nB = has_next ? (const char*)g.Bt + (size_t)nxt.pn * tstep + (size_t)nxt.k0 * 2 : cB;
        const int nt = cur.nt;
        for (int t = 0; t < nt; t += 2) {
            const bool last = (t == nt - 2);
            const char* a1 = cA + (size_t)(t + 1) * kstep;
            const char* a2 = last ? nA : cA + (size_t)(t + 2) * kstep; const char* b2 = last ? nB : cB + (size_t)(t + 2) * kstep;
            const char* a3 = a2 + kstep; const char* b3 = b2 + kstep;
            if (last && has_next) S.a_ready(nxt);
            if constexpr (SP2) {
            PG8_LDB(B0, 0, 0); PG8_LDB(B1, 0, 1); PG8_SCHED; PG8_LDA(At, 0, 0); PG8_STAGE(PG8_SA(1, 1), a1 + hstep, voffA);
            PG8_WAIT_V(8); PG8_WAIT_L(0); PG8_BAR; PG8_MMA(0, 0, At, B0); PG8_MMA(0, 1, At, B1); PG8_BAR; PG8_SCHED;
            PG8_LDA(At, 0, 1); PG8_STAGE(PG8_SB(0, 0), b2, voffB); PG8_STAGE(PG8_SB(0, 1), b2 + hstep, voffB); PG8_STAGE(PG8_SA(0, 0), a2, voffA);
            PG8_WAIT_V(8); PG8_WAIT_L(0); PG8_BAR; PG8_MMA(1, 0, At, B0); PG8_MMA(1, 1, At, B1); PG8_BAR; PG8_SCHED;
            PG8_LDB(B0, 1, 0); PG8_LDB(B1, 1, 1); PG8_SCHED; PG8_LDA(At, 1, 0); PG8_STAGE(PG8_SA(0, 1), a2 + hstep, voffA);
            PG8_WAIT_V(8); PG8_WAIT_L(0); PG8_BAR; PG8_MMA(0, 0, At, B0); PG8_MMA(0, 1, At, B1); PG8_BAR; PG8_SCHED;
            PG8_LDA(At, 1, 1); PG8_STAGE(PG8_SB(1, 0), b3, voffB); PG8_STAGE(PG8_SB(1, 1), b3 + hstep, voffB); PG8_STAGE(PG8_SA(1, 0), a3, voffA);
            PG8_WAIT_V(8); PG8_WAIT_L(0); PG8_BAR; PG8_MMA(1, 0, At, B0); PG8_MMA(1, 1, At, B1); PG8_BAR; PG8_SCHED;
            } else {
            PG8_LDB(B0, 0, 0); PG8_SCHED; PG8_LDA(At, 0, 0); PG8_STAGE(PG8_SA(1, 1), a1 + hstep, voffA);
            PG8_WAIT_L(8); PG8_BAR; PG8_WAIT_L(0); PG8_MMA(0, 0, At, B0); PG8_BAR; PG8_SCHED;
            PG8_LDB(B1, 0, 1); PG8_STAGE(PG8_SB(0, 0), b2, voffB);
            PG8_BAR; PG8_WAIT_L(0); PG8_MMA(0, 1, At, B1); PG8_BAR;
            PG8_LDA(At, 0, 1); PG8_STAGE(PG8_SA(0, 0), a2, voffA);
            PG8_BAR; PG8_WAIT_L(0); PG8_MMA(1, 0, At, B0); PG8_BAR; PG8_SCHED;
            PG8_STAGE(PG8_SB(0, 1), b2 + hstep, voffB);
            PG8_WAIT_V(6); PG8_BAR; PG8_MMA(1, 1, At, B1); PG8_BAR;
            PG8_LDB(B0, 1, 0); PG8_SCHED; PG8_LDA(At, 1, 0); PG8_STAGE(PG8_SA(0, 1), a2 + hstep, voffA);
            PG8_WAIT_L(8); PG8_BAR; PG8_WAIT_L(0); PG8_MMA(0, 0, At, B0); PG8_BAR; PG8_SCHED;
            PG8_LDB(B1, 1, 1); PG8_STAGE(PG8_SB(1, 0), b3, voffB);
            PG8_BAR; PG8_WAIT_L(0); PG8_MMA(0, 1, At, B1); PG8_BAR;
            PG8_LDA(At, 1, 1); PG8_STAGE(PG8_SA(1, 0), a3, voffA);
            PG8_BAR; PG8_WAIT_L(0); PG8_MMA(1, 0, At, B0); PG8_BAR; PG8_SCHED;
            PG8_STAGE(PG8_SB(1, 1), b3 + hstep, voffB);
            PG8_WAIT_V(6); PG8_BAR; PG8_MMA(1, 1, At, B1); PG8_BAR;
            }
        }
        if constexpr (ALIGN_EPI) { if (wr == 0) PG8_BAR; }
        if constexpr (!Epi::AFTER_DRAIN) { E(acc, cur, wr, wc, fr, fq); S.done(cur); }
        if (!has_next) break;
#pragma unroll
        for (int a = 0; a < 2; ++a)
#pragma unroll
            for (int b = 0; b < 2; ++b)
#pragma unroll
                for (int m = 0; m < 4; ++m)
#pragma unroll
                    for (int n = 0; n < 2; ++n) acc[a][b][m][n] = (f32x4){0.f, 0.f, 0.f, 0.f};
        cur = nxt; cA = nA; cB = nB; ++ui;
        if constexpr (ALIGN_EPI) { if (wr == 1) PG8_BAR; }
    }
    PG8_WAIT_V(0);
    if constexpr (!ALIGN_EPI) { if (wr == 0) PG8_BAR; }
    PG8_BAR;
#undef PG8_SA
#undef PG8_SB
#undef PG8_STAGE
#undef PG8_LDA
#undef PG8_LDB
#undef PG8_MMA
#undef PG8_WAIT_V
#undef PG8_WAIT_L
#undef PG8_BAR
#undef PG8_SCHED
}
}

constexpr int RING_BYTES = 131072;
constexpr int SCR_BYTES = 8 * 64 * 65 * 4;
constexpr int LDSCTL_OFF = 151552, LDS_BYTES = 155648;

#define GAS __attribute__((address_space(1)))
#define LAS __attribute__((address_space(3)))
typedef unsigned short bf16;
typedef unsigned v4u __attribute__((ext_vector_type(4)));
typedef unsigned v2u __attribute__((ext_vector_type(2)));
typedef float f32x4 __attribute__((ext_vector_type(4)));
typedef short bf16x8 __attribute__((ext_vector_type(8)));
typedef short s16x4 __attribute__((ext_vector_type(4)));
#define LDS_WAIT() asm volatile("s_waitcnt lgkmcnt(0)" ::: "memory")
__device__ __forceinline__ unsigned f2bf(float f) { unsigned u = __builtin_bit_cast(unsigned, f); return (u + 0x7fffu + ((u >> 16) & 1u)) >> 16; }
__device__ __forceinline__ unsigned pk2(float lo, float hi) { return pg8::cvt_pk_bf16(lo, hi); }
__device__ __forceinline__ float bflo(unsigned w) { return __builtin_bit_cast(float, w << 16); }
__device__ __forceinline__ float bfhi(unsigned w) { return __builtin_bit_cast(float, w & 0xffff0000u); }

#define XB_TMO      128
#define XB_XCNT(j)  (256  + 64 * (j))
#define XB_XSUB(j)  (1280 + 64 * (j))
#define XB_XGEN(j)  (2304 + 64 * (j))
#define XB_TOP      3328
#define XB_TOPGEN   3392
#define XCD_BAR_WORDS 3456
#define XB_SPIN_CAP (1u << 18)
__device__ __forceinline__ unsigned xb_ld(unsigned* p)              { return __hip_atomic_load(p, __ATOMIC_RELAXED, __HIP_MEMORY_SCOPE_AGENT); }
__device__ __forceinline__ unsigned xb_add(unsigned* p, unsigned v) { return __hip_atomic_fetch_add(p, v, __ATOMIC_RELAXED, __HIP_MEMORY_SCOPE_AGENT); }
__device__ __forceinline__ unsigned xb_xcc_id() { return (unsigned)__builtin_amdgcn_s_getreg((3 << 11) | 20) & 0xFu; }
#define XB_SPIN(cond, bar) do { unsigned _sp = 0; while (cond) { __builtin_amdgcn_s_sleep(1); \
    if ((++_sp & 255u) == 0u) { if (xb_ld(&(bar)[XB_TMO])) break; if (_sp > XB_SPIN_CAP) { atomicAdd(&(bar)[XB_TMO], 1u); break; } } } } while (0)
struct XcdBarrier { unsigned* bar; unsigned x; volatile LAS unsigned* st; };
__device__ __forceinline__ XcdBarrier xcd_barrier_post(unsigned* bar, volatile LAS unsigned* st) {
    XcdBarrier b; b.bar = bar; b.x = xb_xcc_id(); b.st = st;
    if (threadIdx.x == 0) (void)xb_add(&bar[XB_XCNT(b.x)], 1u);
    return b;
}
__device__ __forceinline__ void xcd_barrier_complete(unsigned* bar, unsigned x, unsigned& nloc, unsigned& nx) {
    const unsigned G = gridDim.x * gridDim.y * gridDim.z;
    unsigned sum, cnt, mine, sp = 0u;
    for (;;) {
        sum = 0u; cnt = 0u; mine = 0u;
#pragma unroll
        for (unsigned j = 0; j < 16; ++j) { const unsigned c = xb_ld(&bar[XB_XCNT(j)]); sum += c; cnt += (c > 0u) ? 1u : 0u; mine = (j == x) ? c : mine; }
        if (sum == G) break;
        __builtin_amdgcn_s_sleep(1);
        if ((++sp & 255u) == 0u) { if (xb_ld(&bar[XB_TMO])) break; if (sp > XB_SPIN_CAP) { atomicAdd(&bar[XB_TMO], 1u); break; } }
    }
    nloc = mine > 0u ? mine : 1u; nx = cnt > 0u ? cnt : 1u;
}
__device__ __forceinline__ void xcd_barrier(const XcdBarrier& b) {
    asm volatile("s_waitcnt vmcnt(0)" ::: "memory");
    __syncthreads();
    if (threadIdx.x == 0) {
        unsigned* bar = b.bar;
        __builtin_amdgcn_s_waitcnt(0);
        unsigned nloc = b.st[0], nx = b.st[1];
        if (nloc == 0u) { xcd_barrier_complete(bar, b.x, nloc, nx); b.st[0] = nloc; b.st[1] = nx; }
        const unsigned old = xb_add(&bar[XB_XSUB(b.x)], 1u);
        const unsigned gen = old / nloc;
        if (old + 1u == (gen + 1u) * nloc) {
            __builtin_amdgcn_fence(__ATOMIC_RELEASE, "agent");
            asm volatile("s_waitcnt vmcnt(0)" ::: "memory");
            const unsigned og = xb_add(&bar[XB_TOP], 1u);
            const unsigned tg = og / nx;
            if (og + 1u == (tg + 1u) * nx) xb_add(&bar[XB_TOPGEN], 1u);
            else XB_SPIN(xb_ld(&bar[XB_TOPGEN]) == tg, bar);
            __builtin_amdgcn_fence(__ATOMIC_ACQUIRE, "agent");
            xb_add(&bar[XB_XGEN(b.x)], 1u);
            asm volatile("s_waitcnt vmcnt(0)" ::: "memory");
        } else {
            XB_SPIN(xb_ld(&bar[XB_XGEN(b.x)]) == gen, bar);
            __builtin_amdgcn_fence(__ATOMIC_ACQUIRE, "agent");
            asm volatile("s_waitcnt vmcnt(0)" ::: "memory");
        }
    }
    __syncthreads();
}

__device__ __forceinline__ float wave_sum(float v) {
#pragma unroll
    for (int o = 1; o < 64; o <<= 1) v += __shfl_xor(v, o);
    return v;
}
template <int MAPK> __device__ __forceinline__ int wmap(int n) {
    if (MAPK == 1) { const int pn = n >> 8, r = n & 255; return ((r < 128) ? 0 : DFF) + 128 * pn + (r & 127); }
    if (MAPK == 2) { return n < 4096 ? n : (n < 6144 ? n + 32 : (n < 6176 ? n - 2048 : -1)); }
    if (MAPK == 3) { if (n < 2048) return n; const int q = n - 2048, pn = q >> 8, r = q & 255; return ((r < 128) ? 2048 : 4096) + 128 * pn + (r & 127); }
    return n;
}
template <int MAPK, bool BIAS = false> __device__ __forceinline__ void transpose_item(const float* W, int K, int Nsrc, bf16* WT, int nblk, LAS float* scr, int item, int lane, const float* shift = nullptr, float* biasp = nullptr) {
    const int kb = item / nblk, nb = item - kb * nblk, k0 = 64 * kb, n0 = 64 * nb;
    const int n = n0 + lane, sc = wmap<MAPK>(n);
    const float scale = (MAPK == 2 && n < 1024) ? 0.08838834764831845f : 1.0f;
    const float* src = W + (size_t)k0 * Nsrc + (sc >= 0 ? sc : 0);
#pragma unroll
    for (int hb = 0; hb < 2; ++hb) { float v[32];
#pragma unroll
        for (int i = 0; i < 32; ++i) v[i] = src[(size_t)(32 * hb + i) * Nsrc];
#pragma unroll
        for (int i = 0; i < 32; ++i) scr[(32 * hb + i) * 65 + lane] = (sc >= 0) ? v[i] * scale : 0.f; }
    LDS_WAIT(); asm volatile("" ::: "memory");
    if (BIAS) { float sv[5], ba[5];
#pragma unroll
        for (int b = 0; b < 5; ++b) { sv[b] = shift[(size_t)b * MODW + k0 + lane]; ba[b] = 0.f; }
#pragma unroll 16
        for (int k = 0; k < 64; ++k) { const float w = scr[k * 65 + lane];
#pragma unroll
            for (int b = 0; b < 5; ++b) ba[b] += w * __builtin_bit_cast(float, __builtin_amdgcn_readlane(__builtin_bit_cast(int, sv[b]), k)); }
#pragma unroll
        for (int b = 0; b < 5; ++b) biasp[((size_t)kb * 5 + b) * NBCOL + n0 + lane] = ba[b]; }
    const int c = lane & 7;
#pragma unroll
    for (int j = 0; j < 8; ++j) { const int nn = (lane >> 3) + 8 * j; const LAS float* s = scr + (8 * c) * 65 + nn;
        v4u o; o.x = pk2(s[0 * 65], s[1 * 65]); o.y = pk2(s[2 * 65], s[3 * 65]); o.z = pk2(s[4 * 65], s[5 * 65]); o.w = pk2(s[6 * 65], s[7 * 65]);
        *(GAS v4u*)(WT + (size_t)(n0 + nn) * K + k0 + 8 * c) = o; }
    LDS_WAIT(); asm volatile("" ::: "memory");
}

struct KArgs { const float* in[17]; float* out; unsigned char* ws; int ph_lo, ph_hi; };

__device__ __forceinline__ void normmod_phase(const float* xx, const float* xc, int rows, const float* ng, const float* modl, int j, bf16* HB, int gw, int NGW, int lane, const float* ctxP = nullptr, const float* cgate = nullptr, int first_row = 0) {
    for (int r = first_row + gw; r < rows; r += NGW) {
        const bool isc = r >= MX; const int b = isc ? 4 : (r >> 12);
        const float* src = isc ? xc + (size_t)(r - MX) * D : xx + (size_t)r * D;
        const float* shift = modl + (size_t)b * MODW + (3 * j) * D; const float* scale = shift + D;
        f32x4 v[8]; float ss = 0.f;
#pragma unroll
        for (int q = 0; q < 8; ++q) { v[q] = *(const f32x4*)(src + 4 * (lane + 64 * q));
            if (ctxP && isc) { const int c = 4 * (lane + 64 * q); f32x4 p = *(const f32x4*)(ctxP + (size_t)(r - MX) * D + c);
#pragma unroll
                for (int sl = 1; sl < 8; ++sl) p += *(const f32x4*)(ctxP + ((size_t)sl * MC + (r - MX)) * D + c);
                v[q] += p * (*(const f32x4*)(cgate + c)) * 0.5f; }
            ss += (v[q][0] * v[q][0] + v[q][1] * v[q][1]) + (v[q][2] * v[q][2] + v[q][3] * v[q][3]); }
        const float rstd = 1.0f / sqrtf(wave_sum(ss) * (1.0f / D) + RMS_EPS);
        bf16* orow = HB + (size_t)r * D;
#pragma unroll
        for (int q = 0; q < 8; ++q) { const int c = 4 * (lane + 64 * q);
            const f32x4 g4 = *(const f32x4*)(ng + c), s4 = *(const f32x4*)(scale + c), h4 = *(const f32x4*)(shift + c);
            const f32x4 y = v[q] * rstd * g4 * (s4 + 1.0f) + h4;
            v2u o; o.x = pk2(y[0], y[1]); o.y = pk2(y[2], y[3]); *(v2u*)(orow + c) = o; }
    }
}
__device__ __forceinline__ void final_norm_phase(const float* X, const float* ng, float* out, int gw, int NGW, int lane) {
    for (int r = gw; r < MX; r += NGW) {
        const float* src = X + (size_t)r * D; f32x4 v[8]; float ss = 0.f;
#pragma unroll
        for (int q = 0; q < 8; ++q) { v[q] = *(const f32x4*)(src + 4 * (lane + 64 * q)); ss += (v[q][0] * v[q][0] + v[q][1] * v[q][1]) + (v[q][2] * v[q][2] + v[q][3] * v[q][3]); }
        const float rstd = 1.0f / sqrtf(wave_sum(ss) * (1.0f / D) + RMS_EPS);
        float* orow = out + (size_t)r * D;
#pragma unroll
        for (int q = 0; q < 8; ++q) { const int c = 4 * (lane + 64 * q); const f32x4 g4 = *(const f32x4*)(ng + c); *(f32x4*)(orow + c) = v[q] * rstd * g4; }
    }
}
__device__ __forceinline__ void unpack8(const v4u w, float (&f)[8]) { f[0] = bflo(w.x); f[1] = bfhi(w.x); f[2] = bflo(w.y); f[3] = bfhi(w.y); f[4] = bflo(w.z); f[5] = bfhi(w.z); f[6] = bflo(w.w); f[7] = bfhi(w.w); }
__device__ __forceinline__ void headnorm_phase(const bf16* HF, const bf16* HBW, const bf16* QKVO, const float* ng, bf16* Y, int gw, int NGW, int lane) {
    for (int r = gw; r < MX; r += NGW) {
#pragma unroll
        for (int q = 0; q < 4; ++q) { const int c = 8 * (lane + 64 * q);
            const v4u a = *(const v4u*)(HF + (size_t)r * D + c), b = *(const v4u*)(HBW + (size_t)r * D + c), o = *(const v4u*)(QKVO + (size_t)r * 6144 + 4096 + c);
            float fa[8], fb[8], fo[8]; unpack8(a, fa); unpack8(b, fb); unpack8(o, fo);
            float s[8], ss = 0.f;
#pragma unroll
            for (int i = 0; i < 8; ++i) { s[i] = fa[i] + fb[i]; ss += s[i] * s[i]; }
#pragma unroll
            for (int of = 1; of < 32; of <<= 1) ss += __shfl_xor(ss, of);
            const float rstd = 1.0f / sqrtf(ss * (1.0f / DVH) + RMS_EPS);
            const f32x4 g0 = *(const f32x4*)(ng + c), g1 = *(const f32x4*)(ng + c + 4);
            float y[8];
#pragma unroll
            for (int i = 0; i < 8; ++i) { const float g = i < 4 ? g0[i] : g1[i - 4]; y[i] = s[i] * rstd * g * __builtin_amdgcn_rcpf(1.0f + __builtin_amdgcn_exp2f(-1.44269504f * fo[i])); }
            v4u w; w.x = pk2(y[0], y[1]); w.y = pk2(y[2], y[3]); w.z = pk2(y[4], y[5]); w.w = pk2(y[6], y[7]);
            *(v4u*)(Y + (size_t)r * D + c) = w; }
    }
}
__device__ __forceinline__ void convmix_phase(const bf16* BG, const bf16* Z, const float* cw, bf16* Y, int gw, int NGW, int lane) {
    for (int r = gw; r < MX; r += NGW) { const int t = r & 63;
#pragma unroll
        for (int q = 0; q < 4; ++q) { const int c = 8 * (lane + 64 * q);
            const v4u zero = (v4u){0u, 0u, 0u, 0u};
            const v4u zc = *(const v4u*)(Z + (size_t)r * D + c), zp = t > 0 ? *(const v4u*)(Z + (size_t)(r - 1) * D + c) : zero, zn = t < 63 ? *(const v4u*)(Z + (size_t)(r + 1) * D + c) : zero;
            const v4u bg = *(const v4u*)(BG + (size_t)r * D + c);
            float fc[8], fp[8], fn[8], fb[8]; unpack8(zc, fc); unpack8(zp, fp); unpack8(zn, fn); unpack8(bg, fb);
            float y[8];
#pragma unroll
            for (int h = 0; h < 2; ++h) { const f32x4 w0 = *(const f32x4*)(cw + c + 4 * h), w1 = *(const f32x4*)(cw + D + c + 4 * h), w2 = *(const f32x4*)(cw + 2 * D + c + 4 * h);
#pragma unroll
                for (int i = 0; i < 4; ++i) y[4 * h + i] = fb[4 * h + i] * (w0[i] * fp[4 * h + i] + w1[i] * fc[4 * h + i] + w2[i] * fn[4 * h + i]); }
            v4u w; w.x = pk2(y[0], y[1]); w.y = pk2(y[2], y[3]); w.z = pk2(y[4], y[5]); w.w = pk2(y[6], y[7]);
            *(v4u*)(Y + (size_t)r * D + c) = w; }
    }
}

__device__ __forceinline__ void mod_partials(const KArgs& a, int l, int wv, int nwv, int lane) {
    float* modp = (float*)(a.ws + WS_MODP);
    constexpr int NCG = MODW / 256, NKS = D / 64, NIT = NCG * NKS;
    for (int it = wv; it < NIT; it += nwv) {
        const int cg = it / NKS, ks = it - cg * NKS, k0 = 64 * ks, col = 256 * cg + 4 * lane;
        float sv[5];
#pragma unroll
        for (int b = 0; b < 5; ++b) { const float cv = (b < 4) ? a.in[1][b * D + k0 + lane] : a.in[3][k0 + lane]; sv[b] = pg8::silu_f(cv); }
        f32x4 acc[5];
#pragma unroll
        for (int b = 0; b < 5; ++b) acc[b] = (f32x4){0.f, 0.f, 0.f, 0.f};
        const float* wp = a.in[4] + ((size_t)l * D + k0) * MODW + col;
#pragma unroll 8
        for (int k = 0; k < 64; ++k) { const f32x4 w = *(const f32x4*)(wp + (size_t)k * MODW);
#pragma unroll
            for (int b = 0; b < 5; ++b) { const float s = __builtin_bit_cast(float, __builtin_amdgcn_readlane(__builtin_bit_cast(int, sv[b]), k)); acc[b] += w * s; } }
#pragma unroll
        for (int b = 0; b < 5; ++b) *(f32x4*)(modp + (((size_t)ks * 2 + l) * 5 + b) * MODW + col) = acc[b];
    }
}
template <int LIST> __device__ __forceinline__ void convert_list(const KArgs& a, LAS unsigned char* lds, int wv, int nwv, int wave, int lane) {
    unsigned char* ws = a.ws;
    LAS float* scr = (LAS float*)(lds + wave * (64 * 65 * 4));
    const float* mod = (const float*)(ws + WS_MOD); float* bp = (float*)(ws + WS_BIASP);
    constexpr int I_FI = (D / 64) * (NFI / 64), I_FO = (DFF / 64) * (D / 64), I_MI = (D / 64) * (NML / 64), I_SQ = (D / 64) * (D / 64), I_CI = (D / 64) * (NCV / 64);
    if (LIST == 0) {
        for (int it = wv; it < I_FI + I_FO; it += nwv) { int r = it;
            if (r < I_FI) { transpose_item<1>(a.in[7], D, NFI, (bf16*)(ws + WS_WFI), NFI / 64, scr, r, lane); continue; } r -= I_FI;
            transpose_item<0>(a.in[8], DFF, D, (bf16*)(ws + WS_WFO), D / 64, scr, r, lane); }
    } else if (LIST == 1) {
        for (int it = wv; it < I_MI + I_SQ; it += nwv) { int r = it;
            if (r < I_MI) { transpose_item<2, true>(a.in[9], D, NMLSRC, (bf16*)(ws + WS_WMI), NML / 64, scr, r, lane, mod + 3 * D, bp + BOFF_MI); continue; } r -= I_MI;
            transpose_item<0>(a.in[12], D, D, (bf16*)(ws + WS_WMO), D / 64, scr, r, lane); }
    } else {
        for (int it = wv; it < 3 * I_FI + 3 * I_FO + I_CI + I_SQ; it += nwv) { int r = it;
            if (r < 3 * I_FI) { const int mi = 1 + r / I_FI; r -= (mi - 1) * I_FI;
                const float* sh = mi == 1 ? mod + 6 * D : (mi == 2 ? mod + (size_t)5 * MODW : mod + (size_t)5 * MODW + 6 * D); float* bq = bp + (mi == 1 ? BOFF_F1 : (mi == 2 ? BOFF_F2 : BOFF_F3));
                transpose_item<1, true>(a.in[7] + (size_t)mi * D * NFI, D, NFI, (bf16*)(ws + WS_WFI) + (size_t)mi * NFI * D, NFI / 64, scr, r, lane, sh, bq); continue; } r -= 3 * I_FI;
            if (r < 3 * I_FO) { const int mi = 1 + r / I_FO; r -= (mi - 1) * I_FO; transpose_item<0>(a.in[8] + (size_t)mi * DFF * D, DFF, D, (bf16*)(ws + WS_WFO) + (size_t)mi * D * DFF, D / 64, scr, r, lane); continue; } r -= 3 * I_FO;
            if (r < I_CI) { transpose_item<3, true>(a.in[13], D, NCV, (bf16*)(ws + WS_WCI), NCV / 64, scr, r, lane, mod + (size_t)5 * MODW + 3 * D, bp + BOFF_CI); continue; } r -= I_CI;
            transpose_item<0>(a.in[15], D, D, (bf16*)(ws + WS_WCO), D / 64, scr, r, lane); }
    }
}
__device__ __forceinline__ bool tail_rank(int nwg, int G, int bx, int& rank, int& cnt) { const int rem = nwg % G; if (rem == 0) { rank = bx; cnt = G; return true; } rank = bx - rem; cnt = G - rem; return bx >= rem; }

__device__ __forceinline__ void modreduce_phase(const float* modp, const float* bmod, const float* normg, float* mod, float* gs, int l, int gtid, int NGT) {
    constexpr int NV = 5 * MODW / 4;
    for (int i = gtid; i < NV; i += NGT) { const int b = i / (MODW / 4), c4 = i - b * (MODW / 4), lb = l * 5 + b;
        f32x4 s = *(const f32x4*)(bmod + (size_t)l * MODW + 4 * c4);
        for (int ks = 0; ks < D / 64; ++ks) s += *(const f32x4*)(modp + ((size_t)ks * 10 + lb) * MODW + 4 * c4);
        *(f32x4*)(mod + (size_t)lb * MODW + 4 * c4) = s;
        const int seg = (4 * c4) / D, col = 4 * c4 - seg * D;
        if (seg % 3 == 1) { const int j = seg / 3; *(f32x4*)(gs + ((size_t)(l * 3 + j) * 5 + b) * D + col) = *(const f32x4*)(normg + (size_t)(l * 3 + j) * D + col) * (s + 1.0f); } }
}
__device__ __forceinline__ void rowstat_phase(const float* SS, float* rstd, bool ctx_ones, int gtid, int NGT) {
    for (int r = gtid; r < MX; r += NGT) { float t = 0.f;
#pragma unroll
        for (int q = 0; q < 8; ++q) { const f32x4 v = *(const f32x4*)(SS + (size_t)r * 32 + 4 * q); t += (v[0] + v[1]) + (v[2] + v[3]); }
        rstd[r] = 1.0f / sqrtf(t * (1.0f / D) + RMS_EPS); }
    if (ctx_ones) for (int r = MX + gtid; r < MT; r += NGT) rstd[r] = 1.0f;
}
__device__ __forceinline__ void biasreduce_phase(const float* biasp, float* bias, int gtid, int NGT) {
    constexpr int NV = NBCOL / 4;
    for (int i = gtid; i < 6 * NV; i += NGT) { const int b = i / NV, c4 = i - b * NV; f32x4 s = (f32x4){0.f, 0.f, 0.f, 0.f};
        if (b < 5) for (int kb = 0; kb < D / 64; ++kb) s += *(const f32x4*)(biasp + ((size_t)kb * 5 + b) * NBCOL + 4 * c4);
        *(f32x4*)(bias + (size_t)b * NBCOL + 4 * c4) = s; }
}

constexpr int SQ_OFF = 0, SK_OFF = 17408, SKW_OFF = 34816, SV_OFF = 52224, SCB_OFF = 63488, SP_OFF = 85248, STAB_OFF = 94464, SCH_OFF = 146688;
constexpr int QSTR = 272, VSTR = 176, PSTR = 144, CBSZ = 21760, NTOK = 68 * 64;
static_assert(SCH_OFF + 4 * 68 * 4 <= LDSCTL_OFF, "scan LDS");

#define SCAN_BAR() do { asm volatile("s_waitcnt lgkmcnt(0)" ::: "memory"); __builtin_amdgcn_s_barrier(); asm volatile("" ::: "memory"); } while (0)
__device__ __forceinline__ bf16x8 tr_frag(LAS unsigned char* p0, LAS unsigned char* p1) {
    const s16x4 a = __builtin_amdgcn_ds_read_tr16_b64_v4i16((LAS s16x4*)p0), b = __builtin_amdgcn_ds_read_tr16_b64_v4i16((LAS s16x4*)p1);
    return (bf16x8){a[0], a[1], a[2], a[3], b[0], b[1], b[2], b[3]};
}
__device__ __forceinline__ float fexp(float x) { return __builtin_amdgcn_exp2f(1.44269504f * x); }

template <int PROBE> __device__ __forceinline__ void scan_phase(LAS unsigned char* lds, const bf16* QKVO, const float* GATES, bf16* HF, bf16* HBW, int vcu, int G, int tid, int lane, int wave) {
    const int fr = lane & 15, fq = lane >> 4, tq = (lane & 15) >> 2, tp = lane & 3;
    LAS float* cjA = (LAS float*)(lds + STAB_OFF); LAS float* cmA = cjA + NTOK; LAS float* bsA = cmA + NTOK;
    LAS float* chM = (LAS float*)(lds + SCH_OFF); LAS float* chML = chM + 68; LAS float* chBE = chML + 68; LAS float* chMC = chBE + 68;
    for (int u = vcu; u < 256; u += G) {
        const int sl = u & 3, dir = (u >> 2) & 1, h = (u >> 3) & 7, b = u >> 6, e0 = 64 * sl;
        bf16* HO = dir ? HBW : HF;
        const int prow = tid >> 4, pch = tid & 15, vrow = tid >> 3, vch = tid & 7;
        auto row_of = [&](int st) { const bool isc = st < 4; const int ci = isc ? st : st - 4, n = isc ? 4 : 64, ch = dir ? (n - 1 - ci) : ci; return (isc ? MX + b * CTXL : b * SEQ) + ch * 64; };
        f32x4 Cacc[5];
#pragma unroll
        for (int e = 0; e < 5; ++e) Cacc[e] = (f32x4){0.f, 0.f, 0.f, 0.f};
        SCAN_BAR();
        {
            float gi[9], gf[9];
#pragma unroll
            for (int q = 0; q < 9; ++q) { const int st = wave + NWAVES * q; if (st < 68) { const float* gp = GATES + (size_t)(row_of(st) + lane) * 32 + (2 * dir) * 8 + h; gi[q] = gp[0]; gf[q] = gp[8]; } else { gi[q] = 0.f; gf[q] = 0.f; } }
#pragma unroll
            for (int q = 0; q < 9; ++q) { const int st = wave + NWAVES * q; if (st < 68) {
                const float ax = fabsf(gf[q]), ee = fexp(-ax), l1p = (ee < 1e-3f) ? ee * (1.0f - 0.5f * ee) : __logf(1.0f + ee);
                const float f = fminf(gf[q], 0.f) - l1p;
                float bs = f;
#pragma unroll
                for (int o = 1; o < 64; o <<= 1) { const float t = dir ? __shfl_down(bs, o) : __shfl_up(bs, o); const bool ok = dir ? (lane + o < 64) : (lane >= o); bs += ok ? t : 0.f; }
                const float cj = gi[q] - bs; float cm = cj;
#pragma unroll
                for (int o = 1; o < 64; o <<= 1) { const float t = dir ? __shfl_down(cm, o) : __shfl_up(cm, o); const bool ok = dir ? (lane + o < 64) : (lane >= o); cm = ok ? fmaxf(cm, t) : cm; }
                cjA[st * 64 + lane] = cj; cmA[st * 64 + lane] = cm; bsA[st * 64 + lane] = bs;
                if (lane == (dir ? 0 : 63)) { chBE[st] = bs; chMC[st] = cm; } } }
        }
        for (int i = tid; i < CBSZ / 16; i += 512) *(LAS v4u*)(lds + SCB_OFF + 16 * i) = (v4u){0u, 0u, 0u, 0u};
        if (tid < 128) { const int r = tid >> 1; *(LAS v4u*)(lds + SV_OFF + r * VSTR + (8 + (tid & 1)) * 16) = (tid & 1) ? (v4u){0u, 0u, 0u, 0u} : (v4u){0x3F80u, 0u, 0u, 0u}; }
        v4u rq[4][2], rk[4][2], rv[2];
        auto load_qk = [&](int st, v4u (&q)[2], v4u (&k)[2]) { if (st < 68 && (PROBE != 1 || st < 5)) { const int row0 = row_of(st);
#pragma unroll
            for (int i = 0; i < 2; ++i) { const bf16* p = QKVO + (size_t)(row0 + prow + 32 * i) * 6144 + h * DKH + pch * 8; q[i] = *(const v4u*)p; k[i] = *(const v4u*)(p + 1024); } } };
        auto load_v = [&](int st, v4u& v) { if (st < 68 && (PROBE != 1 || st < 2)) v = *(const v4u*)(QKVO + (size_t)(row_of(st) + vrow) * 6144 + 2048 + h * DVH + e0 + vch * 8); };
        { v4u q0[2], k0[2];
          load_qk(0, q0, k0); load_qk(1, rq[1], rk[1]); load_qk(2, rq[2], rk[2]); load_qk(3, rq[3], rk[3]); load_qk(4, rq[0], rk[0]);
          load_v(0, rv[0]); load_v(1, rv[1]);
#pragma unroll
          for (int i = 0; i < 2; ++i) { *(LAS v4u*)(lds + SQ_OFF + (prow + 32 * i) * QSTR + pch * 16) = q0[i]; *(LAS v4u*)(lds + SK_OFF + (prow + 32 * i) * QSTR + pch * 16) = k0[i]; } }
        SCAN_BAR();
        if (tid == 0) { float m = -1e30f; for (int st = 0; st < 68; ++st) { chM[st] = m; const float ML = fmaxf(m, chMC[st]); chML[st] = ML; m = chBE[st] + ML; } }
        SCAN_BAR();
        const int sb = wave & 3, hf = wave >> 2, s_pos = 16 * sb + fr;
        auto step = [&](const int st, const bool isc, v4u (&RQ)[2], v4u (&RK)[2], v4u& RV) {
            const float m_t = chM[st], ML_t = chML[st];
#pragma unroll
            for (int i = 0; i < 2; ++i) { const int r = prow + 32 * i; const float wj = fexp(cjA[st * 64 + r] - ML_t);
                const v4u kraw = *(const LAS v4u*)(lds + SK_OFF + r * QSTR + pch * 16);
                float kf[8]; unpack8(kraw, kf); v4u kw; kw.x = pk2(kf[0] * wj, kf[1] * wj); kw.y = pk2(kf[2] * wj, kf[3] * wj); kw.z = pk2(kf[4] * wj, kf[5] * wj); kw.w = pk2(kf[6] * wj, kf[7] * wj);
                *(LAS v4u*)(lds + SKW_OFF + r * QSTR + pch * 16) = kw; }
            *(LAS v4u*)(lds + SV_OFF + vrow * VSTR + vch * 16) = RV;
            load_v(st + 2, RV);
            f32x4 a2[3]; float Ms = 0.f;
            if (!isc) {
                bf16x8 Yq[4];
#pragma unroll
                for (int ks = 0; ks < 4; ++ks) Yq[ks] = *(const LAS bf16x8*)(lds + SQ_OFF + s_pos * QSTR + (32 * ks + 8 * fq) * 2);
                Ms = fmaxf(m_t, cmA[st * 64 + s_pos]);
#pragma unroll
                for (int jj = 0; jj < 2; ++jj) { const int jb = 2 * hf + jj; f32x4 sacc = (f32x4){0.f, 0.f, 0.f, 0.f};
#pragma unroll
                    for (int ks = 0; ks < 4; ++ks) { const bf16x8 Xk = *(const LAS bf16x8*)(lds + SK_OFF + (16 * jb + fr) * QSTR + (32 * ks + 8 * fq) * 2);
                        sacc = __builtin_amdgcn_mfma_f32_16x16x32_bf16(Xk, Yq[ks], sacc, 0, 0, 0); }
                    const f32x4 c4 = *(const LAS f32x4*)(cjA + st * 64 + 16 * jb + 4 * fq); float p[4];
#pragma unroll
                    for (int r = 0; r < 4; ++r) { const int j_pos = 16 * jb + 4 * fq + r; const bool ok = dir ? (j_pos >= s_pos) : (j_pos <= s_pos); p[r] = sacc[r] * fexp(ok ? (c4[r] - Ms) : -1e30f); }
                    v2u pw; pw.x = pk2(p[0], p[1]); pw.y = pk2(p[2], p[3]);
                    *(LAS v2u*)(lds + SP_OFF + s_pos * PSTR + (16 * jb + 4 * fq) * 2) = pw; }
#pragma unroll
                for (int ti = 0; ti < 3; ++ti) { const int e = (ti == 2) ? 4 : 2 * hf + ti; a2[ti] = (f32x4){0.f, 0.f, 0.f, 0.f};
#pragma unroll
                    for (int ks = 0; ks < 4; ++ks) { const bf16x8 Xc = *(const LAS bf16x8*)(lds + SCB_OFF + (16 * e + fr) * QSTR + (32 * ks + 8 * fq) * 2);
                        a2[ti] = __builtin_amdgcn_mfma_f32_16x16x32_bf16(Xc, Yq[ks], a2[ti], 0, 0, 0); } }
            }
            SCAN_BAR();
            {
                const float decay = fexp(m_t - ML_t);
                bf16x8 Xkw[2], Yp[2];
#pragma unroll
                for (int ks = 0; ks < 2; ++ks) { LAS unsigned char* p = lds + SKW_OFF + (32 * ks + 8 * fq + tq) * QSTR + (16 * wave + 4 * tp) * 2; Xkw[ks] = tr_frag(p, p + 4 * QSTR); }
                if (!isc) {
#pragma unroll
                    for (int ks = 0; ks < 2; ++ks) Yp[ks] = *(const LAS bf16x8*)(lds + SP_OFF + s_pos * PSTR + (32 * ks + 8 * fq) * 2);
                }
                f32x4 o[3];
#pragma unroll
                for (int e = 0; e < 5; ++e) { bf16x8 Yv[2];
#pragma unroll
                    for (int ks = 0; ks < 2; ++ks) { LAS unsigned char* p = lds + SV_OFF + (32 * ks + 8 * fq + tq) * VSTR + (16 * e + 4 * tp) * 2; Yv[ks] = tr_frag(p, p + 4 * VSTR); }
                    if (!isc && (e == 4 || hf == (e >> 1))) { const int ti = (e == 4) ? 2 : (e & 1); f32x4 a1 = (f32x4){0.f, 0.f, 0.f, 0.f};
#pragma unroll
                        for (int ks = 0; ks < 2; ++ks) a1 = __builtin_amdgcn_mfma_f32_16x16x32_bf16(Yv[ks], Yp[ks], a1, 0, 0, 0);
                        o[ti] = a1; }
                    Cacc[e] = Cacc[e] * decay;
#pragma unroll
                    for (int ks = 0; ks < 2; ++ks) Cacc[e] = __builtin_amdgcn_mfma_f32_16x16x32_bf16(Xkw[ks], Yv[ks], Cacc[e], 0, 0, 0);
                    v2u cw; cw.x = pk2(Cacc[e][0], Cacc[e][1]); cw.y = pk2(Cacc[e][2], Cacc[e][3]);
                    *(LAS v2u*)(lds + SCB_OFF + (16 * e + fr) * QSTR + (16 * wave + 4 * fq) * 2) = cw; }
                if (!isc) {
                    const float wint = fexp(m_t - Ms), hden = fexp(-(bsA[st * 64 + s_pos] + Ms));
#pragma unroll
                    for (int ti = 0; ti < 3; ++ti) o[ti] = o[ti] + a2[ti] * wint;
                    const float den = __shfl(o[2][0], fr);
                    const float inv = 1.0f / fmaxf(fabsf(den), hden);
                    const int orow = row_of(st) + s_pos;
#pragma unroll
                    for (int ti = 0; ti < 2; ++ti) { const int e = 2 * hf + ti; const f32x4 hv = o[ti] * inv; v2u w; w.x = pk2(hv[0], hv[1]); w.y = pk2(hv[2], hv[3]);
                        *(v2u*)(HO + (size_t)orow * D + h * DVH + e0 + 16 * e + 4 * fq) = w; }
                }
                if (st + 1 < 68) {
#pragma unroll
                    for (int i = 0; i < 2; ++i) { *(LAS v4u*)(lds + SQ_OFF + (prow + 32 * i) * QSTR + pch * 16) = RQ[i]; *(LAS v4u*)(lds + SK_OFF + (prow + 32 * i) * QSTR + pch * 16) = RK[i]; }
                    load_qk(st + 5, RQ, RK);
                }
            }
            SCAN_BAR();
        };
        for (int g = 0; g < 17; ++g) { const bool isc = (g == 0); const int st = 4 * g;
            step(st, isc, rq[1], rk[1], rv[0]); step(st + 1, isc, rq[2], rk[2], rv[1]); step(st + 2, isc, rq[3], rk[3], rv[0]); step(st + 3, isc, rq[0], rk[0], rv[1]); }
    }
}

constexpr int NPHASES = 24;
__global__ void __launch_bounds__(NWAVES * 64, 2) fwd_kernel(KArgs a) {
    extern __shared__ __attribute__((aligned(16))) unsigned char lds_raw[];
    LAS unsigned char* lds = (LAS unsigned char*)lds_raw;
    const int tid = threadIdx.x, lane = tid & 63, wave = __builtin_amdgcn_readfirstlane(tid >> 6);
    const int G = gridDim.x, bx = blockIdx.x, vcu = (G % 8 == 0) ? (bx % 8) * (G / 8) + bx / 8 : bx;
    const int gw = vcu * NWAVES + wave, NGW = G * NWAVES;
    unsigned char* ws = a.ws;
    unsigned* ctl = (unsigned*)(ws + WS_CTL);
    volatile LAS unsigned* MISC = (volatile LAS unsigned*)(lds + LDSCTL_OFF);
    for (int u = tid; u < (LDS_BYTES - LDSCTL_OFF) / 4; u += NWAVES * 64) ((LAS unsigned*)(lds + LDSCTL_OFF))[u] = 0u;
    __syncthreads();
    XcdBarrier bar; bar.bar = ctl + CW_BAR; bar.x = 0; bar.st = nullptr;
#if !MK_PER_PHASE
    bar = xcd_barrier_post(ctl + CW_BAR, MISC + 8);
#endif
    const int lo = a.ph_lo, hi = a.ph_hi;
#define IN(k) (lo <= (k) && (k) < hi)
#if MK_PER_PHASE
#define SEAM(k) do { } while (0)
#else
#define SEAM(k) do { if (IN(k) && IN((k) + 1)) xcd_barrier(bar); } while (0)
#endif
#define x_in (a.in[0])
#define ctx_in (a.in[2])
#define X ((float*)(ws + WS_X))
#define HB ((bf16*)(ws + WS_HB))
#define ACT ((bf16*)(ws + WS_ACT))
#define QKVO ((bf16*)(ws + WS_QKVO))
#define GATES ((float*)(ws + WS_GATES))
#define HF ((bf16*)(ws + WS_HF))
#define HBW ((bf16*)(ws + WS_HBW))
#define mod ((const float*)(ws + WS_MOD))
#define WFI ((const bf16*)(ws + WS_WFI))
#define WFO ((const bf16*)(ws + WS_WFO))
#define normg (a.in[6])
#define GS ((float*)(ws + WS_GS))
#define SS ((float*)(ws + WS_SS))
#define RSTD ((float*)(ws + WS_RSTD))
#define BIAS ((float*)(ws + WS_BIAS))
#define YB ((bf16*)(ws + WS_ACT))
#define BG ((bf16*)(ws + WS_QKVO))
#define ZB ((bf16*)(ws + WS_QKVO) + (size_t)MX * D)
    const int gtid = bx * NWAVES * 64 + tid, NGT = G * NWAVES * 64;
    if (IN(0)) { mod_partials(a, 0, gw, NGW, lane); mod_partials(a, 1, gw, NGW, lane); convert_list<0>(a, lds, gw, NGW, wave, lane); }
    SEAM(0);
    if (IN(1)) { modreduce_phase((const float*)(ws + WS_MODP), a.in[5], normg, (float*)(ws + WS_MOD), GS, 0, gtid, NGT); modreduce_phase((const float*)(ws + WS_MODP), a.in[5], normg, (float*)(ws + WS_MOD), GS, 1, gtid, NGT); }
    SEAM(1);
#define FFN_UP(p, wi, rows, FOLDV, boff) do { if (IN(p)) { pg8::Gemm g{HB, WFI + (size_t)(wi) * NFI * D, rows, NFI, D}; pg8::StaticOrder S; S.init(rows, NFI, G, bx, D); \
        pg8::EpiSwigluT<FOLDV> E{ACT, DFF, pg8::Fold{ws, (boff)}}; pg8::gemm_phase<pg8::EpiSwigluT<FOLDV>, pg8::StaticOrder, true, true>(lds, g, S, E); } SEAM(p); } while (0)
#define FFN_DOWN(p, wi, l, j, xsx, xsc, NEXTV, nsub) do { if (IN(p)) { pg8::Gemm g{ACT, WFO + (size_t)(wi) * D * DFF, MX, D, DFF}; pg8::StaticOrder S; S.init(MX, D, G, bx, DFF); \
        pg8::EpiResidT<NEXTV, true> E{xsx, xsc, ws, (l) * 5 * MODW + (3 * (j) + 2) * D, (nsub)}; \
        pg8::gemm_phase<pg8::EpiResidT<NEXTV, true>, pg8::StaticOrder, true, true>(lds, g, S, E); } } while (0)

    if (IN(2)) normmod_phase(x_in, ctx_in, MT, normg + (0 * 3 + 0) * D, mod, 0, HB, gw, NGW, lane);
    SEAM(2);
    FFN_UP(3, 0, MT, false, 0);
    if (IN(4)) { FFN_DOWN(4, 0, 0, 0, x_in, ctx_in, true, 1);
        { pg8::Gemm g{ACT, WFO, MT, D, DFF}; pg8::SplitKOrder S{G, bx, MX / 256};
          pg8::EpiPartial E{(float*)(ws + WS_CTXP), MX, (size_t)MC * D};
          pg8::gemm_phase<pg8::EpiPartial, pg8::SplitKOrder, true, true>(lds, g, S, E); } }
    SEAM(4);
    if (IN(4)) { convert_list<1>(a, lds, gw, NGW, wave, lane); convert_list<2>(a, lds, gw, NGW, wave, lane); if (IN(5)) xcd_barrier(bar); }
    if (IN(5)) { rowstat_phase(SS, RSTD, true, gtid, NGT); biasreduce_phase((const float*)(ws + WS_BIASP), BIAS, gtid, NGT);
        normmod_phase(X, ctx_in, MT, normg + (0 * 3 + 1) * D, mod, 1, HB, gw, NGW, lane, (const float*)(ws + WS_CTXP), mod + (size_t)4 * MODW + (3 * 0 + 2) * D, MX); }
    SEAM(5);
    if (IN(6)) { pg8::Gemm g{HB, (const bf16*)(ws + WS_WMI), MT, NML, D}; pg8::StaticOrder S; S.init(MT, NML, G, bx, D); pg8::EpiMlstmInT<true> E{QKVO, GATES, a.in[10], pg8::Fold{ws, BOFF_MI}};
        pg8::gemm_phase<pg8::EpiMlstmInT<true>, pg8::StaticOrder, true, true>(lds, g, S, E); }
    SEAM(6);
    if (IN(7)) scan_phase<0>(lds, QKVO, GATES, HF, HBW, vcu, G, tid, lane, wave);
    SEAM(7);
    if (IN(8)) headnorm_phase(HF, HBW, QKVO, a.in[11], YB, gw, NGW, lane);
    SEAM(8);
    if (IN(9)) { pg8::Gemm g{YB, (const bf16*)(ws + WS_WMO), MX, D, D}; pg8::StaticOrder S; S.init(MX, D, G, bx, D);
        pg8::EpiResidT<true, false> E{X, X, ws, (3 * 1 + 2) * D, 2};
        pg8::gemm_phase<pg8::EpiResidT<true, false>, pg8::StaticOrder, true, true>(lds, g, S, E); }
    SEAM(9);
    if (IN(10)) rowstat_phase(SS, RSTD, false, gtid, NGT);
    SEAM(10);
    FFN_UP(11, 1, MX, true, BOFF_F1);
    FFN_DOWN(12, 1, 0, 2, X, X, true, 3); SEAM(12);
    if (IN(13)) rowstat_phase(SS, RSTD, false, gtid, NGT);
    SEAM(13);
    FFN_UP(14, 2, MX, true, BOFF_F2);
    FFN_DOWN(15, 2, 1, 0, X, X, true, 4); SEAM(15);
    if (IN(16)) rowstat_phase(SS, RSTD, false, gtid, NGT);
    SEAM(16);
    if (IN(17)) { pg8::Gemm g{HB, (const bf16*)(ws + WS_WCI), MX, NCV, D}; pg8::StaticOrder S; S.init(MX, NCV, G, bx, D); pg8::EpiConvInT<true> E{BG, ZB, pg8::Fold{ws, BOFF_CI}};
        pg8::gemm_phase<pg8::EpiConvInT<true>, pg8::StaticOrder, true, true>(lds, g, S, E); }
    SEAM(17);
    if (IN(18)) convmix_phase(BG, ZB, a.in[14], YB, gw, NGW, lane);
    SEAM(18);
    if (IN(19)) { pg8::Gemm g{YB, (const bf16*)(ws + WS_WCO), MX, D, D}; pg8::StaticOrder S; S.init(MX, D, G, bx, D);
        pg8::EpiResidT<true, false> E{X, X, ws, 5 * MODW + (3 * 1 + 2) * D, 5};
        pg8::gemm_phase<pg8::EpiResidT<true, false>, pg8::StaticOrder, true, true>(lds, g, S, E); }
    SEAM(19);
    if (IN(20)) rowstat_phase(SS, RSTD, false, gtid, NGT);
    SEAM(20);
    FFN_UP(21, 3, MX, true, BOFF_F3);
    FFN_DOWN(22, 3, 1, 2, X, X, false, 0); SEAM(22);
    if (IN(23)) final_norm_phase(X, a.in[16], a.out, gw, NGW, lane);
#undef FFN_UP
#undef FFN_DOWN
#undef x_in
#undef ctx_in
#undef X
#undef HB
#undef ACT
#undef QKVO
#undef GATES
#undef HF
#undef HBW
#undef mod
#undef WFI
#undef WFO
#undef normg
#undef GS
#undef SS
#undef RSTD
#undef BIAS
#undef YB
#undef BG
#undef ZB
#undef IN
#undef SEAM
}

extern "C" void kernel_launch(void* const* d_in, const int* in_sizes, int n_in, void* d_out, int out_size, void* d_ws, size_t ws_size, hipStream_t stream) {
    static int grid = 0;
    if (grid == 0) {
        if (n_in != 17 || in_sizes[0] != MX * D || out_size != MX * D || ws_size < WS_END) { fprintf(stderr, "kernel_launch: unexpected shapes (n_in %d, in0 %d, out %d, ws %zu)\n", n_in, n_in > 0 ? in_sizes[0] : -1, out_size, ws_size); grid = -1; return; }
        int dev = 0, cus = 0, per_cu = 0;
        if (hipGetDevice(&dev) != hipSuccess || hipDeviceGetAttribute(&cus, hipDeviceAttributeMultiprocessorCount, dev) != hipSuccess) { fprintf(stderr, "kernel_launch: device query failed\n"); grid = -1; return; }
        if (hipFuncSetAttribute((const void*)fwd_kernel, hipFuncAttributeMaxDynamicSharedMemorySize, LDS_BYTES) != hipSuccess) { fprintf(stderr, "kernel_launch: hipFuncSetAttribute failed\n"); grid = -1; return; }
        if (hipOccupancyMaxActiveBlocksPerMultiprocessor(&per_cu, (const void*)fwd_kernel, NWAVES * 64, LDS_BYTES) != hipSuccess || per_cu < 1) { fprintf(stderr, "kernel_launch: occupancy query reports %d workgroups per CU\n", per_cu); }
        (void)hipGetLastError();
        grid = cus;
    }
    if (grid < 0) return;
    if (hipMemsetAsync((char*)d_ws + WS_CTL, 0, CTL_ZERO_BYTES, stream) != hipSuccess) { fprintf(stderr, "kernel_launch: memset failed\n"); return; }
    KArgs a{};
    for (int i = 0; i < 17; ++i) a.in[i] = (const float*)d_in[i];
    a.out = (float*)d_out; a.ws = (unsigned char*)d_ws;
#if MK_PER_PHASE
    for (int p = 0; p < NPHASES; ++p) { a.ph_lo = p; a.ph_hi = p + 1; hipLaunchKernelGGL(fwd_kernel, dim3(grid), dim3(NWAVES * 64), LDS_BYTES, stream, a); }
#else
    a.ph_lo = 0; a.ph_hi = NPHASES;
    hipLaunchKernelGGL(fwd_kernel, dim3(grid), dim3(NWAVES * 64), LDS_BYTES, stream, a);
#endif
    const hipError_t le = hipPeekAtLastError();
    if (le != hipSuccess) fprintf(stderr, "kernel_launch: launch failed: %s\n", hipGetErrorName(le));
}
```

```cpp
#include <hip/hip_runtime.h>
#include <cstdio>
#include <cstdint>

#ifndef PROBE_DUP
#define PROBE_DUP -1
#endif
#ifndef TAILS
#define TAILS 0
#endif
#ifndef MK_PER_PHASE
#define MK_PER_PHASE 0
#endif

constexpr int NWAVES = 8;
constexpr int BATCH = 4, SEQ = 4096, D = 2048, CTXL = 256, NH = 8, DKH = 128, DVH = 256, DFF = 5504;
constexpr int MX = BATCH * SEQ, MC = BATCH * CTXL, MT = MX + MC;
constexpr int NFI = 2 * DFF;
constexpr int NML = 6400, NMLSRC = 6176, NCV = 6144;
constexpr int MODW = 9 * D;
constexpr float RMS_EPS = 1e-6f;

constexpr size_t MiB = 1u << 20;
constexpr size_t WS_CTL = 0, CTL_ZERO_BYTES = 2 * MiB;
constexpr size_t WS_MOD = 1 * MiB;
constexpr size_t WS_WFI = 2 * MiB;
constexpr size_t WS_WFO = 174 * MiB;
constexpr size_t WS_WMI = 260 * MiB;
constexpr size_t WS_WMO = 285 * MiB;
constexpr size_t WS_WCI = 293 * MiB;
constexpr size_t WS_WCO = 317 * MiB;
constexpr size_t WS_X = 326 * MiB;
constexpr size_t WS_HB = 462 * MiB;
constexpr size_t WS_ACT = 530 * MiB;
constexpr size_t WS_QKVO = 713 * MiB;
constexpr size_t WS_GATES = 917 * MiB;
constexpr size_t WS_HF = 920 * MiB, WS_HBW = 984 * MiB;
constexpr size_t WS_MODP = WS_HF;
constexpr size_t WS_CTXP = 1048 * MiB;
constexpr int NBCOL = 45568;
constexpr int BOFF_MI = 0, BOFF_F1 = 6400, BOFF_F2 = 17408, BOFF_CI = 28416, BOFF_F3 = 34560;
constexpr size_t WS_BIASP = 1112 * MiB;
constexpr size_t WS_BIAS = 1142 * MiB;
constexpr size_t WS_GS = 1144 * MiB;
constexpr size_t WS_SS = 1145 * MiB;
constexpr size_t WS_RSTD = 1148 * MiB;
constexpr size_t WS_END = 1149 * MiB;
constexpr int CW_BAR = 4096;

namespace pg8 {
#define PG8_LAS __attribute__((address_space(3)))
typedef unsigned short bf16_t;
typedef short bf16x8 __attribute__((ext_vector_type(8)));
typedef float f32x4 __attribute__((ext_vector_type(4)));
typedef unsigned u32x4 __attribute__((ext_vector_type(4)));
constexpr int BM = 256, BK = 64, HALF = 128, HTB = HALF * BK * 2, STAGE_BYTES = 8 * HTB, NXCD = 8, WGM = 8;

__host__ __device__ __forceinline__ int lds_byte(int r, int c) { const int st = (r >> 4) * 2 + (c >> 5), rr = r & 15, cc = c & 31, ob = rr * 64 + cc * 2; return st * 1024 + (ob ^ (((ob >> 9) & 1) << 5)); }
__host__ __device__ __forceinline__ void stage_rc(int b, int& R, int& C) { const int st = b / 1024, sb = b % 1024, swz = sb ^ (((sb >> 9) & 1) << 5); R = (st >> 1) * 16 + swz / 64; C = (st & 1) * 32 + (swz % 64) / 2; }
__host__ __device__ __forceinline__ int perm32(int rho) { const int n = rho >> 4, i = rho & 15; return 8 * (i >> 2) + 4 * n + (i & 3); }

struct Unit { int pm, pn, k0, nt; };
struct Gemm { const bf16_t* A; const bf16_t* Bt; int M, N, K; };

struct StaticOrder {
    int nM, nN, nwg, G, c, ntk, wgm;
    __host__ __device__ void init(int M, int N, int G_, int c_, int K_, int wgm_ = WGM) { nM = M / BM; nN = N / BM; nwg = nM * nN; G = G_; c = c_; ntk = K_ / BK; wgm = wgm_; }
    __host__ __device__ bool next(int i, Unit& u) const {
        const long L = (long)i * G + c; if (L >= nwg) return false;
        int wgid = (int)L; { const int q = nwg / NXCD, r = nwg % NXCD, xcd = wgid % NXCD, off = wgid / NXCD; wgid = (xcd < r ? xcd * (q + 1) : r * (q + 1) + (xcd - r) * q) + off; }
        const int nig = wgm * nN, gid = wgid / nig, fm = gid * wgm, gsz = (nM - fm) < wgm ? (nM - fm) : wgm;
        u.pm = fm + ((wgid % nig) % gsz); u.pn = (wgid % nig) / gsz; u.k0 = 0; u.nt = ntk; return true;
    }
    __device__ __forceinline__ void a_ready(const Unit&) const {}
    __device__ __forceinline__ void done(const Unit&) const {}
};

typedef __bf16 bf16x2_t __attribute__((ext_vector_type(2)));
typedef float f32x2_t __attribute__((ext_vector_type(2)));
struct SplitKOrder {
    int G, c, pm0;
    __device__ __forceinline__ bool next(int i, Unit& u) const { const long L = (long)i * G + c; if (L >= 256) return false; const int w = (int)L, sl = w & 7, tile = w >> 3;
        u.pm = pm0 + (tile >> 3); u.pn = tile & 7; const int p0 = sl < 5 ? 5 * sl : 25 + 6 * (sl - 5), np = sl < 5 ? 5 : 6; u.k0 = p0 * 128; u.nt = np * 2; return true; }
    __device__ __forceinline__ void a_ready(const Unit&) const {}
    __device__ __forceinline__ void done(const Unit&) const {}
};
__device__ __forceinline__ unsigned cvt_pk_bf16(float lo, float hi) { const f32x2_t v = {lo, hi}; const bf16x2_t b = __builtin_convertvector(v, bf16x2_t); return __builtin_bit_cast(unsigned, b); }
__device__ __forceinline__ float silu_f(float x) { return x * __builtin_amdgcn_rcpf(1.0f + __builtin_amdgcn_exp2f(-1.44269504f * x)); }


struct Fold { const unsigned char* ws; int boff;
    __device__ __forceinline__ const float* rstd() const { return (const float*)(ws + WS_RSTD); }
    __device__ __forceinline__ const float* bias(int bidx) const { return (const float*)(ws + WS_BIAS) + (size_t)bidx * NBCOL + boff; } };
template <bool FOLD> struct EpiSwigluT {
    static constexpr bool PERM = true, AFTER_DRAIN = false;
    bf16_t* O; int ldc; Fold F;
    __device__ __forceinline__ void operator()(const f32x4 (&acc)[2][2][4][2], const Unit& u, int wr, int wc, int fr, int fq) const {
        const int row0 = u.pm * BM + wr * 64 + fr, col0 = u.pn * HALF + wc * 32 + 8 * fq;
        f32x4 bg[2], bu[2];
        if (FOLD) { const int bidx = (u.pm * BM >= MX) ? 5 : (u.pm >> 4); const float* bp = F.bias(bidx) + u.pn * BM + wc * 32 + 8 * fq;
            bg[0] = *(const f32x4*)bp; bg[1] = *(const f32x4*)(bp + 4); bu[0] = *(const f32x4*)(bp + HALF); bu[1] = *(const f32x4*)(bp + HALF + 4); }
#pragma unroll
        for (int ai = 0; ai < 2; ++ai)
#pragma unroll
            for (int m = 0; m < 4; ++m) { const int r = row0 + ai * HALF + m * 16; bf16_t* rowp = O + (size_t)r * ldc + col0;
                f32x4 g0 = acc[ai][0][m][0], g1 = acc[ai][0][m][1], u0 = acc[ai][1][m][0], u1 = acc[ai][1][m][1];
                if (FOLD) { const float rs = F.rstd()[r]; g0 = g0 * rs + bg[0]; g1 = g1 * rs + bg[1]; u0 = u0 * rs + bu[0]; u1 = u1 * rs + bu[1]; }
                u32x4 w; w.x = cvt_pk_bf16(silu_f(g0[0]) * u0[0], silu_f(g0[1]) * u0[1]); w.y = cvt_pk_bf16(silu_f(g0[2]) * u0[2], silu_f(g0[3]) * u0[3]);
                w.z = cvt_pk_bf16(silu_f(g1[0]) * u1[0], silu_f(g1[1]) * u1[1]); w.w = cvt_pk_bf16(silu_f(g1[2]) * u1[2], silu_f(g1[3]) * u1[3]);
                *(u32x4*)rowp = w; }
    }
};
template <bool NEXT, bool HALFC> struct EpiResidT {
    static constexpr bool PERM = false, AFTER_DRAIN = false;
    const float* xin_x; const float* xin_c; unsigned char* ws; int gate_off, nsub;
    __device__ __forceinline__ void operator()(const f32x4 (&acc)[2][2][4][2], const Unit& u, int wr, int wc, int fr, int fq) const {
        const bool isc = (u.pm * BM) >= MX; const int bidx = isc ? 4 : (u.pm >> 4); const float coef = HALFC ? 0.5f : 1.0f;
        float* X = (float*)(ws + WS_X); bf16_t* XS = (bf16_t*)(ws + WS_HB); float* SS = (float*)(ws + WS_SS);
        const float* gv = (const float*)(ws + WS_MOD) + gate_off + (size_t)bidx * MODW; const float* gs = (const float*)(ws + WS_GS) + ((size_t)nsub * 5 + bidx) * D;
        const int col0 = u.pn * BM + wc * 32 + 4 * fq; const int row0 = u.pm * BM + wr * 64 + fr;
        f32x4 gg[2][2], gsv[2][2];
#pragma unroll
        for (int bj = 0; bj < 2; ++bj)
#pragma unroll
            for (int n = 0; n < 2; ++n) { gg[bj][n] = *(const f32x4*)(gv + col0 + bj * HALF + n * 16) * coef; if (NEXT) gsv[bj][n] = *(const f32x4*)(gs + col0 + bj * HALF + n * 16); }
#pragma unroll
        for (int ai = 0; ai < 2; ++ai)
#pragma unroll
            for (int m = 0; m < 4; ++m) { const int r = row0 + ai * HALF + m * 16;
                const float* src = (isc ? xin_c + (size_t)(r - MX) * D : xin_x + (size_t)r * D) + col0; float* dst = X + (size_t)r * D + col0; float sq = 0.f;
#pragma unroll
                for (int bj = 0; bj < 2; ++bj)
#pragma unroll
                    for (int n = 0; n < 2; ++n) { const f32x4 bs = *(const f32x4*)(src + bj * HALF + n * 16); const f32x4 xn = bs + acc[ai][bj][m][n] * gg[bj][n]; *(f32x4*)(dst + bj * HALF + n * 16) = xn;
                        if (NEXT) { const f32x4 y = xn * gsv[bj][n]; typedef unsigned u32x2v __attribute__((ext_vector_type(2))); u32x2v w; w.x = cvt_pk_bf16(y[0], y[1]); w.y = cvt_pk_bf16(y[2], y[3]);
                            *(u32x2v*)(XS + (size_t)r * D + col0 + bj * HALF + n * 16) = w; sq += (xn[0] * xn[0] + xn[1] * xn[1]) + (xn[2] * xn[2] + xn[3] * xn[3]); } }
                if (NEXT) { sq += __shfl_xor(sq, 16); sq += __shfl_xor(sq, 32); if (fq == 0) SS[(size_t)r * 32 + u.pn * 4 + wc] = sq; }
                if (m & 1) asm volatile("" ::: "memory"); }
    }
};
struct EpiPartial {
    static constexpr bool PERM = false, AFTER_DRAIN = false;
    float* P; int row0; size_t slice_stride;
    __device__ __forceinline__ void operator()(const f32x4 (&acc)[2][2][4][2], const Unit& u, int wr, int wc, int fr, int fq) const {
        const int sl = u.k0 < 25 * 128 ? u.k0 / (5 * 128) : 5 + (u.k0 - 25 * 128) / (6 * 128);
        float* base = P + (size_t)sl * slice_stride; const int col0 = u.pn * BM + wc * 32 + 4 * fq, r0 = u.pm * BM - row0 + wr * 64 + fr;
#pragma unroll
        for (int ai = 0; ai < 2; ++ai)
#pragma unroll
            for (int m = 0; m < 4; ++m) { float* rowp = base + (size_t)(r0 + ai * HALF + m * 16) * 2048 + col0;
#pragma unroll
                for (int bj = 0; bj < 2; ++bj)
#pragma unroll
                    for (int n = 0; n < 2; ++n) *(f32x4*)(rowp + bj * HALF + n * 16) = acc[ai][bj][m][n]; }
    }
};
template <bool FOLD> struct EpiMlstmInT {
    static constexpr bool PERM = true, AFTER_DRAIN = false;
    bf16_t* O; float* G; const float* bgate; Fold F;
    __device__ __forceinline__ void operator()(const f32x4 (&acc)[2][2][4][2], const Unit& u, int wr, int wc, int fr, int fq) const {
        const int row0 = u.pm * BM + wr * 64 + fr;
        f32x4 bv[2][2];
#pragma unroll
        for (int bj = 0; bj < 2; ++bj)
#pragma unroll
            for (int n = 0; n < 2; ++n) bv[bj][n] = (f32x4){0.f, 0.f, 0.f, 0.f};
        if (FOLD) { const int bidx = (u.pm * BM >= MX) ? 5 : (u.pm >> 4); const float* bp = F.bias(bidx) + u.pn * BM + wc * 32 + 8 * fq;
#pragma unroll
            for (int bj = 0; bj < 2; ++bj)
#pragma unroll
                for (int n = 0; n < 2; ++n) bv[bj][n] = *(const f32x4*)(bp + bj * HALF + 4 * n); }
        if (u.pn < 24) {
            const int col0 = u.pn * BM + wc * 32 + 8 * fq;
#pragma unroll
            for (int ai = 0; ai < 2; ++ai)
#pragma unroll
                for (int m = 0; m < 4; ++m) { const int r = row0 + ai * HALF + m * 16; bf16_t* rowp = O + (size_t)r * 6144 + col0; const float rs = FOLD ? F.rstd()[r] : 1.0f;
#pragma unroll
                    for (int bj = 0; bj < 2; ++bj) { f32x4 v0 = acc[ai][bj][m][0], v1 = acc[ai][bj][m][1]; if (FOLD) { v0 = v0 * rs + bv[bj][0]; v1 = v1 * rs + bv[bj][1]; }
                        u32x4 w; w.x = cvt_pk_bf16(v0[0], v0[1]); w.y = cvt_pk_bf16(v0[2], v0[3]); w.z = cvt_pk_bf16(v1[0], v1[1]); w.w = cvt_pk_bf16(v1[2], v1[3]);
                        *(u32x4*)(rowp + bj * HALF) = w; } }
        } else if (wc == 0) {
            const f32x4 b0 = *(const f32x4*)(bgate + 8 * fq) + bv[0][0], b1 = *(const f32x4*)(bgate + 8 * fq + 4) + bv[0][1];
#pragma unroll
            for (int ai = 0; ai < 2; ++ai)
#pragma unroll
                for (int m = 0; m < 4; ++m) { const int r = row0 + ai * HALF + m * 16; float* rowp = G + (size_t)r * 32 + 8 * fq; const float rs = FOLD ? F.rstd()[r] : 1.0f;
                    *(f32x4*)rowp = acc[ai][0][m][0] * rs + b0; *(f32x4*)(rowp + 4) = acc[ai][0][m][1] * rs + b1; }
        }
    }
};
template <bool FOLD> struct EpiConvInT {
    static constexpr bool PERM = true, AFTER_DRAIN = false;
    bf16_t* BG; bf16_t* Z; Fold F;
    __device__ __forceinline__ void operator()(const f32x4 (&acc)[2][2][4][2], const Unit& u, int wr, int wc, int fr, int fq) const {
        const int row0 = u.pm * BM + wr * 64 + fr;
        f32x4 bv[2][2];
#pragma unroll
        for (int bj = 0; bj < 2; ++bj)
#pragma unroll
            for (int n = 0; n < 2; ++n) bv[bj][n] = (f32x4){0.f, 0.f, 0.f, 0.f};
        if (FOLD) { const int bidx = (u.pm * BM >= MX) ? 5 : (u.pm >> 4); const float* bp = F.bias(bidx) + u.pn * BM + wc * 32 + 8 * fq;
#pragma unroll
            for (int bj = 0; bj < 2; ++bj)
#pragma unroll
                for (int n = 0; n < 2; ++n) bv[bj][n] = *(const f32x4*)(bp + bj * HALF + 4 * n); }
        if (u.pn < 8) {
            const int col0 = u.pn * BM + wc * 32 + 8 * fq;
#pragma unroll
            for (int ai = 0; ai < 2; ++ai)
#pragma unroll
                for (int m = 0; m < 4; ++m) { const int r = row0 + ai * HALF + m * 16; bf16_t* rowp = BG + (size_t)r * 2048 + col0; const float rs = FOLD ? F.rstd()[r] : 1.0f;
#pragma unroll
                    for (int bj = 0; bj < 2; ++bj) { f32x4 v0 = acc[ai][bj][m][0], v1 = acc[ai][bj][m][1]; if (FOLD) { v0 = v0 * rs + bv[bj][0]; v1 = v1 * rs + bv[bj][1]; }
                        u32x4 w; w.x = cvt_pk_bf16(v0[0], v0[1]); w.y = cvt_pk_bf16(v0[2], v0[3]); w.z = cvt_pk_bf16(v1[0], v1[1]); w.w = cvt_pk_bf16(v1[2], v1[3]);
                        *(u32x4*)(rowp + bj * HALF) = w; } }
        } else {
            const int col0 = (u.pn - 8) * HALF + wc * 32 + 8 * fq;
#pragma unroll
            for (int ai = 0; ai < 2; ++ai)
#pragma unroll
                for (int m = 0; m < 4; ++m) { const int r = row0 + ai * HALF + m * 16; bf16_t* rowp = Z + (size_t)r * 2048 + col0; const float rs = FOLD ? F.rstd()[r] : 1.0f;
                    f32x4 c0 = acc[ai][0][m][0], c1 = acc[ai][0][m][1], u0 = acc[ai][1][m][0], u1 = acc[ai][1][m][1];
                    if (FOLD) { c0 = c0 * rs + bv[0][0]; c1 = c1 * rs + bv[0][1]; u0 = u0 * rs + bv[1][0]; u1 = u1 * rs + bv[1][1]; }
                    const f32x4 v0 = c0 * u0, v1 = c1 * u1;
                    u32x4 w; w.x = cvt_pk_bf16(v0[0], v0[1]); w.y = cvt_pk_bf16(v0[2], v0[3]); w.z = cvt_pk_bf16(v1[0], v1[1]); w.w = cvt_pk_bf16(v1[2], v1[3]);
                    *(u32x4*)rowp = w; }
        }
    }
};

template <class Epi, class Sched, bool ALIGN_EPI = false, bool SP2 = false>
__device__ __forceinline__ void gemm_phase(PG8_LAS unsigned char* lds, const Gemm g, const Sched& S, const Epi& E) {
    const int tid = threadIdx.x, wid = __builtin_amdgcn_readfirstlane(tid >> 6), lane = tid & 63, wr = wid >> 2, wc = wid & 3, fr = lane & 15, fq = lane >> 4;
    const int K = g.K;
    unsigned voffA[2], voffB[2];
#pragma unroll
    for (int i = 0; i < 2; ++i) { int R, C; stage_rc(tid * 16 + i * 8192, R, C); const int Rb = Epi::PERM ? ((R & ~31) + perm32(R & 31)) : R;
        voffA[i] = (unsigned)(R * K + C) * 2u; voffB[i] = (unsigned)(Rb * K + C) * 2u; }
    const size_t kstep = (size_t)(BK * 2);
    const size_t hstep = (size_t)HALF * K * 2;
    const size_t tstep = 2 * hstep;
    const unsigned ldsw = (unsigned)wid * 1024u;
    const int aoff = lds_byte(wr * 64 + fr, fq * 8), boff = lds_byte(wc * 32 + fr, fq * 8);
#define PG8_SA(b, h) (((b) * 2 + (h)) * HTB)
#define PG8_SB(b, h) ((4 + (b) * 2 + (h)) * HTB)
#define PG8_STAGE(bufoff, gbase, voff) do { _Pragma("unroll") for (int _i = 0; _i < 2; ++_i) \
        __builtin_amdgcn_global_load_lds((const unsigned*)((const char*)(gbase) + (voff)[_i]), (PG8_LAS unsigned*)(lds + (bufoff) + ldsw + _i * 8192), 16, 0, 0); } while (0)
#define PG8_LDA(dst, b, h) do { _Pragma("unroll") for (int m = 0; m < 4; ++m) _Pragma("unroll") for (int k = 0; k < 2; ++k) dst[m][k] = *(const PG8_LAS bf16x8*)(lds + PG8_SA(b, h) + aoff + m * 2048 + k * 1024); } while (0)
#define PG8_LDB(dst, b, h) do { _Pragma("unroll") for (int n = 0; n < 2; ++n) _Pragma("unroll") for (int k = 0; k < 2; ++k) dst[n][k] = *(const PG8_LAS bf16x8*)(lds + PG8_SB(b, h) + boff + n * 2048 + k * 1024); } while (0)
#define PG8_MMA(ai, bj, At, Bt) do { __builtin_amdgcn_s_setprio(1); _Pragma("unroll") for (int m = 0; m < 4; ++m) _Pragma("unroll") for (int n = 0; n < 2; ++n) _Pragma("unroll") for (int k = 0; k < 2; ++k) \
        acc[ai][bj][m][n] = __builtin_amdgcn_mfma_f32_16x16x32_bf16(Bt[n][k], At[m][k], acc[ai][bj][m][n], 0, 0, 0); __builtin_amdgcn_s_setprio(0); } while (0)
#define PG8_WAIT_V(n) asm volatile("s_waitcnt vmcnt(" #n ")" ::: "memory")
#define PG8_WAIT_L(n) asm volatile("s_waitcnt lgkmcnt(" #n ")" ::: "memory")
#define PG8_BAR __builtin_amdgcn_s_barrier()
#define PG8_SCHED __builtin_amdgcn_sched_barrier(0)
    Unit cur, nxt; int ui = 0;
    if (!S.next(0, cur)) return;
    f32x4 acc[2][2][4][2];
#pragma unroll
    for (int a = 0; a < 2; ++a)
#pragma unroll
        for (int b = 0; b < 2; ++b)
#pragma unroll
            for (int m = 0; m < 4; ++m)
#pragma unroll
                for (int n = 0; n < 2; ++n) acc[a][b][m][n] = (f32x4){0.f, 0.f, 0.f, 0.f};
    bf16x8 At[4][2], B0[2][2], B1[2][2];
    const char* cA = (const char*)g.A + (size_t)cur.pm * tstep + (size_t)cur.k0 * 2; const char* cB = (const char*)g.Bt + (size_t)cur.pn * tstep + (size_t)cur.k0 * 2;
    S.a_ready(cur);
    if constexpr (SP2) {
        PG8_STAGE(PG8_SB(0, 0), cB, voffB); PG8_STAGE(PG8_SB(0, 1), cB + hstep, voffB); PG8_STAGE(PG8_SA(0, 0), cA, voffA); PG8_STAGE(PG8_SA(0, 1), cA + hstep, voffA);
        if (wr == 1) PG8_BAR;
        PG8_WAIT_V(2); PG8_BAR;
        PG8_STAGE(PG8_SB(1, 0), cB + kstep, voffB); PG8_STAGE(PG8_SA(1, 0), cA + kstep, voffA); PG8_STAGE(PG8_SB(1, 1), cB + hstep + kstep, voffB);
        PG8_WAIT_V(6); PG8_BAR;
    } else {
        PG8_STAGE(PG8_SB(0, 0), cB, voffB); PG8_STAGE(PG8_SA(0, 0), cA, voffA); PG8_STAGE(PG8_SB(0, 1), cB + hstep, voffB); PG8_STAGE(PG8_SA(0, 1), cA + hstep, voffA);
        if (wr == 1) PG8_BAR;
        PG8_WAIT_V(4); PG8_BAR;
        PG8_STAGE(PG8_SB(1, 0), cB + kstep, voffB); PG8_STAGE(PG8_SA(1, 0), cA + kstep, voffA); PG8_STAGE(PG8_SB(1, 1), cB + hstep + kstep, voffB);
        PG8_WAIT_V(6); PG8_BAR;
    }
    for (;;) {
        const bool has_next = S.next(ui + 1, nxt);
        const char* nA = has_next ? (const char*)g.A + (size_t)nxt.pm * tstep + (size_t)nxt.k0 * 2 : cA; const char* nB = has_next ? (const char*)g.Bt + (size_t)nxt.pn * tstep + (size_t)nxt.k0 * 2 : cB;
        const int nt = cur.nt;
        for (int t = 0; t < nt; t += 2) {
            const bool last = (t == nt - 2);
            const char* a1 = cA + (size_t)(t + 1) * kstep;
            const char* a2 = last ? nA : cA + (size_t)(t + 2) * kstep; const char* b2 = last ? nB : cB + (size_t)(t + 2) * kstep;
            const char* a3 = a2 + kstep; const char* b3 = b2 + kstep;
            if (last && has_next) S.a_ready(nxt);
            if constexpr (SP2) {
            PG8_LDB(B0, 0, 0); PG8_LDB(B1, 0, 1); PG8_SCHED; PG8_LDA(At, 0, 0); PG8_STAGE(PG8_SA(1, 1), a1 + hstep, voffA);
            PG8_WAIT_V(8); PG8_WAIT_L(0); PG8_BAR; PG8_MMA(0, 0, At, B0); PG8_MMA(0, 1, At, B1); PG8_BAR; PG8_SCHED;
            PG8_LDA(At, 0, 1); PG8_STAGE(PG8_SB(0, 0), b2, voffB); PG8_STAGE(PG8_SB(0, 1), b2 + hstep, voffB); PG8_STAGE(PG8_SA(0, 0), a2, voffA);
            PG8_WAIT_V(8); PG8_WAIT_L(0); PG8_BAR; PG8_MMA(1, 0, At, B0); PG8_MMA(1, 1, At, B1); PG8_BAR; PG8_SCHED;
            PG8_LDB(B0, 1, 0); PG8_LDB(B1, 1, 1); PG8_SCHED; PG8_LDA(At, 1, 0); PG8_STAGE(PG8_SA(0, 1), a2 + hstep, voffA);
            PG8_WAIT_V(8); PG8_WAIT_L(0); PG8_BAR; PG8_MMA(0, 0, At, B0); PG8_MMA(0, 1, At, B1); PG8_BAR; PG8_SCHED;
            PG8_LDA(At, 1, 1); PG8_STAGE(PG8_SB(1, 0), b3, voffB); PG8_STAGE(PG8_SB(1, 1), b3 + hstep, voffB); PG8_STAGE(PG8_SA(1, 0), a3, voffA);
            PG8_WAIT_V(8); PG8_WAIT_L(0); PG8_BAR; PG8_MMA(1, 0, At, B0); PG8_MMA(1, 1, At, B1); PG8_BAR; PG8_SCHED;
            } else {
            PG8_LDB(B0, 0, 0); PG8_SCHED; PG8_LDA(At, 0, 0); PG8_STAGE(PG8_SA(1, 1), a1 + hstep, voffA);
            PG8_WAIT_L(8); PG8_BAR; PG8_WAIT_L(0); PG8_MMA(0, 0, At, B0); PG8_BAR; PG8_SCHED;
            PG8_LDB(B1, 0, 1); PG8_STAGE(PG8_SB(0, 0), b2, voffB);
            PG8_BAR; PG8_WAIT_L(0); PG8_MMA(0, 1, At, B1); PG8_BAR;
            PG8_LDA(At, 0, 1); PG8_STAGE(PG8_SA(0, 0), a2, voffA);
            PG8_BAR; PG8_WAIT_L(0); PG8_MMA(1, 0, At, B0); PG8_BAR; PG8_SCHED;
            PG8_STAGE(PG8_SB(0, 1), b2 + hstep, voffB);
            PG8_WAIT_V(6); PG8_BAR; PG8_MMA(1, 1, At, B1); PG8_BAR;
            PG8_LDB(B0, 1, 0); PG8_SCHED; PG8_LDA(At, 1, 0); PG8_STAGE(PG8_SA(0, 1), a2 + hstep, voffA);
            PG8_WAIT_L(8); PG8_BAR; PG8_WAIT_L(0); PG8_MMA(0, 0, At, B0); PG8_BAR; PG8_SCHED;
            PG8_LDB(B1, 1, 1); PG8_STAGE(PG8_SB(1, 0), b3, voffB);
            PG8_BAR; PG8_WAIT_L(0); PG8_MMA(0, 1, At, B1); PG8_BAR;
            PG8_LDA(At, 1, 1); PG8_STAGE(PG8_SA(1, 0), a3, voffA);
            PG8_BAR; PG8_WAIT_L(0); PG8_MMA(1, 0, At, B0); PG8_BAR; PG8_SCHED;
            PG8_STAGE(PG8_SB(1, 1), b3 + hstep, voffB);
            PG8_WAIT_V(6); PG8_BAR; PG8_MMA(1, 1, At, B1); PG8_BAR;
            }
        }
        if constexpr (ALIGN_EPI) { if (wr == 0) PG8_BAR; }
        if constexpr (!Epi::AFTER_DRAIN) { E(acc, cur, wr, wc, fr, fq); S.done(cur); }
        if (!has_next) break;
#pragma unroll
        for (int a = 0; a < 2; ++a)
#pragma unroll
            for (int b = 0; b < 2; ++b)
#pragma unroll
                for (int m = 0; m < 4; ++m)
#pragma unroll
                    for (int n = 0; n < 2; ++n) acc[a][b][m][n] = (f32x4){0.f, 0.f, 0.f, 0.f};
        cur = nxt; cA = nA; cB = nB; ++ui;
        if constexpr (ALIGN_EPI) { if (wr == 1) PG8_BAR; }
    }
    PG8_WAIT_V(0);
    if constexpr (!ALIGN_EPI) { if (wr == 0) PG8_BAR; }
    PG8_BAR;
#undef PG8_SA
#undef PG8_SB
#undef PG8_STAGE
#undef PG8_LDA
#undef PG8_LDB
#undef PG8_MMA
#undef PG8_WAIT_V
#undef PG8_WAIT_L
#undef PG8_BAR
#undef PG8_SCHED
}
}

constexpr int RING_BYTES = 131072;
constexpr int SCR_BYTES = 8 * 64 * 65 * 4;
constexpr int LDSCTL_OFF = 151552, LDS_BYTES = 155648;

#define GAS __attribute__((address_space(1)))
#define LAS __attribute__((address_space(3)))
typedef unsigned short bf16;
typedef unsigned v4u __attribute__((ext_vector_type(4)));
typedef unsigned v2u __attribute__((ext_vector_type(2)));
typedef float f32x4 __attribute__((ext_vector_type(4)));
typedef short bf16x8 __attribute__((ext_vector_type(8)));
typedef short s16x4 __attribute__((ext_vector_type(4)));
#define LDS_WAIT() asm volatile("s_waitcnt lgkmcnt(0)" ::: "memory")
__device__ __forceinline__ unsigned f2bf(float f) { unsigned u = __builtin_bit_cast(unsigned, f); return (u + 0x7fffu + ((u >> 16) & 1u)) >> 16; }
__device__ __forceinline__ unsigned pk2(float lo, float hi) { return pg8::cvt_pk_bf16(lo, hi); }
__device__ __forceinline__ float bflo(unsigned w) { return __builtin_bit_cast(float, w << 16); }
__device__ __forceinline__ float bfhi(unsigned w) { return __builtin_bit_cast(float, w & 0xffff0000u); }

#define XB_TMO      128
#define XB_XCNT(j)  (256  + 64 * (j))
#define XB_XSUB(j)  (1280 + 64 * (j))
#define XB_XGEN(j)  (2304 + 64 * (j))
#define XB_TOP      3328
#define XB_TOPGEN   3392
#define XCD_BAR_WORDS 3456
#define XB_SPIN_CAP (1u << 18)
__device__ __forceinline__ unsigned xb_ld(unsigned* p)              { return __hip_atomic_load(p, __ATOMIC_RELAXED, __HIP_MEMORY_SCOPE_AGENT); }
__device__ __forceinline__ unsigned xb_add(unsigned* p, unsigned v) { return __hip_atomic_fetch_add(p, v, __ATOMIC_RELAXED, __HIP_MEMORY_SCOPE_AGENT); }
__device__ __forceinline__ unsigned xb_xcc_id() { return (unsigned)__builtin_amdgcn_s_getreg((3 << 11) | 20) & 0xFu; }
#define XB_SPIN(cond, bar) do { unsigned _sp = 0; while (cond) { __builtin_amdgcn_s_sleep(1); \
    if ((++_sp & 255u) == 0u) { if (xb_ld(&(bar)[XB_TMO])) break; if (_sp > XB_SPIN_CAP) { atomicAdd(&(bar)[XB_TMO], 1u); break; } } } } while (0)
struct XcdBarrier { unsigned* bar; unsigned x; volatile LAS unsigned* st; };
__device__ __forceinline__ XcdBarrier xcd_barrier_post(unsigned* bar, volatile LAS unsigned* st) {
    XcdBarrier b; b.bar = bar; b.x = xb_xcc_id(); b.st = st;
    if (threadIdx.x == 0) (void)xb_add(&bar[XB_XCNT(b.x)], 1u);
    return b;
}
__device__ __forceinline__ void xcd_barrier_complete(unsigned* bar, unsigned x, unsigned& nloc, unsigned& nx) {
    const unsigned G = gridDim.x * gridDim.y * gridDim.z;
    unsigned sum, cnt, mine, sp = 0u;
    for (;;) {
        sum = 0u; cnt = 0u; mine = 0u;
#pragma unroll
        for (unsigned j = 0; j < 16; ++j) { const unsigned c = xb_ld(&bar[XB_XCNT(j)]); sum += c; cnt += (c > 0u) ? 1u : 0u; mine = (j == x) ? c : mine; }
        if (sum == G) break;
        __builtin_amdgcn_s_sleep(1);
        if ((++sp & 255u) == 0u) { if (xb_ld(&bar[XB_TMO])) break; if (sp > XB_SPIN_CAP) { atomicAdd(&bar[XB_TMO], 1u); break; } }
    }
    nloc = mine > 0u ? mine : 1u; nx = cnt > 0u ? cnt : 1u;
}
__device__ __forceinline__ void xcd_barrier(const XcdBarrier& b) {
    asm volatile("s_waitcnt vmcnt(0)" ::: "memory");
    __syncthreads();
    if (threadIdx.x == 0) {
        unsigned* bar = b.bar;
        __builtin_amdgcn_s_waitcnt(0);
        unsigned nloc = b.st[0], nx = b.st[1];
        if (nloc == 0u) { xcd_barrier_complete(bar, b.x, nloc, nx); b.st[0] = nloc; b.st[1] = nx; }
        const unsigned old = xb_add(&bar[XB_XSUB(b.x)], 1u);
        const unsigned gen = old / nloc;
        if (old + 1u == (gen + 1u) * nloc) {
            __builtin_amdgcn_fence(__ATOMIC_RELEASE, "agent");
            asm volatile("s_waitcnt vmcnt(0)" ::: "memory");
            const unsigned og = xb_add(&bar[XB_TOP], 1u);
            const unsigned tg = og / nx;
            if (og + 1u == (tg + 1u) * nx) xb_add(&bar[XB_TOPGEN], 1u);
            else XB_SPIN(xb_ld(&bar[XB_TOPGEN]) == tg, bar);
            __builtin_amdgcn_fence(__ATOMIC_ACQUIRE, "agent");
            xb_add(&bar[XB_XGEN(b.x)], 1u);
            asm volatile("s_waitcnt vmcnt(0)" ::: "memory");
        } else {
            XB_SPIN(xb_ld(&bar[XB_XGEN(b.x)]) == gen, bar);
            __builtin_amdgcn_fence(__ATOMIC_ACQUIRE, "agent");
            asm volatile("s_waitcnt vmcnt(0)" ::: "memory");
        }
    }
    __syncthreads();
}

__device__ __forceinline__ float wave_sum(float v) {
#pragma unroll
    for (int o = 1; o < 64; o <<= 1) v += __shfl_xor(v, o);
    return v;
}
template <int MAPK> __device__ __forceinline__ int wmap(int n) {
    if (MAPK == 1) { const int pn = n >> 8, r = n & 255; return ((r < 128) ? 0 : DFF) + 128 * pn + (r & 127); }
    if (MAPK == 2) { return n < 4096 ? n : (n < 6144 ? n + 32 : (n < 6176 ? n - 2048 : -1)); }
    if (MAPK == 3) { if (n < 2048) return n; const int q = n - 2048, pn = q >> 8, r = q & 255; return ((r < 128) ? 2048 : 4096) + 128 * pn + (r & 127); }
    return n;
}
template <int MAPK, bool BIAS = false> __device__ __forceinline__ void transpose_item(const float* W, int K, int Nsrc, bf16* WT, int nblk, LAS float* scr, int item, int lane, const float* shift = nullptr, float* biasp = nullptr) {
    const int kb = item / nblk, nb = item - kb * nblk, k0 = 64 * kb, n0 = 64 * nb;
    const int n = n0 + lane, sc = wmap<MAPK>(n);
    const float scale = (MAPK == 2 && n < 1024) ? 0.08838834764831845f : 1.0f;
    const float* src = W + (size_t)k0 * Nsrc + (sc >= 0 ? sc : 0);
#pragma unroll
    for (int hb = 0; hb < 2; ++hb) { float v[32];
#pragma unroll
        for (int i = 0; i < 32; ++i) v[i] = src[(size_t)(32 * hb + i) * Nsrc];
#pragma unroll
        for (int i = 0; i < 32; ++i) scr[(32 * hb + i) * 65 + lane] = (sc >= 0) ? v[i] * scale : 0.f; }
    LDS_WAIT(); asm volatile("" ::: "memory");
    if (BIAS) { float sv[5], ba[5];
#pragma unroll
        for (int b = 0; b < 5; ++b) { sv[b] = shift[(size_t)b * MODW + k0 + lane]; ba[b] = 0.f; }
#pragma unroll 16
        for (int k = 0; k < 64; ++k) { const float w = scr[k * 65 + lane];
#pragma unroll
            for (int b = 0; b < 5; ++b) ba[b] += w * __builtin_bit_cast(float, __builtin_amdgcn_readlane(__builtin_bit_cast(int, sv[b]), k)); }
#pragma unroll
        for (int b = 0; b < 5; ++b) biasp[((size_t)kb * 5 + b) * NBCOL + n0 + lane] = ba[b]; }
    const int c = lane & 7;
#pragma unroll
    for (int j = 0; j < 8; ++j) { const int nn = (lane >> 3) + 8 * j; const LAS float* s = scr + (8 * c) * 65 + nn;
        v4u o; o.x = pk2(s[0 * 65], s[1 * 65]); o.y = pk2(s[2 * 65], s[3 * 65]); o.z = pk2(s[4 * 65], s[5 * 65]); o.w = pk2(s[6 * 65], s[7 * 65]);
        *(GAS v4u*)(WT + (size_t)(n0 + nn) * K + k0 + 8 * c) = o; }
    LDS_WAIT(); asm volatile("" ::: "memory");
}

struct KArgs { const float* in[17]; float* out; unsigned char* ws; int ph_lo, ph_hi; };

__device__ __forceinline__ void normmod_phase(const float* xx, const float* xc, int rows, const float* ng, const float* modl, int j, bf16* HB, int gw, int NGW, int lane, const float* ctxP = nullptr, const float* cgate = nullptr, int first_row = 0) {
    for (int r = first_row + gw; r < rows; r += NGW) {
        const bool isc = r >= MX; const int b = isc ? 4 : (r >> 12);
        const float* src = isc ? xc + (size_t)(r - MX) * D : xx + (size_t)r * D;
        const float* shift = modl + (size_t)b * MODW + (3 * j) * D; const float* scale = shift + D;
        f32x4 v[8]; float ss = 0.f;
#pragma unroll
        for (int q = 0; q < 8; ++q) { v[q] = *(const f32x4*)(src + 4 * (lane + 64 * q));
            if (ctxP && isc) { const int c = 4 * (lane + 64 * q); f32x4 p = *(const f32x4*)(ctxP + (size_t)(r - MX) * D + c);
#pragma unroll
                for (int sl = 1; sl < 8; ++sl) p += *(const f32x4*)(ctxP + ((size_t)sl * MC + (r - MX)) * D + c);
                v[q] += p * (*(const f32x4*)(cgate + c)) * 0.5f; }
            ss += (v[q][0] * v[q][0] + v[q][1] * v[q][1]) + (v[q][2] * v[q][2] + v[q][3] * v[q][3]); }
        const float rstd = 1.0f / sqrtf(wave_sum(ss) * (1.0f / D) + RMS_EPS);
        bf16* orow = HB + (size_t)r * D;
#pragma unroll
        for (int q = 0; q < 8; ++q) { const int c = 4 * (lane + 64 * q);
            const f32x4 g4 = *(const f32x4*)(ng + c), s4 = *(const f32x4*)(scale + c), h4 = *(const f32x4*)(shift + c);
            const f32x4 y = v[q] * rstd * g4 * (s4 + 1.0f) + h4;
            v2u o; o.x = pk2(y[0], y[1]); o.y = pk2(y[2], y[3]); *(v2u*)(orow + c) = o; }
    }
}
__device__ __forceinline__ void final_norm_phase(const float* X, const float* ng, float* out, int gw, int NGW, int lane) {
    for (int r = gw; r < MX; r += NGW) {
        const float* src = X + (size_t)r * D; f32x4 v[8]; float ss = 0.f;
#pragma unroll
        for (int q = 0; q < 8; ++q) { v[q] = *(const f32x4*)(src + 4 * (lane + 64 * q)); ss += (v[q][0] * v[q][0] + v[q][1] * v[q][1]) + (v[q][2] * v[q][2] + v[q][3] * v[q][3]); }
        const float rstd = 1.0f / sqrtf(wave_sum(ss) * (1.0f / D) + RMS_EPS);
        float* orow = out + (size_t)r * D;
#pragma unroll
        for (int q = 0; q < 8; ++q) { const int c = 4 * (lane + 64 * q); const f32x4 g4 = *(const f32x4*)(ng + c); *(f32x4*)(orow + c) = v[q] * rstd * g4; }
    }
}
__device__ __forceinline__ void unpack8(const v4u w, float (&f)[8]) { f[0] = bflo(w.x); f[1] = bfhi(w.x); f[2] = bflo(w.y); f[3] = bfhi(w.y); f[4] = bflo(w.z); f[5] = bfhi(w.z); f[6] = bflo(w.w); f[7] = bfhi(w.w); }
__device__ __forceinline__ void headnorm_phase(const bf16* HF, const bf16* HBW, const bf16* QKVO, const float* ng, bf16* Y, int gw, int NGW, int lane) {
    for (int r = gw; r < MX; r += NGW) {
#pragma unroll
        for (int q = 0; q < 4; ++q) { const int c = 8 * (lane + 64 * q);
            const v4u a = *(const v4u*)(HF + (size_t)r * D + c), b = *(const v4u*)(HBW + (size_t)r * D + c), o = *(const v4u*)(QKVO + (size_t)r * 6144 + 4096 + c);
            float fa[8], fb[8], fo[8]; unpack8(a, fa); unpack8(b, fb); unpack8(o, fo);
            float s[8], ss = 0.f;
#pragma unroll
            for (int i = 0; i < 8; ++i) { s[i] = fa[i] + fb[i]; ss += s[i] * s[i]; }
#pragma unroll
            for (int of = 1; of < 32; of <<= 1) ss += __shfl_xor(ss, of);
            const float rstd = 1.0f / sqrtf(ss * (1.0f / DVH) + RMS_EPS);
            const f32x4 g0 = *(const f32x4*)(ng + c), g1 = *(const f32x4*)(ng + c + 4);
            float y[8];
#pragma unroll
            for (int i = 0; i < 8; ++i) { const float g = i < 4 ? g0[i] : g1[i - 4]; y[i] = s[i] * rstd * g * __builtin_amdgcn_rcpf(1.0f + __builtin_amdgcn_exp2f(-1.44269504f * fo[i])); }
            v4u w; w.x = pk2(y[0], y[1]); w.y = pk2(y[2], y[3]); w.z = pk2(y[4], y[5]); w.w = pk2(y[6], y[7]);
            *(v4u*)(Y + (size_t)r * D + c) = w; }
    }
}
__device__ __forceinline__ void convmix_phase(const bf16* BG, const bf16* Z, const float* cw, bf16* Y, int gw, int NGW, int lane) {
    for (int r = gw; r < MX; r += NGW) { const int t = r & 63;
#pragma unroll
        for (int q = 0; q < 4; ++q) { const int c = 8 * (lane + 64 * q);
            const v4u zero = (v4u){0u, 0u, 0u, 0u};
            const v4u zc = *(const v4u*)(Z + (size_t)r * D + c), zp = t > 0 ? *(const v4u*)(Z + (size_t)(r - 1) * D + c) : zero, zn = t < 63 ? *(const v4u*)(Z + (size_t)(r + 1) * D + c) : zero;
            const v4u bg = *(const v4u*)(BG + (size_t)r * D + c);
            float fc[8], fp[8], fn[8], fb[8]; unpack8(zc, fc); unpack8(zp, fp); unpack8(zn, fn); unpack8(bg, fb);
            float y[8];
#pragma unroll
            for (int h = 0; h < 2; ++h) { const f32x4 w0 = *(const f32x4*)(cw + c + 4 * h), w1 = *(const f32x4*)(cw + D + c + 4 * h), w2 = *(const f32x4*)(cw + 2 * D + c + 4 * h);
#pragma unroll
                for (int i = 0; i < 4; ++i) y[4 * h + i] = fb[4 * h + i] * (w0[i] * fp[4 * h + i] + w1[i] * fc[4 * h + i] + w2[i] * fn[4 * h + i]); }
            v4u w; w.x = pk2(y[0], y[1]); w.y = pk2(y[2], y[3]); w.z = pk2(y[4], y[5]); w.w = pk2(y[6], y[7]);
            *(v4u*)(Y + (size_t)r * D + c) = w; }
    }
}

__device__ __forceinline__ void mod_partials(const KArgs& a, int l, int wv, int nwv, int lane) {
    float* modp = (float*)(a.ws + WS_MODP);
    constexpr int NCG = MODW / 256, NKS = D / 64, NIT = NCG * NKS;
    for (int it = wv; it < NIT; it += nwv) {
        const int cg = it / NKS, ks = it - cg * NKS, k0 = 64 * ks, col = 256 * cg + 4 * lane;
        float sv[5];
#pragma unroll
        for (int b = 0; b < 5; ++b) { const float cv = (b < 4) ? a.in[1][b * D + k0 + lane] : a.in[3][k0 + lane]; sv[b] = pg8::silu_f(cv); }
        f32x4 acc[5];
#pragma unroll
        for (int b = 0; b < 5; ++b) acc[b] = (f32x4){0.f, 0.f, 0.f, 0.f};
        const float* wp = a.in[4] + ((size_t)l * D + k0) * MODW + col;
#pragma unroll 8
        for (int k = 0; k < 64; ++k) { const f32x4 w = *(const f32x4*)(wp + (size_t)k * MODW);
#pragma unroll
            for (int b = 0; b < 5; ++b) { const float s = __builtin_bit_cast(float, __builtin_amdgcn_readlane(__builtin_bit_cast(int, sv[b]), k)); acc[b] += w * s; } }
#pragma unroll
        for (int b = 0; b < 5; ++b) *(f32x4*)(modp + (((size_t)ks * 2 + l) * 5 + b) * MODW + col) = acc[b];
    }
}
template <int LIST> __device__ __forceinline__ void convert_list(const KArgs& a, LAS unsigned char* lds, int wv, int nwv, int wave, int lane) {
    unsigned char* ws = a.ws;
    LAS float* scr = (LAS float*)(lds + wave * (64 * 65 * 4));
    const float* mod = (const float*)(ws + WS_MOD); float* bp = (float*)(ws + WS_BIASP);
    constexpr int I_FI = (D / 64) * (NFI / 64), I_FO = (DFF / 64) * (D / 64), I_MI = (D / 64) * (NML / 64), I_SQ = (D / 64) * (D / 64), I_CI = (D / 64) * (NCV / 64);
    if (LIST == 0) {
        for (int it = wv; it < I_FI + I_FO; it += nwv) { int r = it;
            if (r < I_FI) { transpose_item<1>(a.in[7], D, NFI, (bf16*)(ws + WS_WFI), NFI / 64, scr, r, lane); continue; } r -= I_FI;
            transpose_item<0>(a.in[8], DFF, D, (bf16*)(ws + WS_WFO), D / 64, scr, r, lane); }
    } else if (LIST == 1) {
        for (int it = wv; it < I_MI + I_SQ; it += nwv) { int r = it;
            if (r < I_MI) { transpose_item<2, true>(a.in[9], D, NMLSRC, (bf16*)(ws + WS_WMI), NML / 64, scr, r, lane, mod + 3 * D, bp + BOFF_MI); continue; } r -= I_MI;
            transpose_item<0>(a.in[12], D, D, (bf16*)(ws + WS_WMO), D / 64, scr, r, lane); }
    } else {
        for (int it = wv; it < 3 * I_FI + 3 * I_FO + I_CI + I_SQ; it += nwv) { int r = it;
            if (r < 3 * I_FI) { const int mi = 1 + r / I_FI; r -= (mi - 1) * I_FI;
                const float* sh = mi == 1 ? mod + 6 * D : (mi == 2 ? mod + (size_t)5 * MODW : mod + (size_t)5 * MODW + 6 * D); float* bq = bp + (mi == 1 ? BOFF_F1 : (mi == 2 ? BOFF_F2 : BOFF_F3));
                transpose_item<1, true>(a.in[7] + (size_t)mi * D * NFI, D, NFI, (bf16*)(ws + WS_WFI) + (size_t)mi * NFI * D, NFI / 64, scr, r, lane, sh, bq); continue; } r -= 3 * I_FI;
            if (r < 3 * I_FO) { const int mi = 1 + r / I_FO; r -= (mi - 1) * I_FO; transpose_item<0>(a.in[8] + (size_t)mi * DFF * D, DFF, D, (bf16*)(ws + WS_WFO) + (size_t)mi * D * DFF, D / 64, scr, r, lane); continue; } r -= 3 * I_FO;
            if (r < I_CI) { transpose_item<3, true>(a.in[13], D, NCV, (bf16*)(ws + WS_WCI), NCV / 64, scr, r, lane, mod + (size_t)5 * MODW + 3 * D, bp + BOFF_CI); continue; } r -= I_CI;
            transpose_item<0>(a.in[15], D, D, (bf16*)(ws + WS_WCO), D / 64, scr, r, lane); }
    }
}
__device__ __forceinline__ bool tail_rank(int nwg, int G, int bx, int& rank, int& cnt) { const int rem = nwg % G; if (rem == 0) { rank = bx; cnt = G; return true; } rank = bx - rem; cnt = G - rem; return bx >= rem; }

__device__ __forceinline__ void modreduce_phase(const float* modp, const float* bmod, const float* normg, float* mod, float* gs, int l, int gtid, int NGT) {
    constexpr int NV = 5 * MODW / 4;
    for (int i = gtid; i < NV; i += NGT) { const int b = i / (MODW / 4), c4 = i - b * (MODW / 4), lb = l * 5 + b;
        f32x4 s = *(const f32x4*)(bmod + (size_t)l * MODW + 4 * c4);
        for (int ks = 0; ks < D / 64; ++ks) s += *(const f32x4*)(modp + ((size_t)ks * 10 + lb) * MODW + 4 * c4);
        *(f32x4*)(mod + (size_t)lb * MODW + 4 * c4) = s;
        const int seg = (4 * c4) / D, col = 4 * c4 - seg * D;
        if (seg % 3 == 1) { const int j = seg / 3; *(f32x4*)(gs + ((size_t)(l * 3 + j) * 5 + b) * D + col) = *(const f32x4*)(normg + (size_t)(l * 3 + j) * D + col) * (s + 1.0f); } }
}
__device__ __forceinline__ void rowstat_phase(const float* SS, float* rstd, bool ctx_ones, int gtid, int NGT) {
    for (int r = gtid; r < MX; r += NGT) { float t = 0.f;
#pragma unroll
        for (int q = 0; q < 8; ++q) { const f32x4 v = *(const f32x4*)(SS + (size_t)r * 32 + 4 * q); t += (v[0] + v[1]) + (v[2] + v[3]); }
        rstd[r] = 1.0f / sqrtf(t * (1.0f / D) + RMS_EPS); }
    if (ctx_ones) for (int r = MX + gtid; r < MT; r += NGT) rstd[r] = 1.0f;
}
__device__ __forceinline__ void biasreduce_phase(const float* biasp, float* bias, int gtid, int NGT) {
    constexpr int NV = NBCOL / 4;
    for (int i = gtid; i < 6 * NV; i += NGT) { const int b = i / NV, c4 = i - b * NV; f32x4 s = (f32x4){0.f, 0.f, 0.f, 0.f};
        if (b < 5) for (int kb = 0; kb < D / 64; ++kb) s += *(const f32x4*)(biasp + ((size_t)kb * 5 + b) * NBCOL + 4 * c4);
        *(f32x4*)(bias + (size_t)b * NBCOL + 4 * c4) = s; }
}

constexpr int SQ_OFF = 0, SK_OFF = 17408, SKW_OFF = 34816, SV_OFF = 52224, SCB_OFF = 63488, SP_OFF = 85248, STAB_OFF = 94464, SCH_OFF = 146688;
constexpr int QSTR = 272, VSTR = 176, PSTR = 144, CBSZ = 21760, NTOK = 68 * 64;
static_assert(SCH_OFF + 4 * 68 * 4 <= LDSCTL_OFF, "scan LDS");

#define SCAN_BAR() do { asm volatile("s_waitcnt lgkmcnt(0)" ::: "memory"); __builtin_amdgcn_s_barrier(); asm volatile("" ::: "memory"); } while (0)
__device__ __forceinline__ bf16x8 tr_frag(LAS unsigned char* p0, LAS unsigned char* p1) {
    const s16x4 a = __builtin_amdgcn_ds_read_tr16_b64_v4i16((LAS s16x4*)p0), b = __builtin_amdgcn_ds_read_tr16_b64_v4i16((LAS s16x4*)p1);
    return (bf16x8){a[0], a[1], a[2], a[3], b[0], b[1], b[2], b[3]};
}
__device__ __forceinline__ float fexp(float x) { return __builtin_amdgcn_exp2f(1.44269504f * x); }

template <int PROBE> __device__ __forceinline__ void scan_phase(LAS unsigned char* lds, const bf16* QKVO, const float* GATES, bf16* HF, bf16* HBW, int vcu, int G, int tid, int lane, int wave) {
    const int fr = lane & 15, fq = lane >> 4, tq = (lane & 15) >> 2, tp = lane & 3;
    LAS float* cjA = (LAS float*)(lds + STAB_OFF); LAS float* cmA = cjA + NTOK; LAS float* bsA = cmA + NTOK;
    LAS float* chM = (LAS float*)(lds + SCH_OFF); LAS float* chML = chM + 68; LAS float* chBE = chML + 68; LAS float* chMC = chBE + 68;
    for (int u = vcu; u < 256; u += G) {
        const int sl = u & 3, dir = (u >> 2) & 1, h = (u >> 3) & 7, b = u >> 6, e0 = 64 * sl;
        bf16* HO = dir ? HBW : HF;
        const int prow = tid >> 4, pch = tid & 15, vrow = tid >> 3, vch = tid & 7;
        auto row_of = [&](int st) { const bool isc = st < 4; const int ci = isc ? st : st - 4, n = isc ? 4 : 64, ch = dir ? (n - 1 - ci) : ci; return (isc ? MX + b * CTXL : b * SEQ) + ch * 64; };
        f32x4 Cacc[5];
#pragma unroll
        for (int e = 0; e < 5; ++e) Cacc[e] = (f32x4){0.f, 0.f, 0.f, 0.f};
        SCAN_BAR();
        {
            float gi[9], gf[9];
#pragma unroll
            for (int q = 0; q < 9; ++q) { const int st = wave + NWAVES * q; if (st < 68) { const float* gp = GATES + (size_t)(row_of(st) + lane) * 32 + (2 * dir) * 8 + h; gi[q] = gp[0]; gf[q] = gp[8]; } else { gi[q] = 0.f; gf[q] = 0.f; } }
#pragma unroll
            for (int q = 0; q < 9; ++q) { const int st = wave + NWAVES * q; if (st < 68) {
                const float ax = fabsf(gf[q]), ee = fexp(-ax), l1p = (ee < 1e-3f) ? ee * (1.0f - 0.5f * ee) : __logf(1.0f + ee);
                const float f = fminf(gf[q], 0.f) - l1p;
                float bs = f;
#pragma unroll
                for (int o = 1; o < 64; o <<= 1) { const float t = dir ? __shfl_down(bs, o) : __shfl_up(bs, o); const bool ok = dir ? (lane + o < 64) : (lane >= o); bs += ok ? t : 0.f; }
                const float cj = gi[q] - bs; float cm = cj;
#pragma unroll
                for (int o = 1; o < 64; o <<= 1) { const float t = dir ? __shfl_down(cm, o) : __shfl_up(cm, o); const bool ok = dir ? (lane + o < 64) : (lane >= o); cm = ok ? fmaxf(cm, t) : cm; }
                cjA[st * 64 + lane] = cj; cmA[st * 64 + lane] = cm; bsA[st * 64 + lane] = bs;
                if (lane == (dir ? 0 : 63)) { chBE[st] = bs; chMC[st] = cm; } } }
        }
        for (int i = tid; i < CBSZ / 16; i += 512) *(LAS v4u*)(lds + SCB_OFF + 16 * i) = (v4u){0u, 0u, 0u, 0u};
        if (tid < 128) { const int r = tid >> 1; *(LAS v4u*)(lds + SV_OFF + r * VSTR + (8 + (tid & 1)) * 16) = (tid & 1) ? (v4u){0u, 0u, 0u, 0u} : (v4u){0x3F80u, 0u, 0u, 0u}; }
        v4u rq[4][2], rk[4][2], rv[2];
        auto load_qk = [&](int st, v4u (&q)[2], v4u (&k)[2]) { if (st < 68 && (PROBE != 1 || st < 5)) { const int row0 = row_of(st);
#pragma unroll
            for (int i = 0; i < 2; ++i) { const bf16* p = QKVO + (size_t)(row0 + prow + 32 * i) * 6144 + h * DKH + pch * 8; q[i] = *(const v4u*)p; k[i] = *(const v4u*)(p + 1024); } } };
        auto load_v = [&](int st, v4u& v) { if (st < 68 && (PROBE != 1 || st < 2)) v = *(const v4u*)(QKVO + (size_t)(row_of(st) + vrow) * 6144 + 2048 + h * DVH + e0 + vch * 8); };
        { v4u q0[2], k0[2];
          load_qk(0, q0, k0); load_qk(1, rq[1], rk[1]); load_qk(2, rq[2], rk[2]); load_qk(3, rq[3], rk[3]); load_qk(4, rq[0], rk[0]);
          load_v(0, rv[0]); load_v(1, rv[1]);
#pragma unroll
          for (int i = 0; i < 2; ++i) { *(LAS v4u*)(lds + SQ_OFF + (prow + 32 * i) * QSTR + pch * 16) = q0[i]; *(LAS v4u*)(lds + SK_OFF + (prow + 32 * i) * QSTR + pch * 16) = k0[i]; } }
        SCAN_BAR();
        if (tid == 0) { float m = -1e30f; for (int st = 0; st < 68; ++st) { chM[st] = m; const float ML = fmaxf(m, chMC[st]); chML[st] = ML; m = chBE[st] + ML; } }
        SCAN_BAR();
        const int sb = wave & 3, hf = wave >> 2, s_pos = 16 * sb + fr;
        auto step = [&](const int st, const bool isc, v4u (&RQ)[2], v4u (&RK)[2], v4u& RV) {
            const float m_t = chM[st], ML_t = chML[st];
#pragma unroll
            for (int i = 0; i < 2; ++i) { const int r = prow + 32 * i; const float wj = fexp(cjA[st * 64 + r] - ML_t);
                const v4u kraw = *(const LAS v4u*)(lds + SK_OFF + r * QSTR + pch * 16);
                float kf[8]; unpack8(kraw, kf); v4u kw; kw.x = pk2(kf[0] * wj, kf[1] * wj); kw.y = pk2(kf[2] * wj, kf[3] * wj); kw.z = pk2(kf[4] * wj, kf[5] * wj); kw.w = pk2(kf[6] * wj, kf[7] * wj);
                *(LAS v4u*)(lds + SKW_OFF + r * QSTR + pch * 16) = kw; }
            *(LAS v4u*)(lds + SV_OFF + vrow * VSTR + vch * 16) = RV;
            load_v(st + 2, RV);
            f32x4 a2[3]; float Ms = 0.f;
            if (!isc) {
                bf16x8 Yq[4];
#pragma unroll
                for (int ks = 0; ks < 4; ++ks) Yq[ks] = *(const LAS bf16x8*)(lds + SQ_OFF + s_pos * QSTR + (32 * ks + 8 * fq) * 2);
                Ms = fmaxf(m_t, cmA[st * 64 + s_pos]);
#pragma unroll
                for (int jj = 0; jj < 2; ++jj) { const int jb = 2 * hf + jj; f32x4 sacc = (f32x4){0.f, 0.f, 0.f, 0.f};
#pragma unroll
                    for (int ks = 0; ks < 4; ++ks) { const bf16x8 Xk = *(const LAS bf16x8*)(lds + SK_OFF + (16 * jb + fr) * QSTR + (32 * ks + 8 * fq) * 2);
                        sacc = __builtin_amdgcn_mfma_f32_16x16x32_bf16(Xk, Yq[ks], sacc, 0, 0, 0); }
                    const f32x4 c4 = *(const LAS f32x4*)(cjA + st * 64 + 16 * jb + 4 * fq); float p[4];
#pragma unroll
                    for (int r = 0; r < 4; ++r) { const int j_pos = 16 * jb + 4 * fq + r; const bool ok = dir ? (j_pos >= s_pos) : (j_pos <= s_pos); p[r] = sacc[r] * fexp(ok ? (c4[r] - Ms) : -1e30f); }
                    v2u pw; pw.x = pk2(p[0], p[1]); pw.y = pk2(p[2], p[3]);
                    *(LAS v2u*)(lds + SP_OFF + s_pos * PSTR + (16 * jb + 4 * fq) * 2) = pw; }
#pragma unroll
                for (int ti = 0; ti < 3; ++ti) { const int e = (ti == 2) ? 4 : 2 * hf + ti; a2[ti] = (f32x4){0.f, 0.f, 0.f, 0.f};
#pragma unroll
                    for (int ks = 0; ks < 4; ++ks) { const bf16x8 Xc = *(const LAS bf16x8*)(lds + SCB_OFF + (16 * e + fr) * QSTR + (32 * ks + 8 * fq) * 2);
                        a2[ti] = __builtin_amdgcn_mfma_f32_16x16x32_bf16(Xc, Yq[ks], a2[ti], 0, 0, 0); } }
            }
            SCAN_BAR();
            {
                const float decay = fexp(m_t - ML_t);
                bf16x8 Xkw[2], Yp[2];
#pragma unroll
                for (int ks = 0; ks < 2; ++ks) { LAS unsigned char* p = lds + SKW_OFF + (32 * ks + 8 * fq + tq) * QSTR + (16 * wave + 4 * tp) * 2; Xkw[ks] = tr_frag(p, p + 4 * QSTR); }
                if (!isc) {
#pragma unroll
                    for (int ks = 0; ks < 2; ++ks) Yp[ks] = *(const LAS bf16x8*)(lds + SP_OFF + s_pos * PSTR + (32 * ks + 8 * fq) * 2);
                }
                f32x4 o[3];
#pragma unroll
                for (int e = 0; e < 5; ++e) { bf16x8 Yv[2];
#pragma unroll
                    for (int ks = 0; ks < 2; ++ks) { LAS unsigned char* p = lds + SV_OFF + (32 * ks + 8 * fq + tq) * VSTR + (16 * e + 4 * tp) * 2; Yv[ks] = tr_frag(p, p + 4 * VSTR); }
                    if (!isc && (e == 4 || hf == (e >> 1))) { const int ti = (e == 4) ? 2 : (e & 1); f32x4 a1 = (f32x4){0.f, 0.f, 0.f, 0.f};
#pragma unroll
                        for (int ks = 0; ks < 2; ++ks) a1 = __builtin_amdgcn_mfma_f32_16x16x32_bf16(Yv[ks], Yp[ks], a1, 0, 0, 0);
                        o[ti] = a1; }
                    Cacc[e] = Cacc[e] * decay;
#pragma unroll
                    for (int ks = 0; ks < 2; ++ks) Cacc[e] = __builtin_amdgcn_mfma_f32_16x16x32_bf16(Xkw[ks], Yv[ks], Cacc[e], 0, 0, 0);
                    v2u cw; cw.x = pk2(Cacc[e][0], Cacc[e][1]); cw.y = pk2(Cacc[e][2], Cacc[e][3]);
                    *(LAS v2u*)(lds + SCB_OFF + (16 * e + fr) * QSTR + (16 * wave + 4 * fq) * 2) = cw; }
                if (!isc) {
                    const float wint = fexp(m_t - Ms), hden = fexp(-(bsA[st * 64 + s_pos] + Ms));
#pragma unroll
                    for (int ti = 0; ti < 3; ++ti) o[ti] = o[ti] + a2[ti] * wint;
                    const float den = __shfl(o[2][0], fr);
                    const float inv = 1.0f / fmaxf(fabsf(den), hden);
                    const int orow = row_of(st) + s_pos;
#pragma unroll
                    for (int ti = 0; ti < 2; ++ti) { const int e = 2 * hf + ti; const f32x4 hv = o[ti] * inv; v2u w; w.x = pk2(hv[0], hv[1]); w.y = pk2(hv[2], hv[3]);
                        *(v2u*)(HO + (size_t)orow * D + h * DVH + e0 + 16 * e + 4 * fq) = w; }
                }
                if (st + 1 < 68) {
#pragma unroll
                    for (int i = 0; i < 2; ++i) { *(LAS v4u*)(lds + SQ_OFF + (prow + 32 * i) * QSTR + pch * 16) = RQ[i]; *(LAS v4u*)(lds + SK_OFF + (prow + 32 * i) * QSTR + pch * 16) = RK[i]; }
                    load_qk(st + 5, RQ, RK);
                }
            }
            SCAN_BAR();
        };
        for (int g = 0; g < 17; ++g) { const bool isc = (g == 0); const int st = 4 * g;
            step(st, isc, rq[1], rk[1], rv[0]); step(st + 1, isc, rq[2], rk[2], rv[1]); step(st + 2, isc, rq[3], rk[3], rv[0]); step(st + 3, isc, rq[0], rk[0], rv[1]); }
    }
}

constexpr int NPHASES = 24;
__global__ void __launch_bounds__(NWAVES * 64, 2) fwd_kernel(KArgs a) {
    extern __shared__ __attribute__((aligned(16))) unsigned char lds_raw[];
    LAS unsigned char* lds = (LAS unsigned char*)lds_raw;
    const int tid = threadIdx.x, lane = tid & 63, wave = __builtin_amdgcn_readfirstlane(tid >> 6);
    const int G = gridDim.x, bx = blockIdx.x, vcu = (G % 8 == 0) ? (bx % 8) * (G / 8) + bx / 8 : bx;
    const int gw = vcu * NWAVES + wave, NGW = G * NWAVES;
    unsigned char* ws = a.ws;
    unsigned* ctl = (unsigned*)(ws + WS_CTL);
    volatile LAS unsigned* MISC = (volatile LAS unsigned*)(lds + LDSCTL_OFF);
    for (int u = tid; u < (LDS_BYTES - LDSCTL_OFF) / 4; u += NWAVES * 64) ((LAS unsigned*)(lds + LDSCTL_OFF))[u] = 0u;
    __syncthreads();
    XcdBarrier bar; bar.bar = ctl + CW_BAR; bar.x = 0; bar.st = nullptr;
#if !MK_PER_PHASE
    bar = xcd_barrier_post(ctl + CW_BAR, MISC + 8);
#endif
    const int lo = a.ph_lo, hi = a.ph_hi;
#define IN(k) (lo <= (k) && (k) < hi)
#if MK_PER_PHASE
#define SEAM(k) do { } while (0)
#else
#define SEAM(k) do { if (IN(k) && IN((k) + 1)) xcd_barrier(bar); } while (0)
#endif
#define x_in (a.in[0])
#define ctx_in (a.in[2])
#define X ((float*)(ws + WS_X))
#define HB ((bf16*)(ws + WS_HB))
#define ACT ((bf16*)(ws + WS_ACT))
#define QKVO ((bf16*)(ws + WS_QKVO))
#define GATES ((float*)(ws + WS_GATES))
#define HF ((bf16*)(ws + WS_HF))
#define HBW ((bf16*)(ws + WS_HBW))
#define mod ((const float*)(ws + WS_MOD))
#define WFI ((const bf16*)(ws + WS_WFI))
#define WFO ((const bf16*)(ws + WS_WFO))
#define normg (a.in[6])
#define GS ((float*)(ws + WS_GS))
#define SS ((float*)(ws + WS_SS))
#define RSTD ((float*)(ws + WS_RSTD))
#define BIAS ((float*)(ws + WS_BIAS))
#define YB ((bf16*)(ws + WS_ACT))
#define BG ((bf16*)(ws + WS_QKVO))
#define ZB ((bf16*)(ws + WS_QKVO) + (size_t)MX * D)
    const int gtid = bx * NWAVES * 64 + tid, NGT = G * NWAVES * 64;
    if (IN(0)) { mod_partials(a, 0, gw, NGW, lane); mod_partials(a, 1, gw, NGW, lane); convert_list<0>(a, lds, gw, NGW, wave, lane); }
    SEAM(0);
    if (IN(1)) { modreduce_phase((const float*)(ws + WS_MODP), a.in[5], normg, (float*)(ws + WS_MOD), GS, 0, gtid, NGT); modreduce_phase((const float*)(ws + WS_MODP), a.in[5], normg, (float*)(ws + WS_MOD), GS, 1, gtid, NGT); }
    SEAM(1);
#define FFN_UP(p, wi, rows, FOLDV, boff) do { if (IN(p)) { pg8::Gemm g{HB, WFI + (size_t)(wi) * NFI * D, rows, NFI, D}; pg8::StaticOrder S; S.init(rows, NFI, G, bx, D); \
        pg8::EpiSwigluT<FOLDV> E{ACT, DFF, pg8::Fold{ws, (boff)}}; pg8::gemm_phase<pg8::EpiSwigluT<FOLDV>, pg8::StaticOrder, true, true>(lds, g, S, E); } SEAM(p); } while (0)
#define FFN_DOWN(p, wi, l, j, xsx, xsc, NEXTV, nsub) do { if (IN(p)) { pg8::Gemm g{ACT, WFO + (size_t)(wi) * D * DFF, MX, D, DFF}; pg8::StaticOrder S; S.init(MX, D, G, bx, DFF, 4); \
        pg8::EpiResidT<NEXTV, true> E{xsx, xsc, ws, (l) * 5 * MODW + (3 * (j) + 2) * D, (nsub)}; \
        pg8::gemm_phase<pg8::EpiResidT<NEXTV, true>, pg8::StaticOrder, true, true>(lds, g, S, E); } } while (0)

    if (IN(2)) normmod_phase(x_in, ctx_in, MT, normg + (0 * 3 + 0) * D, mod, 0, HB, gw, NGW, lane);
    SEAM(2);
    FFN_UP(3, 0, MT, false, 0);
    if (IN(4)) { FFN_DOWN(4, 0, 0, 0, x_in, ctx_in, true, 1);
        { pg8::Gemm g{ACT, WFO, MT, D, DFF}; pg8::SplitKOrder S{G, bx, MX / 256};
          pg8::EpiPartial E{(float*)(ws + WS_CTXP), MX, (size_t)MC * D};
          pg8::gemm_phase<pg8::EpiPartial, pg8::SplitKOrder, true, true>(lds, g, S, E); } }
    SEAM(4);
    if (IN(4)) { convert_list<1>(a, lds, gw, NGW, wave, lane); convert_list<2>(a, lds, gw, NGW, wave, lane); if (IN(5)) xcd_barrier(bar); }
    if (IN(5)) { rowstat_phase(SS, RSTD, true, gtid, NGT); biasreduce_phase((const float*)(ws + WS_BIASP), BIAS, gtid, NGT);
        normmod_phase(X, ctx_in, MT, normg + (0 * 3 + 1) * D, mod, 1, HB, gw, NGW, lane, (const float*)(ws + WS_CTXP), mod + (size_t)4 * MODW + (3 * 0 + 2) * D, MX); }
    SEAM(5);
    if (IN(6)) { pg8::Gemm g{HB, (const bf16*)(ws + WS_WMI), MT, NML, D}; pg8::StaticOrder S; S.init(MT, NML, G, bx, D); pg8::EpiMlstmInT<true> E{QKVO, GATES, a.in[10], pg8::Fold{ws, BOFF_MI}};
        pg8::gemm_phase<pg8::EpiMlstmInT<true>, pg8::StaticOrder, true, true>(lds, g, S, E); }
    SEAM(6);
    if (PROBE_DUP == 6) { pg8::Gemm g{HB, (const bf16*)(ws + WS_WMI), MT, NML, D}; pg8::StaticOrder S; S.init(MT, NML, G, bx, D); pg8::EpiMlstmInT<true> E{QKVO, GATES, a.in[10], pg8::Fold{ws, BOFF_MI}};
        pg8::gemm_phase<pg8::EpiMlstmInT<true>, pg8::StaticOrder, true, true>(lds, g, S, E); xcd_barrier(bar); }
    if (IN(7)) scan_phase<0>(lds, QKVO, GATES, HF, HBW, vcu, G, tid, lane, wave);
    SEAM(7);
    if (IN(8)) headnorm_phase(HF, HBW, QKVO, a.in[11], YB, gw, NGW, lane);
    SEAM(8);
    if (PROBE_DUP == 8) { headnorm_phase(HF, HBW, QKVO, a.in[11], YB, gw, NGW, lane); xcd_barrier(bar); }
    if (IN(9)) { pg8::Gemm g{YB, (const bf16*)(ws + WS_WMO), MX, D, D}; pg8::StaticOrder S; S.init(MX, D, G, bx, D, 4);
        pg8::EpiResidT<true, false> E{X, X, ws, (3 * 1 + 2) * D, 2};
        pg8::gemm_phase<pg8::EpiResidT<true, false>, pg8::StaticOrder, true, true>(lds, g, S, E); }
    SEAM(9);
    if (IN(10)) rowstat_phase(SS, RSTD, false, gtid, NGT);
    SEAM(10);
    FFN_UP(11, 1, MX, true, BOFF_F1);
    FFN_DOWN(12, 1, 0, 2, X, X, true, 3); SEAM(12);
    if (PROBE_DUP == 12) { pg8::Gemm g{ACT, WFO + (size_t)1 * D * DFF, MX, D, DFF}; pg8::StaticOrder S; S.init(MX, D, G, bx, DFF); pg8::EpiPartial E{(float*)(ws + WS_QKVO), 0, (size_t)0};
        pg8::gemm_phase<pg8::EpiPartial, pg8::StaticOrder, true, true>(lds, g, S, E); xcd_barrier(bar); }
    if (IN(13)) rowstat_phase(SS, RSTD, false, gtid, NGT);
    SEAM(13);
    FFN_UP(14, 2, MX, true, BOFF_F2);
    FFN_DOWN(15, 2, 1, 0, X, X, true, 4); SEAM(15);
    if (IN(16)) rowstat_phase(SS, RSTD, false, gtid, NGT);
    SEAM(16);
    if (IN(17)) { pg8::Gemm g{HB, (const bf16*)(ws + WS_WCI), MX, NCV, D}; pg8::StaticOrder S; S.init(MX, NCV, G, bx, D); pg8::EpiConvInT<true> E{BG, ZB, pg8::Fold{ws, BOFF_CI}};
        pg8::gemm_phase<pg8::EpiConvInT<true>, pg8::StaticOrder, true, true>(lds, g, S, E); }
    SEAM(17);
    if (IN(18)) convmix_phase(BG, ZB, a.in[14], YB, gw, NGW, lane);
    SEAM(18);
    if (IN(19)) { pg8::Gemm g{YB, (const bf16*)(ws + WS_WCO), MX, D, D}; pg8::StaticOrder S; S.init(MX, D, G, bx, D, 4);
        pg8::EpiResidT<true, false> E{X, X, ws, 5 * MODW + (3 * 1 + 2) * D, 5};
        pg8::gemm_phase<pg8::EpiResidT<true, false>, pg8::StaticOrder, true, true>(lds, g, S, E); }
    SEAM(19);
    if (IN(20)) rowstat_phase(SS, RSTD, false, gtid, NGT);
    SEAM(20);
    FFN_UP(21, 3, MX, true, BOFF_F3);
    FFN_DOWN(22, 3, 1, 2, X, X, false, 0); SEAM(22);
    if (IN(23)) final_norm_phase(X, a.in[16], a.out, gw, NGW, lane);
#undef FFN_UP
#undef FFN_DOWN
#undef x_in
#undef ctx_in
#undef X
#undef HB
#undef ACT
#undef QKVO
#undef GATES
#undef HF
#undef HBW
#undef mod
#undef WFI
#undef WFO
#undef normg
#undef GS
#undef SS
#undef RSTD
#undef BIAS
#undef YB
#undef BG
#undef ZB
#undef IN
#undef SEAM
}

extern "C" void kernel_launch(void* const* d_in, const int* in_sizes, int n_in, void* d_out, int out_size, void* d_ws, size_t ws_size, hipStream_t stream) {
    static int grid = 0;
    if (grid == 0) {
        if (n_in != 17 || in_sizes[0] != MX * D || out_size != MX * D || ws_size < WS_END) { fprintf(stderr, "kernel_launch: unexpected shapes (n_in %d, in0 %d, out %d, ws %zu)\n", n_in, n_in > 0 ? in_sizes[0] : -1, out_size, ws_size); grid = -1; return; }
        int dev = 0, cus = 0, per_cu = 0;
        if (hipGetDevice(&dev) != hipSuccess || hipDeviceGetAttribute(&cus, hipDeviceAttributeMultiprocessorCount, dev) != hipSuccess) { fprintf(stderr, "kernel_launch: device query failed\n"); grid = -1; return; }
        if (hipFuncSetAttribute((const void*)fwd_kernel, hipFuncAttributeMaxDynamicSharedMemorySize, LDS_BYTES) != hipSuccess) { fprintf(stderr, "kernel_launch: hipFuncSetAttribute failed\n"); grid = -1; return; }
        if (hipOccupancyMaxActiveBlocksPerMultiprocessor(&per_cu, (const void*)fwd_kernel, NWAVES * 64, LDS_BYTES) != hipSuccess || per_cu < 1) { fprintf(stderr, "kernel_launch: occupancy query reports %d workgroups per CU\n", per_cu); }
        (void)hipGetLastError();
        grid = cus;
    }
    if (grid < 0) return;
    if (hipMemsetAsync((char*)d_ws + WS_CTL, 0, CTL_ZERO_BYTES, stream) != hipSuccess) { fprintf(stderr, "kernel_launch: memset failed\n"); return; }
    KArgs a{};
    for (int i = 0; i < 17; ++i) a.in[i] = (const float*)d_in[i];
    a.out = (float*)d_out; a.ws = (unsigned char*)d_ws;
#if MK_PER_PHASE
    for (int p = 0; p < NPHASES; ++p) { a.ph_lo = p; a.ph_hi = p + 1; hipLaunchKernelGGL(fwd_kernel, dim3(grid), dim3(NWAVES * 64), LDS_BYTES, stream, a); }
#else
    a.ph_lo = 0; a.ph_hi = NPHASES;
    hipLaunchKernelGGL(fwd_kernel, dim3(grid), dim3(NWAVES * 64), LDS_BYTES, stream, a);
#endif
    const hipError_t le = hipPeekAtLastError();
    if (le != hipSuccess) fprintf(stderr, "kernel_launch: launch failed: %s\n", hipGetErrorName(le));
}
```

```cpp
#include <hip/hip_runtime.h>
#include <cstdio>
#include <cstdint>

#ifndef PROBE_DUP
#define PROBE_DUP -1
#endif
#ifndef TAILS
#define TAILS 0
#endif
#ifndef MK_PER_PHASE
#define MK_PER_PHASE 0
#endif

constexpr int NWAVES = 8;
constexpr int BATCH = 4, SEQ = 4096, D = 2048, CTXL = 256, NH = 8, DKH = 128, DVH = 256, DFF = 5504;
constexpr int MX = BATCH * SEQ, MC = BATCH * CTXL, MT = MX + MC;
constexpr int NFI = 2 * DFF;
constexpr int NML = 6400, NMLSRC = 6176, NCV = 6144;
constexpr int MODW = 9 * D;
constexpr float RMS_EPS = 1e-6f;

constexpr size_t MiB = 1u << 20;
constexpr size_t WS_CTL = 0, CTL_ZERO_BYTES = 2 * MiB;
constexpr size_t WS_MOD = 1 * MiB;
constexpr size_t WS_WFI = 2 * MiB;
constexpr size_t WS_WFO = 174 * MiB;
constexpr size_t WS_WMI = 260 * MiB;
constexpr size_t WS_WMO = 285 * MiB;
constexpr size_t WS_WCI = 293 * MiB;
constexpr size_t WS_WCO = 317 * MiB;
constexpr size_t WS_X = 326 * MiB;
constexpr size_t WS_HB = 462 * MiB;
constexpr size_t WS_ACT = 530 * MiB;
constexpr size_t WS_QKVO = 713 * MiB;
constexpr size_t WS_GATES = 917 * MiB;
constexpr size_t WS_HF = 920 * MiB, WS_HBW = 984 * MiB;
constexpr size_t WS_MODP = WS_HF;
constexpr size_t WS_CTXP = 1048 * MiB;
constexpr int NBCOL = 45568;
constexpr int BOFF_MI = 0, BOFF_F1 = 6400, BOFF_F2 = 17408, BOFF_CI = 28416, BOFF_F3 = 34560;
constexpr size_t WS_BIASP = 1112 * MiB;
constexpr size_t WS_BIAS = 1142 * MiB;
constexpr size_t WS_GS = 1144 * MiB;
constexpr size_t WS_RGS = 1144 * MiB + 512 * 1024;
constexpr size_t WS_SS = 1145 * MiB;
constexpr size_t WS_RSTD = 1148 * MiB;
constexpr size_t WS_END = 1149 * MiB;
constexpr int CW_BAR = 4096;

namespace pg8 {
#define PG8_LAS __attribute__((address_space(3)))
typedef unsigned short bf16_t;
typedef short bf16x8 __attribute__((ext_vector_type(8)));
typedef float f32x4 __attribute__((ext_vector_type(4)));
typedef unsigned u32x4 __attribute__((ext_vector_type(4)));
constexpr int BM = 256, BK = 64, HALF = 128, HTB = HALF * BK * 2, STAGE_BYTES = 8 * HTB, NXCD = 8, WGM = 8;

__host__ __device__ __forceinline__ int lds_byte(int r, int c) { const int st = (r >> 4) * 2 + (c >> 5), rr = r & 15, cc = c & 31, ob = rr * 64 + cc * 2; return st * 1024 + (ob ^ (((ob >> 9) & 1) << 5)); }
__host__ __device__ __forceinline__ void stage_rc(int b, int& R, int& C) { const int st = b / 1024, sb = b % 1024, swz = sb ^ (((sb >> 9) & 1) << 5); R = (st >> 1) * 16 + swz / 64; C = (st & 1) * 32 + (swz % 64) / 2; }
__host__ __device__ __forceinline__ int perm32(int rho) { const int n = rho >> 4, i = rho & 15; return 8 * (i >> 2) + 4 * n + (i & 3); }

struct Unit { int pm, pn, k0, nt; };
struct Gemm { const bf16_t* A; const bf16_t* Bt; int M, N, K; };

struct StaticOrder {
    int nM, nN, nwg, G, c, ntk, wgm;
    __host__ __device__ void init(int M, int N, int G_, int c_, int K_, int wgm_ = WGM) { nM = M / BM; nN = N / BM; nwg = nM * nN; G = G_; c = c_; ntk = K_ / BK; wgm = wgm_; }
    __host__ __device__ bool next(int i, Unit& u) const {
        const long L = (long)i * G + c; if (L >= nwg) return false;
        int wgid = (int)L; { const int q = nwg / NXCD, r = nwg % NXCD, xcd = wgid % NXCD, off = wgid / NXCD; wgid = (xcd < r ? xcd * (q + 1) : r * (q + 1) + (xcd - r) * q) + off; }
        const int nig = wgm * nN, gid = wgid / nig, fm = gid * wgm, gsz = (nM - fm) < wgm ? (nM - fm) : wgm;
        u.pm = fm + ((wgid % nig) % gsz); u.pn = (wgid % nig) / gsz; u.k0 = 0; u.nt = ntk; return true;
    }
    __device__ __forceinline__ void a_ready(const Unit&) const {}
    __device__ __forceinline__ void done(const Unit&) const {}
};

typedef __bf16 bf16x2_t __attribute__((ext_vector_type(2)));
typedef float f32x2_t __attribute__((ext_vector_type(2)));
struct SplitKOrder {
    int G, c, pm0;
    __device__ __forceinline__ bool next(int i, Unit& u) const { const long L = (long)i * G + c; if (L >= 256) return false; const int w = (int)L, sl = w & 7, tile = w >> 3;
        u.pm = pm0 + (tile >> 3); u.pn = tile & 7; const int p0 = sl < 5 ? 5 * sl : 25 + 6 * (sl - 5), np = sl < 5 ? 5 : 6; u.k0 = p0 * 128; u.nt = np * 2; return true; }
    __device__ __forceinline__ void a_ready(const Unit&) const {}
    __device__ __forceinline__ void done(const Unit&) const {}
};
__device__ __forceinline__ unsigned cvt_pk_bf16(float lo, float hi) { const f32x2_t v = {lo, hi}; const bf16x2_t b = __builtin_convertvector(v, bf16x2_t); return __builtin_bit_cast(unsigned, b); }
__device__ __forceinline__ float silu_f(float x) { return x * __builtin_amdgcn_rcpf(1.0f + __builtin_amdgcn_exp2f(-1.44269504f * x)); }


struct Fold { const unsigned char* ws; int boff;
    __device__ __forceinline__ const float* rstd() const { return (const float*)(ws + WS_RSTD); }
    __device__ __forceinline__ const float* bias(int bidx) const { return (const float*)(ws + WS_BIAS) + (size_t)bidx * NBCOL + boff; } };
template <bool FOLD> struct EpiSwigluT {
    static constexpr bool PERM = true, AFTER_DRAIN = false;
    bf16_t* O; int ldc; Fold F;
    __device__ __forceinline__ void operator()(const f32x4 (&acc)[2][2][4][2], const Unit& u, int wr, int wc, int fr, int fq) const {
        const int row0 = u.pm * BM + wr * 64 + fr, col0 = u.pn * HALF + wc * 32 + 8 * fq;
        f32x4 bg[2], bu[2];
        if (FOLD) { const int bidx = (u.pm * BM >= MX) ? 5 : (u.pm >> 4); const float* bp = F.bias(bidx) + u.pn * BM + wc * 32 + 8 * fq;
            bg[0] = *(const f32x4*)bp; bg[1] = *(const f32x4*)(bp + 4); bu[0] = *(const f32x4*)(bp + HALF); bu[1] = *(const f32x4*)(bp + HALF + 4); }
#pragma unroll
        for (int ai = 0; ai < 2; ++ai)
#pragma unroll
            for (int m = 0; m < 4; ++m) { const int r = row0 + ai * HALF + m * 16; bf16_t* rowp = O + (size_t)r * ldc + col0;
                f32x4 g0 = acc[ai][0][m][0], g1 = acc[ai][0][m][1], u0 = acc[ai][1][m][0], u1 = acc[ai][1][m][1];
                if (FOLD) { const float rs = F.rstd()[r]; g0 = g0 * rs + bg[0]; g1 = g1 * rs + bg[1]; u0 = u0 * rs + bu[0]; u1 = u1 * rs + bu[1]; }
                u32x4 w; w.x = cvt_pk_bf16(silu_f(g0[0]) * u0[0], silu_f(g0[1]) * u0[1]); w.y = cvt_pk_bf16(silu_f(g0[2]) * u0[2], silu_f(g0[3]) * u0[3]);
                w.z = cvt_pk_bf16(silu_f(g1[0]) * u1[0], silu_f(g1[1]) * u1[1]); w.w = cvt_pk_bf16(silu_f(g1[2]) * u1[2], silu_f(g1[3]) * u1[3]);
                *(u32x4*)rowp = w; }
    }
};
template <bool SRC32, bool NEXT, bool HALFC> struct EpiResidT {
    static constexpr bool PERM = false, AFTER_DRAIN = false;
    const float* xin_x; const float* xin_c; unsigned char* ws; int gate_off, psub, nsub;
    __device__ __forceinline__ void operator()(const f32x4 (&acc)[2][2][4][2], const Unit& u, int wr, int wc, int fr, int fq) const {
        typedef unsigned u32x2v __attribute__((ext_vector_type(2)));
        const bool isc = (u.pm * BM) >= MX; const int bidx = isc ? 4 : (u.pm >> 4); const float coef = HALFC ? 0.5f : 1.0f;
        float* X = (float*)(ws + WS_X); bf16_t* XS = (bf16_t*)(ws + WS_HB); float* SS = (float*)(ws + WS_SS);
        const float* gv = (const float*)(ws + WS_MOD) + gate_off + (size_t)bidx * MODW; const float* gs = (const float*)(ws + WS_GS) + ((size_t)nsub * 5 + bidx) * D;
        const float* rg = (const float*)(ws + WS_RGS) + ((size_t)psub * 5 + bidx) * D;
        const int col0 = u.pn * BM + wc * 32 + 4 * fq; const int row0 = u.pm * BM + wr * 64 + fr;
        f32x4 gg[2][2], gsv[2][2], rgv[2][2];
#pragma unroll
        for (int bj = 0; bj < 2; ++bj)
#pragma unroll
            for (int n = 0; n < 2; ++n) { gg[bj][n] = *(const f32x4*)(gv + col0 + bj * HALF + n * 16) * coef; if (NEXT) gsv[bj][n] = *(const f32x4*)(gs + col0 + bj * HALF + n * 16);
                if (!SRC32) rgv[bj][n] = *(const f32x4*)(rg + col0 + bj * HALF + n * 16); }
#pragma unroll
        for (int ai = 0; ai < 2; ++ai)
#pragma unroll
            for (int m = 0; m < 4; ++m) { const int r = row0 + ai * HALF + m * 16; float sq = 0.f;
                const float* src = (isc ? xin_c + (size_t)(r - MX) * D : xin_x + (size_t)r * D) + col0;
#pragma unroll
                for (int bj = 0; bj < 2; ++bj)
#pragma unroll
                    for (int n = 0; n < 2; ++n) { const size_t eo = (size_t)r * D + col0 + bj * HALF + n * 16; f32x4 xo;
                        if (SRC32) xo = *(const f32x4*)(src + bj * HALF + n * 16);
                        else { const u32x2v w = *(const u32x2v*)(XS + eo); xo = (f32x4){__builtin_bit_cast(float, w.x << 16), __builtin_bit_cast(float, w.x & 0xffff0000u), __builtin_bit_cast(float, w.y << 16), __builtin_bit_cast(float, w.y & 0xffff0000u)} * rgv[bj][n]; }
                        const f32x4 xn = xo + acc[ai][bj][m][n] * gg[bj][n];
                        if (NEXT) { const f32x4 y = xn * gsv[bj][n]; u32x2v w; w.x = cvt_pk_bf16(y[0], y[1]); w.y = cvt_pk_bf16(y[2], y[3]); *(u32x2v*)(XS + eo) = w;
                            sq += (xn[0] * xn[0] + xn[1] * xn[1]) + (xn[2] * xn[2] + xn[3] * xn[3]); }
                        else *(f32x4*)(X + eo) = xn; }
                if (NEXT) { sq += __shfl_xor(sq, 16); sq += __shfl_xor(sq, 32); if (fq == 0) SS[(size_t)r * 32 + u.pn * 4 + wc] = sq; }
                if (m == 3) asm volatile("" ::: "memory"); }
    }
};
struct EpiPartial {
    static constexpr bool PERM = false, AFTER_DRAIN = false;
    float* P; int row0; size_t slice_stride;
    __device__ __forceinline__ void operator()(const f32x4 (&acc)[2][2][4][2], const Unit& u, int wr, int wc, int fr, int fq) const {
        const int sl = u.k0 < 25 * 128 ? u.k0 / (5 * 128) : 5 + (u.k0 - 25 * 128) / (6 * 128);
        float* base = P + (size_t)sl * slice_stride; const int col0 = u.pn * BM + wc * 32 + 4 * fq, r0 = u.pm * BM - row0 + wr * 64 + fr;
#pragma unroll
        for (int ai = 0; ai < 2; ++ai)
#pragma unroll
            for (int m = 0; m < 4; ++m) { float* rowp = base + (size_t)(r0 + ai * HALF + m * 16) * 2048 + col0;
#pragma unroll
                for (int bj = 0; bj < 2; ++bj)
#pragma unroll
                    for (int n = 0; n < 2; ++n) *(f32x4*)(rowp + bj * HALF + n * 16) = acc[ai][bj][m][n]; }
    }
};
template <bool FOLD> struct EpiMlstmInT {
    static constexpr bool PERM = true, AFTER_DRAIN = false;
    bf16_t* O; float* G; const float* bgate; Fold F;
    __device__ __forceinline__ void operator()(const f32x4 (&acc)[2][2][4][2], const Unit& u, int wr, int wc, int fr, int fq) const {
        const int row0 = u.pm * BM + wr * 64 + fr;
        f32x4 bv[2][2];
#pragma unroll
        for (int bj = 0; bj < 2; ++bj)
#pragma unroll
            for (int n = 0; n < 2; ++n) bv[bj][n] = (f32x4){0.f, 0.f, 0.f, 0.f};
        if (FOLD) { const int bidx = (u.pm * BM >= MX) ? 5 : (u.pm >> 4); const float* bp = F.bias(bidx) + u.pn * BM + wc * 32 + 8 * fq;
#pragma unroll
            for (int bj = 0; bj < 2; ++bj)
#pragma unroll
                for (int n = 0; n < 2; ++n) bv[bj][n] = *(const f32x4*)(bp + bj * HALF + 4 * n); }
        if (u.pn < 24) {
            const int col0 = u.pn * BM + wc * 32 + 8 * fq;
#pragma unroll
            for (int ai = 0; ai < 2; ++ai)
#pragma unroll
                for (int m = 0; m < 4; ++m) { const int r = row0 + ai * HALF + m * 16; bf16_t* rowp = O + (size_t)r * 6144 + col0; const float rs = FOLD ? F.rstd()[r] : 1.0f;
#pragma unroll
                    for (int bj = 0; bj < 2; ++bj) { f32x4 v0 = acc[ai][bj][m][0], v1 = acc[ai][bj][m][1]; if (FOLD) { v0 = v0 * rs + bv[bj][0]; v1 = v1 * rs + bv[bj][1]; }
                        u32x4 w; w.x = cvt_pk_bf16(v0[0], v0[1]); w.y = cvt_pk_bf16(v0[2], v0[3]); w.z = cvt_pk_bf16(v1[0], v1[1]); w.w = cvt_pk_bf16(v1[2], v1[3]);
                        *(u32x4*)(rowp + bj * HALF) = w; } }
        } else if (wc == 0) {
            const f32x4 b0 = *(const f32x4*)(bgate + 8 * fq) + bv[0][0], b1 = *(const f32x4*)(bgate + 8 * fq + 4) + bv[0][1];
#pragma unroll
            for (int ai = 0; ai < 2; ++ai)
#pragma unroll
                for (int m = 0; m < 4; ++m) { const int r = row0 + ai * HALF + m * 16; float* rowp = G + (size_t)r * 32 + 8 * fq; const float rs = FOLD ? F.rstd()[r] : 1.0f;
                    *(f32x4*)rowp = acc[ai][0][m][0] * rs + b0; *(f32x4*)(rowp + 4) = acc[ai][0][m][1] * rs + b1; }
        }
    }
};
template <bool FOLD> struct EpiConvInT {
    static constexpr bool PERM = true, AFTER_DRAIN = false;
    bf16_t* BG; bf16_t* Z; Fold F;
    __device__ __forceinline__ void operator()(const f32x4 (&acc)[2][2][4][2], const Unit& u, int wr, int wc, int fr, int fq) const {
        const int row0 = u.pm * BM + wr * 64 + fr;
        f32x4 bv[2][2];
#pragma unroll
        for (int bj = 0; bj < 2; ++bj)
#pragma unroll
            for (int n = 0; n < 2; ++n) bv[bj][n] = (f32x4){0.f, 0.f, 0.f, 0.f};
        if (FOLD) { const int bidx = (u.pm * BM >= MX) ? 5 : (u.pm >> 4); const float* bp = F.bias(bidx) + u.pn * BM + wc * 32 + 8 * fq;
#pragma unroll
            for (int bj = 0; bj < 2; ++bj)
#pragma unroll
                for (int n = 0; n < 2; ++n) bv[bj][n] = *(const f32x4*)(bp + bj * HALF + 4 * n); }
        if (u.pn < 8) {
            const int col0 = u.pn * BM + wc * 32 + 8 * fq;
#pragma unroll
            for (int ai = 0; ai < 2; ++ai)
#pragma unroll
                for (int m = 0; m < 4; ++m) { const int r = row0 + ai * HALF + m * 16; bf16_t* rowp = BG + (size_t)r * 2048 + col0; const float rs = FOLD ? F.rstd()[r] : 1.0f;
#pragma unroll
                    for (int bj = 0; bj < 2; ++bj) { f32x4 v0 = acc[ai][bj][m][0], v1 = acc[ai][bj][m][1]; if (FOLD) { v0 = v0 * rs + bv[bj][0]; v1 = v1 * rs + bv[bj][1]; }
                        u32x4 w; w.x = cvt_pk_bf16(v0[0], v0[1]); w.y = cvt_pk_bf16(v0[2], v0[3]); w.z = cvt_pk_bf16(v1[0], v1[1]); w.w = cvt_pk_bf16(v1[2], v1[3]);
                        *(u32x4*)(rowp + bj * HALF) = w; } }
        } else {
            const int col0 = (u.pn - 8) * HALF + wc * 32 + 8 * fq;
#pragma unroll
            for (int ai = 0; ai < 2; ++ai)
#pragma unroll
                for (int m = 0; m < 4; ++m) { const int r = row0 + ai * HALF + m * 16; bf16_t* rowp = Z + (size_t)r * 2048 + col0; const float rs = FOLD ? F.rstd()[r] : 1.0f;
                    f32x4 c0 = acc[ai][0][m][0], c1 = acc[ai][0][m][1], u0 = acc[ai][1][m][0], u1 = acc[ai][1][m][1];
                    if (FOLD) { c0 = c0 * rs + bv[0][0]; c1 = c1 * rs + bv[0][1]; u0 = u0 * rs + bv[1][0]; u1 = u1 * rs + bv[1][1]; }
                    const f32x4 v0 = c0 * u0, v1 = c1 * u1;
                    u32x4 w; w.x = cvt_pk_bf16(v0[0], v0[1]); w.y = cvt_pk_bf16(v0[2], v0[3]); w.z = cvt_pk_bf16(v1[0], v1[1]); w.w = cvt_pk_bf16(v1[2], v1[3]);
                    *(u32x4*)rowp = w; }
        }
    }
};

template <class Epi, class Sched, bool ALIGN_EPI = false, bool SP2 = false>
__device__ __forceinline__ void gemm_phase(PG8_LAS unsigned char* lds, const Gemm g, const Sched& S, const Epi& E) {
    const int tid = threadIdx.x, wid = __builtin_amdgcn_readfirstlane(tid >> 6), lane = tid & 63, wr = wid >> 2, wc = wid & 3, fr = lane & 15, fq = lane >> 4;
    const int K = g.K;
    unsigned voffA[2], voffB[2];
#pragma unroll
    for (int i = 0; i < 2; ++i) { int R, C; stage_rc(tid * 16 + i * 8192, R, C); const int Rb = Epi::PERM ? ((R & ~31) + perm32(R & 31)) : R;
        voffA[i] = (unsigned)(R * K + C) * 2u; voffB[i] = (unsigned)(Rb * K + C) * 2u; }
    const size_t kstep = (size_t)(BK * 2);
    const size_t hstep = (size_t)HALF * K * 2;
    const size_t tstep = 2 * hstep;
    const unsigned ldsw = (unsigned)wid * 1024u;
    const int aoff = lds_byte(wr * 64 + fr, fq * 8), boff = lds_byte(wc * 32 + fr, fq * 8);
#define PG8_SA(b, h) (((b) * 2 + (h)) * HTB)
#define PG8_SB(b, h) ((4 + (b) * 2 + (h)) * HTB)
#define PG8_STAGE(bufoff, gbase, voff) do { _Pragma("unroll") for (int _i = 0; _i < 2; ++_i) \
        __builtin_amdgcn_global_load_lds((const unsigned*)((const char*)(gbase) + (voff)[_i]), (PG8_LAS unsigned*)(lds + (bufoff) + ldsw + _i * 8192), 16, 0, 0); } while (0)
#define PG8_LDA(dst, b, h) do { _Pragma("unroll") for (int m = 0; m < 4; ++m) _Pragma("unroll") for (int k = 0; k < 2; ++k) dst[m][k] = *(const PG8_LAS bf16x8*)(lds + PG8_SA(b, h) + aoff + m * 2048 + k * 1024); } while (0)
#define PG8_LDB(dst, b, h) do { _Pragma("unroll") for (int n = 0; n < 2; ++n) _Pragma("unroll") for (int k = 0; k < 2; ++k) dst[n][k] = *(const PG8_LAS bf16x8*)(lds + PG8_SB(b, h) + boff + n * 2048 + k * 1024); } while (0)
#define PG8_MMA(ai, bj, At, Bt) do { __builtin_amdgcn_s_setprio(1); _Pragma("unroll") for (int m = 0; m < 4; ++m) _Pragma("unroll") for (int n = 0; n < 2; ++n) _Pragma("unroll") for (int k = 0; k < 2; ++k) \
        acc[ai][bj][m][n] = __builtin_amdgcn_mfma_f32_16x16x32_bf16(Bt[n][k], At[m][k], acc[ai][bj][m][n], 0, 0, 0); __builtin_amdgcn_s_setprio(0); } while (0)
#define PG8_WAIT_V(n) asm volatile("s_waitcnt vmcnt(" #n ")" ::: "memory")
#define PG8_WAIT_L(n) asm volatile("s_waitcnt lgkmcnt(" #n ")" ::: "memory")
#define PG8_BAR __builtin_amdgcn_s_barrier()
#define PG8_SCHED __builtin_amdgcn_sched_barrier(0)
    Unit cur, nxt; int ui = 0;
    if (!S.next(0, cur)) return;
    f32x4 acc[2][2][4][2];
#pragma unroll
    for (int a = 0; a < 2; ++a)
#pragma unroll
        for (int b = 0; b < 2; ++b)
#pragma unroll
            for (int m = 0; m < 4; ++m)
#pragma unroll
                for (int n = 0; n < 2; ++n) acc[a][b][m][n] = (f32x4){0.f, 0.f, 0.f, 0.f};
    bf16x8 At[4][2], B0[2][2], B1[2][2];
    const char* cA = (const char*)g.A + (size_t)cur.pm * tstep + (size_t)cur.k0 * 2; const char* cB = (const char*)g.Bt + (size_t)cur.pn * tstep + (size_t)cur.k0 * 2;
    S.a_ready(cur);
    if constexpr (SP2) {
        PG8_STAGE(PG8_SB(0, 0), cB, voffB); PG8_STAGE(PG8_SB(0, 1), cB + hstep, voffB); PG8_STAGE(PG8_SA(0, 0), cA, voffA); PG8_STAGE(PG8_SA(0, 1), cA + hstep, voffA);
        if (wr == 1) PG8_BAR;
        PG8_WAIT_V(2); PG8_BAR;
        PG8_STAGE(PG8_SB(1, 0), cB + kstep, voffB); PG8_STAGE(PG8_SA(1, 0), cA + kstep, voffA); PG8_STAGE(PG8_SB(1, 1), cB + hstep + kstep, voffB);
        PG8_WAIT_V(6); PG8_BAR;
    } else {
        PG8_STAGE(PG8_SB(0, 0), cB, voffB); PG8_STAGE(PG8_SA(0, 0), cA, voffA); PG8_STAGE(PG8_SB(0, 1), cB + hstep, voffB); PG8_STAGE(PG8_SA(0, 1), cA + hstep, voffA);
        if (wr == 1) PG8_BAR;
        PG8_WAIT_V(4); PG8_BAR;
        PG8_STAGE(PG8_SB(1, 0), cB + kstep, voffB); PG8_STAGE(PG8_SA(1, 0), cA + kstep, voffA); PG8_STAGE(PG8_SB(1, 1), cB + hstep + kstep, voffB);
        PG8_WAIT_V(6); PG8_BAR;
    }
    for (;;) {
        const bool has_next = S.next(ui + 1, nxt);
        const char* nA = has_next ? (const char*)g.A + (size_t)nxt.pm * tstep + (size_t)nxt.k0 * 2 : cA; const char* nB = has_next ? (const char*)g.Bt + (size_t)nxt.pn * tstep + (size_t)nxt.k0 * 2 : cB;
        const int nt = cur.nt;
        for (int t = 0; t < nt; t += 2) {
            const bool last = (t == nt - 2);
            const char* a1 = cA + (size_t)(t + 1) * kstep;
            const char* a2 = last ? nA : cA + (size_t)(t + 2) * kstep; const char* b2 = last ? nB : cB + (size_t)(t + 2) * kstep;
            const char* a3 = a2 + kstep; const char* b3 = b2 + kstep;
            if (last && has_next) S.a_ready(nxt);
            if constexpr (SP2) {
            PG8_LDB(B0, 0, 0); PG8_LDB(B1, 0, 1); PG8_SCHED; PG8_LDA(At, 0, 0); PG8_STAGE(PG8_SA(1, 1), a1 + hstep, voffA);
            PG8_WAIT_V(8); PG8_WAIT_L(0); PG8_BAR; PG8_MMA(0, 0, At, B0); PG8_MMA(0, 1, At, B1); PG8_BAR; PG8_SCHED;
            PG8_LDA(At, 0, 1); PG8_STAGE(PG8_SB(0, 0), b2, voffB); PG8_STAGE(PG8_SB(0, 1), b2 + hstep, voffB); PG8_STAGE(PG8_SA(0, 0), a2, voffA);
            PG8_WAIT_V(8); PG8_WAIT_L(0); PG8_BAR; PG8_MMA(1, 0, At, B0); PG8_MMA(1, 1, At, B1); PG8_BAR; PG8_SCHED;
            PG8_LDB(B0, 1, 0); PG8_LDB(B1, 1, 1); PG8_SCHED; PG8_LDA(At, 1, 0); PG8_STAGE(PG8_SA(0, 1), a2 + hstep, voffA);
            PG8_WAIT_V(8); PG8_WAIT_L(0); PG8_BAR; PG8_MMA(0, 0, At, B0); PG8_MMA(0, 1, At, B1); PG8_BAR; PG8_SCHED;
            PG8_LDA(At, 1, 1); PG8_STAGE(PG8_SB(1, 0), b3, voffB); PG8_STAGE(PG8_SB(1, 1), b3 + hstep, voffB); PG8_STAGE(PG8_SA(1, 0), a3, voffA);
            PG8_WAIT_V(8); PG8_WAIT_L(0); PG8_BAR; PG8_MMA(1, 0, At, B0); PG8_MMA(1, 1, At, B1); PG8_BAR; PG8_SCHED;
            } else {
            PG8_LDB(B0, 0, 0); PG8_SCHED; PG8_LDA(At, 0, 0); PG8_STAGE(PG8_SA(1, 1), a1 + hstep, voffA);
            PG8_WAIT_L(8); PG8_BAR; PG8_WAIT_L(0); PG8_MMA(0, 0, At, B0); PG8_BAR; PG8_SCHED;
            PG8_LDB(B1, 0, 1); PG8_STAGE(PG8_SB(0, 0), b2, voffB);
            PG8_BAR; PG8_WAIT_L(0); PG8_MMA(0, 1, At, B1); PG8_BAR;
            PG8_LDA(At, 0, 1); PG8_STAGE(PG8_SA(0, 0), a2, voffA);
            PG8_BAR; PG8_WAIT_L(0); PG8_MMA(1, 0, At, B0); PG8_BAR; PG8_SCHED;
            PG8_STAGE(PG8_SB(0, 1), b2 + hstep, voffB);
            PG8_WAIT_V(6); PG8_BAR; PG8_MMA(1, 1, At, B1); PG8_BAR;
            PG8_LDB(B0, 1, 0); PG8_SCHED; PG8_LDA(At, 1, 0); PG8_STAGE(PG8_SA(0, 1), a2 + hstep, voffA);
            PG8_WAIT_L(8); PG8_BAR; PG8_WAIT_L(0); PG8_MMA(0, 0, At, B0); PG8_BAR; PG8_SCHED;
            PG8_LDB(B1, 1, 1); PG8_STAGE(PG8_SB(1, 0), b3, voffB);
            PG8_BAR; PG8_WAIT_L(0); PG8_MMA(0, 1, At, B1); PG8_BAR;
            PG8_LDA(At, 1, 1); PG8_STAGE(PG8_SA(1, 0), a3, voffA);
            PG8_BAR; PG8_WAIT_L(0); PG8_MMA(1, 0, At, B0); PG8_BAR; PG8_SCHED;
            PG8_STAGE(PG8_SB(1, 1), b3 + hstep, voffB);
            PG8_WAIT_V(6); PG8_BAR; PG8_MMA(1, 1, At, B1); PG8_BAR;
            }
        }
        if constexpr (ALIGN_EPI) { if (wr == 0) PG8_BAR; }
        if constexpr (!Epi::AFTER_DRAIN) { E(acc, cur, wr, wc, fr, fq); S.done(cur); }
        if (!has_next) break;
#pragma unroll
        for (int a = 0; a < 2; ++a)
#pragma unroll
            for (int b = 0; b < 2; ++b)
#pragma unroll
                for (int m = 0; m < 4; ++m)
#pragma unroll
                    for (int n = 0; n < 2; ++n) acc[a][b][m][n] = (f32x4){0.f, 0.f, 0.f, 0.f};
        cur = nxt; cA = nA; cB = nB; ++ui;
        if constexpr (ALIGN_EPI) { if (wr == 1) PG8_BAR; }
    }
    PG8_WAIT_V(0);
    if constexpr (!ALIGN_EPI) { if (wr == 0) PG8_BAR; }
    PG8_BAR;
#undef PG8_SA
#undef PG8_SB
#undef PG8_STAGE
#undef PG8_LDA
#undef PG8_LDB
#undef PG8_MMA
#undef PG8_WAIT_V
#undef PG8_WAIT_L
#undef PG8_BAR
#undef PG8_SCHED
}
}

constexpr int RING_BYTES = 131072;
constexpr int SCR_BYTES = 8 * 64 * 65 * 4;
constexpr int LDSCTL_OFF = 151552, LDS_BYTES = 155648;

#define GAS __attribute__((address_space(1)))
#define LAS __attribute__((address_space(3)))
typedef unsigned short bf16;
typedef unsigned v4u __attribute__((ext_vector_type(4)));
typedef unsigned v2u __attribute__((ext_vector_type(2)));
typedef float f32x4 __attribute__((ext_vector_type(4)));
typedef short bf16x8 __attribute__((ext_vector_type(8)));
typedef short s16x4 __attribute__((ext_vector_type(4)));
#define LDS_WAIT() asm volatile("s_waitcnt lgkmcnt(0)" ::: "memory")
__device__ __forceinline__ unsigned f2bf(float f) { unsigned u = __builtin_bit_cast(unsigned, f); return (u + 0x7fffu + ((u >> 16) & 1u)) >> 16; }
__device__ __forceinline__ unsigned pk2(float lo, float hi) { return pg8::cvt_pk_bf16(lo, hi); }
__device__ __forceinline__ float bflo(unsigned w) { return __builtin_bit_cast(float, w << 16); }
__device__ __forceinline__ float bfhi(unsigned w) { return __builtin_bit_cast(float, w & 0xffff0000u); }

#define XB_TMO      128
#define XB_XCNT(j)  (256  + 64 * (j))
#define XB_XSUB(j)  (1280 + 64 * (j))
#define XB_XGEN(j)  (2304 + 64 * (j))
#define XB_TOP      3328
#define XB_TOPGEN   3392
#define XCD_BAR_WORDS 3456
#define XB_SPIN_CAP (1u << 18)
__device__ __forceinline__ unsigned xb_ld(unsigned* p)              { return __hip_atomic_load(p, __ATOMIC_RELAXED, __HIP_MEMORY_SCOPE_AGENT); }
__device__ __forceinline__ unsigned xb_add(unsigned* p, unsigned v) { return __hip_atomic_fetch_add(p, v, __ATOMIC_RELAXED, __HIP_MEMORY_SCOPE_AGENT); }
__device__ __forceinline__ unsigned xb_xcc_id() { return (unsigned)__builtin_amdgcn_s_getreg((3 << 11) | 20) & 0xFu; }
#define XB_SPIN(cond, bar) do { unsigned _sp = 0; while (cond) { __builtin_amdgcn_s_sleep(1); \
    if ((++_sp & 255u) == 0u) { if (xb_ld(&(bar)[XB_TMO])) break; if (_sp > XB_SPIN_CAP) { atomicAdd(&(bar)[XB_TMO], 1u); break; } } } } while (0)
struct XcdBarrier { unsigned* bar; unsigned x; volatile LAS unsigned* st; };
__device__ __forceinline__ XcdBarrier xcd_barrier_post(unsigned* bar, volatile LAS unsigned* st) {
    XcdBarrier b; b.bar = bar; b.x = xb_xcc_id(); b.st = st;
    if (threadIdx.x == 0) (void)xb_add(&bar[XB_XCNT(b.x)], 1u);
    return b;
}
__device__ __forceinline__ void xcd_barrier_complete(unsigned* bar, unsigned x, unsigned& nloc, unsigned& nx) {
    const unsigned G = gridDim.x * gridDim.y * gridDim.z;
    unsigned sum, cnt, mine, sp = 0u;
    for (;;) {
        sum = 0u; cnt = 0u; mine = 0u;
#pragma unroll
        for (unsigned j = 0; j < 16; ++j) { const unsigned c = xb_ld(&bar[XB_XCNT(j)]); sum += c; cnt += (c > 0u) ? 1u : 0u; mine = (j == x) ? c : mine; }
        if (sum == G) break;
        __builtin_amdgcn_s_sleep(1);
        if ((++sp & 255u) == 0u) { if (xb_ld(&bar[XB_TMO])) break; if (sp > XB_SPIN_CAP) { atomicAdd(&bar[XB_TMO], 1u); break; } }
    }
    nloc = mine > 0u ? mine : 1u; nx = cnt > 0u ? cnt : 1u;
}
__device__ __forceinline__ void xcd_barrier(const XcdBarrier& b) {
    asm volatile("s_waitcnt vmcnt(0)" ::: "memory");
    __syncthreads();
    if (threadIdx.x == 0) {
        unsigned* bar = b.bar;
        __builtin_amdgcn_s_waitcnt(0);
        unsigned nloc = b.st[0], nx = b.st[1];
        if (nloc == 0u) { xcd_barrier_complete(bar, b.x, nloc, nx); b.st[0] = nloc; b.st[1] = nx; }
        const unsigned old = xb_add(&bar[XB_XSUB(b.x)], 1u);
        const unsigned gen = old / nloc;
        if (old + 1u == (gen + 1u) * nloc) {
            __builtin_amdgcn_fence(__ATOMIC_RELEASE, "agent");
            asm volatile("s_waitcnt vmcnt(0)" ::: "memory");
            const unsigned og = xb_add(&bar[XB_TOP], 1u);
            const unsigned tg = og / nx;
            if (og + 1u == (tg + 1u) * nx) xb_add(&bar[XB_TOPGEN], 1u);
            else XB_SPIN(xb_ld(&bar[XB_TOPGEN]) == tg, bar);
            __builtin_amdgcn_fence(__ATOMIC_ACQUIRE, "agent");
            xb_add(&bar[XB_XGEN(b.x)], 1u);
            asm volatile("s_waitcnt vmcnt(0)" ::: "memory");
        } else {
            XB_SPIN(xb_ld(&bar[XB_XGEN(b.x)]) == gen, bar);
            __builtin_amdgcn_fence(__ATOMIC_ACQUIRE, "agent");
            asm volatile("s_waitcnt vmcnt(0)" ::: "memory");
        }
    }
    __syncthreads();
}

__device__ __forceinline__ float wave_sum(float v) {
#pragma unroll
    for (int o = 1; o < 64; o <<= 1) v += __shfl_xor(v, o);
    return v;
}
template <int MAPK> __device__ __forceinline__ int wmap(int n) {
    if (MAPK == 1) { const int pn = n >> 8, r = n & 255; return ((r < 128) ? 0 : DFF) + 128 * pn + (r & 127); }
    if (MAPK == 2) { return n < 4096 ? n : (n < 6144 ? n + 32 : (n < 6176 ? n - 2048 : -1)); }
    if (MAPK == 3) { if (n < 2048) return n; const int q = n - 2048, pn = q >> 8, r = q & 255; return ((r < 128) ? 2048 : 4096) + 128 * pn + (r & 127); }
    return n;
}
template <int MAPK, bool BIAS = false> __device__ __forceinline__ void transpose_item(const float* W, int K, int Nsrc, bf16* WT, int nblk, LAS float* scr, int item, int lane, const float* shift = nullptr, float* biasp = nullptr) {
    const int kb = item / nblk, nb = item - kb * nblk, k0 = 64 * kb, n0 = 64 * nb;
    const int n = n0 + lane, sc = wmap<MAPK>(n);
    const float scale = (MAPK == 2 && n < 1024) ? 0.08838834764831845f : 1.0f;
    const float* src = W + (size_t)k0 * Nsrc + (sc >= 0 ? sc : 0);
#pragma unroll
    for (int hb = 0; hb < 2; ++hb) { float v[32];
#pragma unroll
        for (int i = 0; i < 32; ++i) v[i] = src[(size_t)(32 * hb + i) * Nsrc];
#pragma unroll
        for (int i = 0; i < 32; ++i) scr[(32 * hb + i) * 65 + lane] = (sc >= 0) ? v[i] * scale : 0.f; }
    LDS_WAIT(); asm volatile("" ::: "memory");
    if (BIAS) { float sv[5], ba[5];
#pragma unroll
        for (int b = 0; b < 5; ++b) { sv[b] = shift[(size_t)b * MODW + k0 + lane]; ba[b] = 0.f; }
#pragma unroll 16
        for (int k = 0; k < 64; ++k) { const float w = scr[k * 65 + lane];
#pragma unroll
            for (int b = 0; b < 5; ++b) ba[b] += w * __builtin_bit_cast(float, __builtin_amdgcn_readlane(__builtin_bit_cast(int, sv[b]), k)); }
#pragma unroll
        for (int b = 0; b < 5; ++b) biasp[((size_t)kb * 5 + b) * NBCOL + n0 + lane] = ba[b]; }
    const int c = lane & 7;
#pragma unroll
    for (int j = 0; j < 8; ++j) { const int nn = (lane >> 3) + 8 * j; const LAS float* s = scr + (8 * c) * 65 + nn;
        v4u o; o.x = pk2(s[0 * 65], s[1 * 65]); o.y = pk2(s[2 * 65], s[3 * 65]); o.z = pk2(s[4 * 65], s[5 * 65]); o.w = pk2(s[6 * 65], s[7 * 65]);
        *(GAS v4u*)(WT + (size_t)(n0 + nn) * K + k0 + 8 * c) = o; }
    LDS_WAIT(); asm volatile("" ::: "memory");
}

struct KArgs { const float* in[17]; float* out; unsigned char* ws; int ph_lo, ph_hi; };

__device__ __forceinline__ void normmod_phase(const float* xx, const float* xc, int rows, const float* ng, const float* modl, int j, bf16* HB, int gw, int NGW, int lane, const float* ctxP = nullptr, const float* cgate = nullptr, int first_row = 0) {
    for (int r = first_row + gw; r < rows; r += NGW) {
        const bool isc = r >= MX; const int b = isc ? 4 : (r >> 12);
        const float* src = isc ? xc + (size_t)(r - MX) * D : xx + (size_t)r * D;
        const float* shift = modl + (size_t)b * MODW + (3 * j) * D; const float* scale = shift + D;
        f32x4 v[8]; float ss = 0.f;
#pragma unroll
        for (int q = 0; q < 8; ++q) { v[q] = *(const f32x4*)(src + 4 * (lane + 64 * q));
            if (ctxP && isc) { const int c = 4 * (lane + 64 * q); f32x4 p = *(const f32x4*)(ctxP + (size_t)(r - MX) * D + c);
#pragma unroll
                for (int sl = 1; sl < 8; ++sl) p += *(const f32x4*)(ctxP + ((size_t)sl * MC + (r - MX)) * D + c);
                v[q] += p * (*(const f32x4*)(cgate + c)) * 0.5f; }
            ss += (v[q][0] * v[q][0] + v[q][1] * v[q][1]) + (v[q][2] * v[q][2] + v[q][3] * v[q][3]); }
        const float rstd = 1.0f / sqrtf(wave_sum(ss) * (1.0f / D) + RMS_EPS);
        bf16* orow = HB + (size_t)r * D;
#pragma unroll
        for (int q = 0; q < 8; ++q) { const int c = 4 * (lane + 64 * q);
            const f32x4 g4 = *(const f32x4*)(ng + c), s4 = *(const f32x4*)(scale + c), h4 = *(const f32x4*)(shift + c);
            const f32x4 y = v[q] * rstd * g4 * (s4 + 1.0f) + h4;
            v2u o; o.x = pk2(y[0], y[1]); o.y = pk2(y[2], y[3]); *(v2u*)(orow + c) = o; }
    }
}
__device__ __forceinline__ void final_norm_phase(const float* X, const float* ng, float* out, int gw, int NGW, int lane) {
    for (int r = gw; r < MX; r += NGW) {
        const float* src = X + (size_t)r * D; f32x4 v[8]; float ss = 0.f;
#pragma unroll
        for (int q = 0; q < 8; ++q) { v[q] = *(const f32x4*)(src + 4 * (lane + 64 * q)); ss += (v[q][0] * v[q][0] + v[q][1] * v[q][1]) + (v[q][2] * v[q][2] + v[q][3] * v[q][3]); }
        const float rstd = 1.0f / sqrtf(wave_sum(ss) * (1.0f / D) + RMS_EPS);
        float* orow = out + (size_t)r * D;
#pragma unroll
        for (int q = 0; q < 8; ++q) { const int c = 4 * (lane + 64 * q); const f32x4 g4 = *(const f32x4*)(ng + c); *(f32x4*)(orow + c) = v[q] * rstd * g4; }
    }
}
__device__ __forceinline__ void unpack8(const v4u w, float (&f)[8]) { f[0] = bflo(w.x); f[1] = bfhi(w.x); f[2] = bflo(w.y); f[3] = bfhi(w.y); f[4] = bflo(w.z); f[5] = bfhi(w.z); f[6] = bflo(w.w); f[7] = bfhi(w.w); }
__device__ __forceinline__ void headnorm_phase(const bf16* HF, const bf16* HBW, const bf16* QKVO, const float* ng, bf16* Y, int gw, int NGW, int lane) {
    for (int r = gw; r < MX; r += NGW) {
#pragma unroll
        for (int q = 0; q < 4; ++q) { const int c = 8 * (lane + 64 * q);
            const v4u a = *(const v4u*)(HF + (size_t)r * D + c), b = *(const v4u*)(HBW + (size_t)r * D + c), o = *(const v4u*)(QKVO + (size_t)r * 6144 + 4096 + c);
            float fa[8], fb[8], fo[8]; unpack8(a, fa); unpack8(b, fb); unpack8(o, fo);
            float s[8], ss = 0.f;
#pragma unroll
            for (int i = 0; i < 8; ++i) { s[i] = fa[i] + fb[i]; ss += s[i] * s[i]; }
#pragma unroll
            for (int of = 1; of < 32; of <<= 1) ss += __shfl_xor(ss, of);
            const float rstd = 1.0f / sqrtf(ss * (1.0f / DVH) + RMS_EPS);
            const f32x4 g0 = *(const f32x4*)(ng + c), g1 = *(const f32x4*)(ng + c + 4);
            float y[8];
#pragma unroll
            for (int i = 0; i < 8; ++i) { const float g = i < 4 ? g0[i] : g1[i - 4]; y[i] = s[i] * rstd * g * __builtin_amdgcn_rcpf(1.0f + __builtin_amdgcn_exp2f(-1.44269504f * fo[i])); }
            v4u w; w.x = pk2(y[0], y[1]); w.y = pk2(y[2], y[3]); w.z = pk2(y[4], y[5]); w.w = pk2(y[6], y[7]);
            *(v4u*)(Y + (size_t)r * D + c) = w; }
    }
}
__device__ __forceinline__ void convmix_phase(const bf16* BG, const bf16* Z, const float* cw, bf16* Y, int gw, int NGW, int lane) {
    for (int r = gw; r < MX; r += NGW) { const int t = r & 63;
#pragma unroll
        for (int q = 0; q < 4; ++q) { const int c = 8 * (lane + 64 * q);
            const v4u zero = (v4u){0u, 0u, 0u, 0u};
            const v4u zc = *(const v4u*)(Z + (size_t)r * D + c), zp = t > 0 ? *(const v4u*)(Z + (size_t)(r - 1) * D + c) : zero, zn = t < 63 ? *(const v4u*)(Z + (size_t)(r + 1) * D + c) : zero;
            const v4u bg = *(const v4u*)(BG + (size_t)r * D + c);
            float fc[8], fp[8], fn[8], fb[8]; unpack8(zc, fc); unpack8(zp, fp); unpack8(zn, fn); unpack8(bg, fb);
            float y[8];
#pragma unroll
            for (int h = 0; h < 2; ++h) { const f32x4 w0 = *(const f32x4*)(cw + c + 4 * h), w1 = *(const f32x4*)(cw + D + c + 4 * h), w2 = *(const f32x4*)(cw + 2 * D + c + 4 * h);
#pragma unroll
                for (int i = 0; i < 4; ++i) y[4 * h + i] = fb[4 * h + i] * (w0[i] * fp[4 * h + i] + w1[i] * fc[4 * h + i] + w2[i] * fn[4 * h + i]); }
            v4u w; w.x = pk2(y[0], y[1]); w.y = pk2(y[2], y[3]); w.z = pk2(y[4], y[5]); w.w = pk2(y[6], y[7]);
            *(v4u*)(Y + (size_t)r * D + c) = w; }
    }
}

__device__ __forceinline__ void mod_partials(const KArgs& a, int l, int wv, int nwv, int lane) {
    float* modp = (float*)(a.ws + WS_MODP);
    constexpr int NCG = MODW / 256, NKS = D / 64, NIT = NCG * NKS;
    for (int it = wv; it < NIT; it += nwv) {
        const int cg = it / NKS, ks = it - cg * NKS, k0 = 64 * ks, col = 256 * cg + 4 * lane;
        float sv[5];
#pragma unroll
        for (int b = 0; b < 5; ++b) { const float cv = (b < 4) ? a.in[1][b * D + k0 + lane] : a.in[3][k0 + lane]; sv[b] = pg8::silu_f(cv); }
        f32x4 acc[5];
#pragma unroll
        for (int b = 0; b < 5; ++b) acc[b] = (f32x4){0.f, 0.f, 0.f, 0.f};
        const float* wp = a.in[4] + ((size_t)l * D + k0) * MODW + col;
#pragma unroll 8
        for (int k = 0; k < 64; ++k) { const f32x4 w = *(const f32x4*)(wp + (size_t)k * MODW);
#pragma unroll
            for (int b = 0; b < 5; ++b) { const float s = __builtin_bit_cast(float, __builtin_amdgcn_readlane(__builtin_bit_cast(int, sv[b]), k)); acc[b] += w * s; } }
#pragma unroll
        for (int b = 0; b < 5; ++b) *(f32x4*)(modp + (((size_t)ks * 2 + l) * 5 + b) * MODW + col) = acc[b];
    }
}
template <int LIST> __device__ __forceinline__ void convert_list(const KArgs& a, LAS unsigned char* lds, int wv, int nwv, int wave, int lane) {
    unsigned char* ws = a.ws;
    LAS float* scr = (LAS float*)(lds + wave * (64 * 65 * 4));
    const float* mod = (const float*)(ws + WS_MOD); float* bp = (float*)(ws + WS_BIASP);
    constexpr int I_FI = (D / 64) * (NFI / 64), I_FO = (DFF / 64) * (D / 64), I_MI = (D / 64) * (NML / 64), I_SQ = (D / 64) * (D / 64), I_CI = (D / 64) * (NCV / 64);
    if (LIST == 0) {
        for (int it = wv; it < I_FI + I_FO; it += nwv) { int r = it;
            if (r < I_FI) { transpose_item<1>(a.in[7], D, NFI, (bf16*)(ws + WS_WFI), NFI / 64, scr, r, lane); continue; } r -= I_FI;
            transpose_item<0>(a.in[8], DFF, D, (bf16*)(ws + WS_WFO), D / 64, scr, r, lane); }
    } else if (LIST == 1) {
        for (int it = wv; it < I_MI + I_SQ; it += nwv) { int r = it;
            if (r < I_MI) { transpose_item<2, true>(a.in[9], D, NMLSRC, (bf16*)(ws + WS_WMI), NML / 64, scr, r, lane, mod + 3 * D, bp + BOFF_MI); continue; } r -= I_MI;
            transpose_item<0>(a.in[12], D, D, (bf16*)(ws + WS_WMO), D / 64, scr, r, lane); }
    } else {
        for (int it = wv; it < 3 * I_FI + 3 * I_FO + I_CI + I_SQ; it += nwv) { int r = it;
            if (r < 3 * I_FI) { const int mi = 1 + r / I_FI; r -= (mi - 1) * I_FI;
                const float* sh = mi == 1 ? mod + 6 * D : (mi == 2 ? mod + (size_t)5 * MODW : mod + (size_t)5 * MODW + 6 * D); float* bq = bp + (mi == 1 ? BOFF_F1 : (mi == 2 ? BOFF_F2 : BOFF_F3));
                transpose_item<1, true>(a.in[7] + (size_t)mi * D * NFI, D, NFI, (bf16*)(ws + WS_WFI) + (size_t)mi * NFI * D, NFI / 64, scr, r, lane, sh, bq); continue; } r -= 3 * I_FI;
            if (r < 3 * I_FO) { const int mi = 1 + r / I_FO; r -= (mi - 1) * I_FO; transpose_item<0>(a.in[8] + (size_t)mi * DFF * D, DFF, D, (bf16*)(ws + WS_WFO) + (size_t)mi * D * DFF, D / 64, scr, r, lane); continue; } r -= 3 * I_FO;
            if (r < I_CI) { transpose_item<3, true>(a.in[13], D, NCV, (bf16*)(ws + WS_WCI), NCV / 64, scr, r, lane, mod + (size_t)5 * MODW + 3 * D, bp + BOFF_CI); continue; } r -= I_CI;
            transpose_item<0>(a.in[15], D, D, (bf16*)(ws + WS_WCO), D / 64, scr, r, lane); }
    }
}
__device__ __forceinline__ bool tail_rank(int nwg, int G, int bx, int& rank, int& cnt) { const int rem = nwg % G; if (rem == 0) { rank = bx; cnt = G; return true; } rank = bx - rem; cnt = G - rem; return bx >= rem; }

__device__ __forceinline__ void modreduce_phase(const float* modp, const float* bmod, const float* normg, float* mod, float* gs, float* rgs, int l, int gtid, int NGT) {
    constexpr int NV = 5 * MODW / 4;
    for (int i = gtid; i < NV; i += NGT) { const int b = i / (MODW / 4), c4 = i - b * (MODW / 4), lb = l * 5 + b;
        f32x4 s = *(const f32x4*)(bmod + (size_t)l * MODW + 4 * c4);
        for (int ks = 0; ks < D / 64; ++ks) s += *(const f32x4*)(modp + ((size_t)ks * 10 + lb) * MODW + 4 * c4);
        *(f32x4*)(mod + (size_t)lb * MODW + 4 * c4) = s;
        const int seg = (4 * c4) / D, col = 4 * c4 - seg * D;
        if (seg % 3 == 1) { const int j = seg / 3; const f32x4 gv = *(const f32x4*)(normg + (size_t)(l * 3 + j) * D + col) * (s + 1.0f); const size_t o = ((size_t)(l * 3 + j) * 5 + b) * D + col;
            *(f32x4*)(gs + o) = gv; *(f32x4*)(rgs + o) = (f32x4){1.0f / gv[0], 1.0f / gv[1], 1.0f / gv[2], 1.0f / gv[3]}; } }
}
__device__ __forceinline__ void rowstat_phase(const float* SS, float* rstd, bool ctx_ones, int gtid, int NGT) {
    for (int r = gtid; r < MX; r += NGT) { float t = 0.f;
#pragma unroll
        for (int q = 0; q < 8; ++q) { const f32x4 v = *(const f32x4*)(SS + (size_t)r * 32 + 4 * q); t += (v[0] + v[1]) + (v[2] + v[3]); }
        rstd[r] = 1.0f / sqrtf(t * (1.0f / D) + RMS_EPS); }
    if (ctx_ones) for (int r = MX + gtid; r < MT; r += NGT) rstd[r] = 1.0f;
}
__device__ __forceinline__ void biasreduce_phase(const float* biasp, float* bias, int gtid, int NGT) {
    constexpr int NV = NBCOL / 4;
    for (int i = gtid; i < 6 * NV; i += NGT) { const int b = i / NV, c4 = i - b * NV; f32x4 s = (f32x4){0.f, 0.f, 0.f, 0.f};
        if (b < 5) for (int kb = 0; kb < D / 64; ++kb) s += *(const f32x4*)(biasp + ((size_t)kb * 5 + b) * NBCOL + 4 * c4);
        *(f32x4*)(bias + (size_t)b * NBCOL + 4 * c4) = s; }
}

constexpr int SQ_OFF = 0, SK_OFF = 17408, SKW_OFF = 34816, SV_OFF = 52224, SCB_OFF = 63488, SP_OFF = 85248, STAB_OFF = 94464, SCH_OFF = 146688;
constexpr int QSTR = 272, VSTR = 176, PSTR = 144, CBSZ = 21760, NTOK = 68 * 64;
static_assert(SCH_OFF + 4 * 68 * 4 <= LDSCTL_OFF, "scan LDS");

#define SCAN_BAR() do { asm volatile("s_waitcnt lgkmcnt(0)" ::: "memory"); __builtin_amdgcn_s_barrier(); asm volatile("" ::: "memory"); } while (0)
__device__ __forceinline__ bf16x8 tr_frag(LAS unsigned char* p0, LAS unsigned char* p1) {
    const s16x4 a = __builtin_amdgcn_ds_read_tr16_b64_v4i16((LAS s16x4*)p0), b = __builtin_amdgcn_ds_read_tr16_b64_v4i16((LAS s16x4*)p1);
    return (bf16x8){a[0], a[1], a[2], a[3], b[0], b[1], b[2], b[3]};
}
__device__ __forceinline__ float fexp(float x) { return __builtin_amdgcn_exp2f(1.44269504f * x); }

template <int PROBE> __device__ __forceinline__ void scan_phase(LAS unsigned char* lds, const bf16* QKVO, const float* GATES, bf16* HF, bf16* HBW, int vcu, int G, int tid, int lane, int wave) {
    const int fr = lane & 15, fq = lane >> 4, tq = (lane & 15) >> 2, tp = lane & 3;
    LAS float* cjA = (LAS float*)(lds + STAB_OFF); LAS float* cmA = cjA + NTOK; LAS float* bsA = cmA + NTOK;
    LAS float* chM = (LAS float*)(lds + SCH_OFF); LAS float* chML = chM + 68; LAS float* chBE = chML + 68; LAS float* chMC = chBE + 68;
    for (int u = vcu; u < 256; u += G) {
        const int sl = u & 3, dir = (u >> 2) & 1, h = (u >> 3) & 7, b = u >> 6, e0 = 64 * sl;
        bf16* HO = dir ? HBW : HF;
        const int prow = tid >> 4, pch = tid & 15, vrow = tid >> 3, vch = tid & 7;
        auto row_of = [&](int st) { const bool isc = st < 4; const int ci = isc ? st : st - 4, n = isc ? 4 : 64, ch = dir ? (n - 1 - ci) : ci; return (isc ? MX + b * CTXL : b * SEQ) + ch * 64; };
        f32x4 Cacc[5];
#pragma unroll
        for (int e = 0; e < 5; ++e) Cacc[e] = (f32x4){0.f, 0.f, 0.f, 0.f};
        SCAN_BAR();
        {
            float gi[9], gf[9];
#pragma unroll
            for (int q = 0; q < 9; ++q) { const int st = wave + NWAVES * q; if (st < 68) { const float* gp = GATES + (size_t)(row_of(st) + lane) * 32 + (2 * dir) * 8 + h; gi[q] = gp[0]; gf[q] = gp[8]; } else { gi[q] = 0.f; gf[q] = 0.f; } }
#pragma unroll
            for (int q = 0; q < 9; ++q) { const int st = wave + NWAVES * q; if (st < 68) {
                const float ax = fabsf(gf[q]), ee = fexp(-ax), l1p = (ee < 1e-3f) ? ee * (1.0f - 0.5f * ee) : __logf(1.0f + ee);
                const float f = fminf(gf[q], 0.f) - l1p;
                float bs = f;
#pragma unroll
                for (int o = 1; o < 64; o <<= 1) { const float t = dir ? __shfl_down(bs, o) : __shfl_up(bs, o); const bool ok = dir ? (lane + o < 64) : (lane >= o); bs += ok ? t : 0.f; }
                const float cj = gi[q] - bs; float cm = cj;
#pragma unroll
                for (int o = 1; o < 64; o <<= 1) { const float t = dir ? __shfl_down(cm, o) : __shfl_up(cm, o); const bool ok = dir ? (lane + o < 64) : (lane >= o); cm = ok ? fmaxf(cm, t) : cm; }
                cjA[st * 64 + lane] = cj; cmA[st * 64 + lane] = cm; bsA[st * 64 + lane] = bs;
                if (lane == (dir ? 0 : 63)) { chBE[st] = bs; chMC[st] = cm; } } }
        }
        for (int i = tid; i < CBSZ / 16; i += 512) *(LAS v4u*)(lds + SCB_OFF + 16 * i) = (v4u){0u, 0u, 0u, 0u};
        if (tid < 128) { const int r = tid >> 1; *(LAS v4u*)(lds + SV_OFF + r * VSTR + (8 + (tid & 1)) * 16) = (tid & 1) ? (v4u){0u, 0u, 0u, 0u} : (v4u){0x3F80u, 0u, 0u, 0u}; }
        v4u rq[4][2], rk[4][2], rv[2];
        auto load_qk = [&](int st, v4u (&q)[2], v4u (&k)[2]) { if (st < 68 && (PROBE != 1 || st < 5)) { const int row0 = row_of(st);
#pragma unroll
            for (int i = 0; i < 2; ++i) { const bf16* p = QKVO + (size_t)(row0 + prow + 32 * i) * 6144 + h * DKH + pch * 8; q[i] = *(const v4u*)p; k[i] = *(const v4u*)(p + 1024); } } };
        auto load_v = [&](int st, v4u& v) { if (st < 68 && (PROBE != 1 || st < 2)) v = *(const v4u*)(QKVO + (size_t)(row_of(st) + vrow) * 6144 + 2048 + h * DVH + e0 + vch * 8); };
        { v4u q0[2], k0[2];
          load_qk(0, q0, k0); load_qk(1, rq[1], rk[1]); load_qk(2, rq[2], rk[2]); load_qk(3, rq[3], rk[3]); load_qk(4, rq[0], rk[0]);
          load_v(0, rv[0]); load_v(1, rv[1]);
#pragma unroll
          for (int i = 0; i < 2; ++i) { *(LAS v4u*)(lds + SQ_OFF + (prow + 32 * i) * QSTR + pch * 16) = q0[i]; *(LAS v4u*)(lds + SK_OFF + (prow + 32 * i) * QSTR + pch * 16) = k0[i]; } }
        SCAN_BAR();
        if (tid == 0) { float m = -1e30f; for (int st = 0; st < 68; ++st) { chM[st] = m; const float ML = fmaxf(m, chMC[st]); chML[st] = ML; m = chBE[st] + ML; } }
        SCAN_BAR();
        const int sb = wave & 3, hf = wave >> 2, s_pos = 16 * sb + fr;
        auto step = [&](const int st, const bool isc, v4u (&RQ)[2], v4u (&RK)[2], v4u& RV) {
            const float m_t = chM[st], ML_t = chML[st];
#pragma unroll
            for (int i = 0; i < 2; ++i) { const int r = prow + 32 * i; const float wj = fexp(cjA[st * 64 + r] - ML_t);
                const v4u kraw = *(const LAS v4u*)(lds + SK_OFF + r * QSTR + pch * 16);
                float kf[8]; unpack8(kraw, kf); v4u kw; kw.x = pk2(kf[0] * wj, kf[1] * wj); kw.y = pk2(kf[2] * wj, kf[3] * wj); kw.z = pk2(kf[4] * wj, kf[5] * wj); kw.w = pk2(kf[6] * wj, kf[7] * wj);
                *(LAS v4u*)(lds + SKW_OFF + r * QSTR + pch * 16) = kw; }
            *(LAS v4u*)(lds + SV_OFF + vrow * VSTR + vch * 16) = RV;
            load_v(st + 2, RV);
            f32x4 a2[3]; float Ms = 0.f;
            if (!isc) {
                bf16x8 Yq[4];
#pragma unroll
                for (int ks = 0; ks < 4; ++ks) Yq[ks] = *(const LAS bf16x8*)(lds + SQ_OFF + s_pos * QSTR + (32 * ks + 8 * fq) * 2);
                Ms = fmaxf(m_t, cmA[st * 64 + s_pos]);
#pragma unroll
                for (int jj = 0; jj < 2; ++jj) { const int jb = 2 * hf + jj; f32x4 sacc = (f32x4){0.f, 0.f, 0.f, 0.f};
#pragma unroll
                    for (int ks = 0; ks < 4; ++ks) { const bf16x8 Xk = *(const LAS bf16x8*)(lds + SK_OFF + (16 * jb + fr) * QSTR + (32 * ks + 8 * fq) * 2);
                        sacc = __builtin_amdgcn_mfma_f32_16x16x32_bf16(Xk, Yq[ks], sacc, 0, 0, 0); }
                    const f32x4 c4 = *(const LAS f32x4*)(cjA + st * 64 + 16 * jb + 4 * fq); float p[4];
#pragma unroll
                    for (int r = 0; r < 4; ++r) { const int j_pos = 16 * jb + 4 * fq + r; const bool ok = dir ? (j_pos >= s_pos) : (j_pos <= s_pos); p[r] = sacc[r] * fexp(ok ? (c4[r] - Ms) : -1e30f); }
                    v2u pw; pw.x = pk2(p[0], p[1]); pw.y = pk2(p[2], p[3]);
                    *(LAS v2u*)(lds + SP_OFF + s_pos * PSTR + (16 * jb + 4 * fq) * 2) = pw; }
#pragma unroll
                for (int ti = 0; ti < 3; ++ti) { const int e = (ti == 2) ? 4 : 2 * hf + ti; a2[ti] = (f32x4){0.f, 0.f, 0.f, 0.f};
#pragma unroll
                    for (int ks = 0; ks < 4; ++ks) { const bf16x8 Xc = *(const LAS bf16x8*)(lds + SCB_OFF + (16 * e + fr) * QSTR + (32 * ks + 8 * fq) * 2);
                        a2[ti] = __builtin_amdgcn_mfma_f32_16x16x32_bf16(Xc, Yq[ks], a2[ti], 0, 0, 0); } }
            }
            SCAN_BAR();
            {
                const float decay = fexp(m_t - ML_t);
                bf16x8 Xkw[2], Yp[2];
#pragma unroll
                for (int ks = 0; ks < 2; ++ks) { LAS unsigned char* p = lds + SKW_OFF + (32 * ks + 8 * fq + tq) * QSTR + (16 * wave + 4 * tp) * 2; Xkw[ks] = tr_frag(p, p + 4 * QSTR); }
                if (!isc) {
#pragma unroll
                    for (int ks = 0; ks < 2; ++ks) Yp[ks] = *(const LAS bf16x8*)(lds + SP_OFF + s_pos * PSTR + (32 * ks + 8 * fq) * 2);
                }
                f32x4 o[3];
#pragma unroll
                for (int e = 0; e < 5; ++e) { bf16x8 Yv[2];
#pragma unroll
                    for (int ks = 0; ks < 2; ++ks) { LAS unsigned char* p = lds + SV_OFF + (32 * ks + 8 * fq + tq) * VSTR + (16 * e + 4 * tp) * 2; Yv[ks] = tr_frag(p, p + 4 * VSTR); }
                    if (!isc && (e == 4 || hf == (e >> 1))) { const int ti = (e == 4) ? 2 : (e & 1); f32x4 a1 = (f32x4){0.f, 0.f, 0.f, 0.f};
#pragma unroll
                        for (int ks = 0; ks < 2; ++ks) a1 = __builtin_amdgcn_mfma_f32_16x16x32_bf16(Yv[ks], Yp[ks], a1, 0, 0, 0);
                        o[ti] = a1; }
                    Cacc[e] = Cacc[e] * decay;
#pragma unroll
                    for (int ks = 0; ks < 2; ++ks) Cacc[e] = __builtin_amdgcn_mfma_f32_16x16x32_bf16(Xkw[ks], Yv[ks], Cacc[e], 0, 0, 0);
                    v2u cw; cw.x = pk2(Cacc[e][0], Cacc[e][1]); cw.y = pk2(Cacc[e][2], Cacc[e][3]);
                    *(LAS v2u*)(lds + SCB_OFF + (16 * e + fr) * QSTR + (16 * wave + 4 * fq) * 2) = cw; }
                if (!isc) {
                    const float wint = fexp(m_t - Ms), hden = fexp(-(bsA[st * 64 + s_pos] + Ms));
#pragma unroll
                    for (int ti = 0; ti < 3; ++ti) o[ti] = o[ti] + a2[ti] * wint;
                    const float den = __shfl(o[2][0], fr);
                    const float inv = 1.0f / fmaxf(fabsf(den), hden);
                    const int orow = row_of(st) + s_pos;
#pragma unroll
                    for (int ti = 0; ti < 2; ++ti) { const int e = 2 * hf + ti; const f32x4 hv = o[ti] * inv; v2u w; w.x = pk2(hv[0], hv[1]); w.y = pk2(hv[2], hv[3]);
                        *(v2u*)(HO + (size_t)orow * D + h * DVH + e0 + 16 * e + 4 * fq) = w; }
                }
                if (st + 1 < 68) {
#pragma unroll
                    for (int i = 0; i < 2; ++i) { *(LAS v4u*)(lds + SQ_OFF + (prow + 32 * i) * QSTR + pch * 16) = RQ[i]; *(LAS v4u*)(lds + SK_OFF + (prow + 32 * i) * QSTR + pch * 16) = RK[i]; }
                    load_qk(st + 5, RQ, RK);
                }
            }
            SCAN_BAR();
        };
        for (int g = 0; g < 17; ++g) { const bool isc = (g == 0); const int st = 4 * g;
            step(st, isc, rq[1], rk[1], rv[0]); step(st + 1, isc, rq[2], rk[2], rv[1]); step(st + 2, isc, rq[3], rk[3], rv[0]); step(st + 3, isc, rq[0], rk[0], rv[1]); }
    }
}

constexpr int NPHASES = 24;
__global__ void __launch_bounds__(NWAVES * 64, 2) fwd_kernel(KArgs a) {
    extern __shared__ __attribute__((aligned(16))) unsigned char lds_raw[];
    LAS unsigned char* lds = (LAS unsigned char*)lds_raw;
    const int tid = threadIdx.x, lane = tid & 63, wave = __builtin_amdgcn_readfirstlane(tid >> 6);
    const int G = gridDim.x, bx = blockIdx.x, vcu = (G % 8 == 0) ? (bx % 8) * (G / 8) + bx / 8 : bx;
    const int gw = vcu * NWAVES + wave, NGW = G * NWAVES;
    unsigned char* ws = a.ws;
    unsigned* ctl = (unsigned*)(ws + WS_CTL);
    volatile LAS unsigned* MISC = (volatile LAS unsigned*)(lds + LDSCTL_OFF);
    for (int u = tid; u < (LDS_BYTES - LDSCTL_OFF) / 4; u += NWAVES * 64) ((LAS unsigned*)(lds + LDSCTL_OFF))[u] = 0u;
    __syncthreads();
    XcdBarrier bar; bar.bar = ctl + CW_BAR; bar.x = 0; bar.st = nullptr;
#if !MK_PER_PHASE
    bar = xcd_barrier_post(ctl + CW_BAR, MISC + 8);
#endif
    const int lo = a.ph_lo, hi = a.ph_hi;
#define IN(k) (lo <= (k) && (k) < hi)
#if MK_PER_PHASE
#define SEAM(k) do { } while (0)
#else
#define SEAM(k) do { if (IN(k) && IN((k) + 1)) xcd_barrier(bar); } while (0)
#endif
#define x_in (a.in[0])
#define ctx_in (a.in[2])
#define X ((float*)(ws + WS_X))
#define HB ((bf16*)(ws + WS_HB))
#define ACT ((bf16*)(ws + WS_ACT))
#define QKVO ((bf16*)(ws + WS_QKVO))
#define GATES ((float*)(ws + WS_GATES))
#define HF ((bf16*)(ws + WS_HF))
#define HBW ((bf16*)(ws + WS_HBW))
#define mod ((const float*)(ws + WS_MOD))
#define WFI ((const bf16*)(ws + WS_WFI))
#define WFO ((const bf16*)(ws + WS_WFO))
#define normg (a.in[6])
#define GS ((float*)(ws + WS_GS))
#define SS ((float*)(ws + WS_SS))
#define RSTD ((float*)(ws + WS_RSTD))
#define BIAS ((float*)(ws + WS_BIAS))
#define YB ((bf16*)(ws + WS_ACT))
#define BG ((bf16*)(ws + WS_QKVO))
#define ZB ((bf16*)(ws + WS_QKVO) + (size_t)MX * D)
    const int gtid = bx * NWAVES * 64 + tid, NGT = G * NWAVES * 64;
    if (IN(0)) { mod_partials(a, 0, gw, NGW, lane); mod_partials(a, 1, gw, NGW, lane); convert_list<0>(a, lds, gw, NGW, wave, lane); }
    SEAM(0);
    if (IN(1)) { modreduce_phase((const float*)(ws + WS_MODP), a.in[5], normg, (float*)(ws + WS_MOD), GS, (float*)(ws + WS_RGS), 0, gtid, NGT); modreduce_phase((const float*)(ws + WS_MODP), a.in[5], normg, (float*)(ws + WS_MOD), GS, (float*)(ws + WS_RGS), 1, gtid, NGT); }
    SEAM(1);
#define FFN_UP(p, wi, rows, FOLDV, boff) do { if (IN(p)) { pg8::Gemm g{HB, WFI + (size_t)(wi) * NFI * D, rows, NFI, D}; pg8::StaticOrder S; S.init(rows, NFI, G, bx, D); \
        pg8::EpiSwigluT<FOLDV> E{ACT, DFF, pg8::Fold{ws, (boff)}}; pg8::gemm_phase<pg8::EpiSwigluT<FOLDV>, pg8::StaticOrder, true, true>(lds, g, S, E); } SEAM(p); } while (0)
#define FFN_DOWN(p, wi, l, j, SRCV, NEXTV, nsub) do { if (IN(p)) { pg8::Gemm g{ACT, WFO + (size_t)(wi) * D * DFF, MX, D, DFF}; pg8::StaticOrder S; S.init(MX, D, G, bx, DFF, 4); \
        pg8::EpiResidT<SRCV, NEXTV, true> E{x_in, ctx_in, ws, (l) * 5 * MODW + (3 * (j) + 2) * D, (l) * 3 + (j), (nsub)}; \
        pg8::gemm_phase<pg8::EpiResidT<SRCV, NEXTV, true>, pg8::StaticOrder, true, true>(lds, g, S, E); } } while (0)

    if (IN(2)) normmod_phase(x_in, ctx_in, MT, normg + (0 * 3 + 0) * D, mod, 0, HB, gw, NGW, lane);
    SEAM(2);
    FFN_UP(3, 0, MT, false, 0);
    if (IN(4)) { FFN_DOWN(4, 0, 0, 0, true, true, 1);
        { pg8::Gemm g{ACT, WFO, MT, D, DFF}; pg8::SplitKOrder S{G, bx, MX / 256};
          pg8::EpiPartial E{(float*)(ws + WS_CTXP), MX, (size_t)MC * D};
          pg8::gemm_phase<pg8::EpiPartial, pg8::SplitKOrder, true, true>(lds, g, S, E); } }
    SEAM(4);
    if (IN(4)) { convert_list<1>(a, lds, gw, NGW, wave, lane); convert_list<2>(a, lds, gw, NGW, wave, lane); if (IN(5)) xcd_barrier(bar); }
    if (IN(5)) { rowstat_phase(SS, RSTD, true, gtid, NGT); biasreduce_phase((const float*)(ws + WS_BIASP), BIAS, gtid, NGT);
        normmod_phase(X, ctx_in, MT, normg + (0 * 3 + 1) * D, mod, 1, HB, gw, NGW, lane, (const float*)(ws + WS_CTXP), mod + (size_t)4 * MODW + (3 * 0 + 2) * D, MX); }
    SEAM(5);
    if (IN(6)) { pg8::Gemm g{HB, (const bf16*)(ws + WS_WMI), MT, NML, D}; pg8::StaticOrder S; S.init(MT, NML, G, bx, D); pg8::EpiMlstmInT<true> E{QKVO, GATES, a.in[10], pg8::Fold{ws, BOFF_MI}};
        pg8::gemm_phase<pg8::EpiMlstmInT<true>, pg8::StaticOrder, true, true>(lds, g, S, E); }
    SEAM(6);
    if (PROBE_DUP == 6) { pg8::Gemm g{HB, (const bf16*)(ws + WS_WMI), MT, NML, D}; pg8::StaticOrder S; S.init(MT, NML, G, bx, D); pg8::EpiMlstmInT<true> E{QKVO, GATES, a.in[10], pg8::Fold{ws, BOFF_MI}};
        pg8::gemm_phase<pg8::EpiMlstmInT<true>, pg8::StaticOrder, true, true>(lds, g, S, E); xcd_barrier(bar); }
    if (IN(7)) scan_phase<0>(lds, QKVO, GATES, HF, HBW, vcu, G, tid, lane, wave);
    SEAM(7);
    if (IN(8)) headnorm_phase(HF, HBW, QKVO, a.in[11], YB, gw, NGW, lane);
    SEAM(8);
    if (PROBE_DUP == 8) { headnorm_phase(HF, HBW, QKVO, a.in[11], YB, gw, NGW, lane); xcd_barrier(bar); }
    if (IN(9)) { pg8::Gemm g{YB, (const bf16*)(ws + WS_WMO), MX, D, D}; pg8::StaticOrder S; S.init(MX, D, G, bx, D, 4);
        pg8::EpiResidT<false, true, false> E{x_in, ctx_in, ws, (3 * 1 + 2) * D, 1, 2};
        pg8::gemm_phase<pg8::EpiResidT<false, true, false>, pg8::StaticOrder, true, true>(lds, g, S, E); }
    SEAM(9);
    if (IN(10)) rowstat_phase(SS, RSTD, false, gtid, NGT);
    SEAM(10);
    FFN_UP(11, 1, MX, true, BOFF_F1);
    FFN_DOWN(12, 1, 0, 2, false, true, 3); SEAM(12);
    if (PROBE_DUP == 12) { pg8::Gemm g{ACT, WFO + (size_t)1 * D * DFF, MX, D, DFF}; pg8::StaticOrder S; S.init(MX, D, G, bx, DFF); pg8::EpiPartial E{(float*)(ws + WS_QKVO), 0, (size_t)0};
        pg8::gemm_phase<pg8::EpiPartial, pg8::StaticOrder, true, true>(lds, g, S, E); xcd_barrier(bar); }
    if (IN(13)) rowstat_phase(SS, RSTD, false, gtid, NGT);
    SEAM(13);
    FFN_UP(14, 2, MX, true, BOFF_F2);
    FFN_DOWN(15, 2, 1, 0, false, true, 4); SEAM(15);
    if (IN(16)) rowstat_phase(SS, RSTD, false, gtid, NGT);
    SEAM(16);
    if (IN(17)) { pg8::Gemm g{HB, (const bf16*)(ws + WS_WCI), MX, NCV, D}; pg8::StaticOrder S; S.init(MX, NCV, G, bx, D); pg8::EpiConvInT<true> E{BG, ZB, pg8::Fold{ws, BOFF_CI}};
        pg8::gemm_phase<pg8::EpiConvInT<true>, pg8::StaticOrder, true, true>(lds, g, S, E); }
    SEAM(17);
    if (IN(18)) convmix_phase(BG, ZB, a.in[14], YB, gw, NGW, lane);
    SEAM(18);
    if (IN(19)) { pg8::Gemm g{YB, (const bf16*)(ws + WS_WCO), MX, D, D}; pg8::StaticOrder S; S.init(MX, D, G, bx, D, 4);
        pg8::EpiResidT<false, true, false> E{x_in, ctx_in, ws, 5 * MODW + (3 * 1 + 2) * D, 4, 5};
        pg8::gemm_phase<pg8::EpiResidT<false, true, false>, pg8::StaticOrder, true, true>(lds, g, S, E); }
    SEAM(19);
    if (IN(20)) rowstat_phase(SS, RSTD, false, gtid, NGT);
    SEAM(20);
    FFN_UP(21, 3, MX, true, BOFF_F3);
    FFN_DOWN(22, 3, 1, 2, false, false, 0); SEAM(22);
    if (IN(23)) final_norm_phase(X, a.in[16], a.out, gw, NGW, lane);
#undef FFN_UP
#undef FFN_DOWN
#undef x_in
#undef ctx_in
#undef X
#undef HB
#undef ACT
#undef QKVO
#undef GATES
#undef HF
#undef HBW
#undef mod
#undef WFI
#undef WFO
#undef normg
#undef GS
#undef SS
#undef RSTD
#undef BIAS
#undef YB
#undef BG
#undef ZB
#undef IN
#undef SEAM
}

extern "C" void kernel_launch(void* const* d_in, const int* in_sizes, int n_in, void* d_out, int out_size, void* d_ws, size_t ws_size, hipStream_t stream) {
    static int grid = 0;
    if (grid == 0) {
        if (n_in != 17 || in_sizes[0] != MX * D || out_size != MX * D || ws_size < WS_END) { fprintf(stderr, "kernel_launch: unexpected shapes (n_in %d, in0 %d, out %d, ws %zu)\n", n_in, n_in > 0 ? in_sizes[0] : -1, out_size, ws_size); grid = -1; return; }
        int dev = 0, cus = 0, per_cu = 0;
        if (hipGetDevice(&dev) != hipSuccess || hipDeviceGetAttribute(&cus, hipDeviceAttributeMultiprocessorCount, dev) != hipSuccess) { fprintf(stderr, "kernel_launch: device query failed\n"); grid = -1; return; }
        if (hipFuncSetAttribute((const void*)fwd_kernel, hipFuncAttributeMaxDynamicSharedMemorySize, LDS_BYTES) != hipSuccess) { fprintf(stderr, "kernel_launch: hipFuncSetAttribute failed\n"); grid = -1; return; }
        if (hipOccupancyMaxActiveBlocksPerMultiprocessor(&per_cu, (const void*)fwd_kernel, NWAVES * 64, LDS_BYTES) != hipSuccess || per_cu < 1) { fprintf(stderr, "kernel_launch: occupancy query reports %d workgroups per CU\n", per_cu); }
        (void)hipGetLastError();
        grid = cus;
    }
    if (grid < 0) return;
    if (hipMemsetAsync((char*)d_ws + WS_CTL, 0, CTL_ZERO_BYTES, stream) != hipSuccess) { fprintf(stderr, "kernel_launch: memset failed\n"); return; }
    KArgs a{};
    for (int i = 0; i < 17; ++i) a.in[i] = (const float*)d_in[i];
    a.out = (float*)d_out; a.ws = (unsigned char*)d_ws;
#if MK_PER_PHASE
    for (int p = 0; p < NPHASES; ++p) { a.ph_lo = p; a.ph_hi = p + 1; hipLaunchKernelGGL(fwd_kernel, dim3(grid), dim3(NWAVES * 64), LDS_BYTES, stream, a); }
#else
    a.ph_lo = 0; a.ph_hi = NPHASES;
    hipLaunchKernelGGL(fwd_kernel, dim3(grid), dim3(NWAVES * 64), LDS_BYTES, stream, a);
#endif
    const hipError_t le = hipPeekAtLastError();
    if (le != hipSuccess) fprintf(stderr, "kernel_launch: launch failed: %s\n", hipGetErrorName(le));
}
```

```cpp
#include <hip/hip_runtime.h>
#include <cstdio>
#include <cstdint>

#ifndef PROBE_DUP
#define PROBE_DUP -1
#endif
#ifndef TAILS
#define TAILS 0
#endif
#ifndef MK_PER_PHASE
#define MK_PER_PHASE 0
#endif

constexpr int NWAVES = 8;
constexpr int BATCH = 4, SEQ = 4096, D = 2048, CTXL = 256, NH = 8, DKH = 128, DVH = 256, DFF = 5504;
constexpr int MX = BATCH * SEQ, MC = BATCH * CTXL, MT = MX + MC;
constexpr int NFI = 2 * DFF;
constexpr int NML = 6400, NMLSRC = 6176, NCV = 6144;
constexpr int MODW = 9 * D;
constexpr float RMS_EPS = 1e-6f;
__host__ __device__ __forceinline__ size_t hb_off(int r, int c) { return (((size_t)(r >> 8) * (D / 64) + (c >> 6)) * 256 + (r & 255)) * 64 + (c & 63); }

constexpr size_t MiB = 1u << 20;
constexpr size_t WS_CTL = 0, CTL_ZERO_BYTES = 64 * 1024;
constexpr size_t WS_MOD = 1 * MiB;
constexpr size_t WS_WFI = 2 * MiB;
constexpr size_t WS_WFO = 174 * MiB;
constexpr size_t WS_WMI = 260 * MiB;
constexpr size_t WS_WMO = 285 * MiB;
constexpr size_t WS_WCI = 293 * MiB;
constexpr size_t WS_WCO = 317 * MiB;
constexpr size_t WS_X = 326 * MiB;
constexpr size_t WS_HB = 462 * MiB;
constexpr size_t WS_ACT = 530 * MiB;
constexpr size_t WS_QKVO = 713 * MiB;
constexpr size_t QH_OFF = 0, KH_OFF = (size_t)17408 * 1024, VH_OFF = (size_t)17408 * 2048, OG_OFF = (size_t)17408 * 4096;
constexpr int CTX_SLOT0 = 4 * 8 * 4096;
constexpr size_t WS_GATES = 917 * MiB;
constexpr size_t WS_HF = 920 * MiB, WS_HBW = 984 * MiB;
constexpr size_t WS_MODP = WS_HF;
constexpr size_t WS_CTXP = 1048 * MiB;
constexpr int NBCOL = 45568;
constexpr int BOFF_MI = 0, BOFF_F1 = 6400, BOFF_F2 = 17408, BOFF_CI = 28416, BOFF_F3 = 34560;
constexpr size_t WS_BIASP = 1112 * MiB;
constexpr size_t WS_BIAS = 1142 * MiB;
constexpr size_t WS_GS = 1144 * MiB;
constexpr size_t WS_RGS = 1144 * MiB + 512 * 1024;
constexpr size_t WS_SS = 1145 * MiB;
constexpr size_t WS_RSTD = 1148 * MiB;
constexpr size_t WS_END = 1149 * MiB;
constexpr int CW_BAR = 4096;

namespace pg8 {
#define PG8_LAS __attribute__((address_space(3)))
typedef unsigned short bf16_t;
typedef short bf16x8 __attribute__((ext_vector_type(8)));
typedef float f32x4 __attribute__((ext_vector_type(4)));
typedef unsigned u32x4 __attribute__((ext_vector_type(4)));
constexpr int BM = 256, BK = 64, HALF = 128, HTB = HALF * BK * 2, STAGE_BYTES = 8 * HTB, NXCD = 8, WGM = 8;

__host__ __device__ __forceinline__ int lds_byte(int r, int c) { const int st = (r >> 4) * 2 + (c >> 5), rr = r & 15, cc = c & 31, ob = rr * 64 + cc * 2; return st * 1024 + (ob ^ (((ob >> 9) & 1) << 5)); }
__host__ __device__ __forceinline__ void stage_rc(int b, int& R, int& C) { const int st = b / 1024, sb = b % 1024, swz = sb ^ (((sb >> 9) & 1) << 5); R = (st >> 1) * 16 + swz / 64; C = (st & 1) * 32 + (swz % 64) / 2; }
__host__ __device__ __forceinline__ int perm32(int rho) { const int n = rho >> 4, i = rho & 15; return 8 * (i >> 2) + 4 * n + (i & 3); }

struct Unit { int pm, pn, k0, nt; };
struct Gemm { const bf16_t* A; const bf16_t* Bt; int M, N, K; };

struct StaticOrder {
    int nM, nN, nwg, G, c, ntk, wgm;
    __host__ __device__ void init(int M, int N, int G_, int c_, int K_, int wgm_ = WGM) { nM = M / BM; nN = N / BM; nwg = nM * nN; G = G_; c = c_; ntk = K_ / BK; wgm = wgm_; }
    __host__ __device__ bool next(int i, Unit& u) const {
        const long L = (long)i * G + c; if (L >= nwg) return false;
        int wgid = (int)L; { const int q = nwg / NXCD, r = nwg % NXCD, xcd = wgid % NXCD, off = wgid / NXCD; wgid = (xcd < r ? xcd * (q + 1) : r * (q + 1) + (xcd - r) * q) + off; }
        const int nig = wgm * nN, gid = wgid / nig, fm = gid * wgm, gsz = (nM - fm) < wgm ? (nM - fm) : wgm;
        u.pm = fm + ((wgid % nig) % gsz); u.pn = (wgid % nig) / gsz; u.k0 = 0; u.nt = ntk; return true;
    }
    __device__ __forceinline__ void a_ready(const Unit&) const {}
    __device__ __forceinline__ void done(const Unit&) const {}
};

typedef __bf16 bf16x2_t __attribute__((ext_vector_type(2)));
typedef float f32x2_t __attribute__((ext_vector_type(2)));
struct SplitKOrder {
    int G, c, pm0;
    __device__ __forceinline__ bool next(int i, Unit& u) const { const long L = (long)i * G + c; if (L >= 256) return false; const int w = (int)L, sl = w & 7, tile = w >> 3;
        u.pm = pm0 + (tile >> 3); u.pn = tile & 7; const int p0 = sl < 5 ? 5 * sl : 25 + 6 * (sl - 5), np = sl < 5 ? 5 : 6; u.k0 = p0 * 128; u.nt = np * 2; return true; }
    __device__ __forceinline__ void a_ready(const Unit&) const {}
    __device__ __forceinline__ void done(const Unit&) const {}
};
__device__ __forceinline__ unsigned cvt_pk_bf16(float lo, float hi) { const f32x2_t v = {lo, hi}; const bf16x2_t b = __builtin_convertvector(v, bf16x2_t); return __builtin_bit_cast(unsigned, b); }
__device__ __forceinline__ float silu_f(float x) { return x * __builtin_amdgcn_rcpf(1.0f + __builtin_amdgcn_exp2f(-1.44269504f * x)); }
__device__ __forceinline__ unsigned swiglu_pk(float ga, float gb, float ua, float ub) {
    const f32x2_t g = {ga, gb}, u = {ua, ub}; const f32x2_t t = g * (f32x2_t){-1.44269504f, -1.44269504f};
    const f32x2_t e = {__builtin_amdgcn_exp2f(t[0]), __builtin_amdgcn_exp2f(t[1])}; const f32x2_t d = e + (f32x2_t){1.0f, 1.0f};
    const f32x2_t r = {__builtin_amdgcn_rcpf(d[0]), __builtin_amdgcn_rcpf(d[1])}; const f32x2_t o = (g * u) * r;
    const bf16x2_t b = __builtin_convertvector(o, bf16x2_t); return __builtin_bit_cast(unsigned, b); }


struct Fold { const unsigned char* ws; int boff;
    __device__ __forceinline__ const float* rstd() const { return (const float*)(ws + WS_RSTD); }
    __device__ __forceinline__ const float* bias(int bidx) const { return (const float*)(ws + WS_BIAS) + (size_t)bidx * NBCOL + boff; }
    __device__ __forceinline__ void rows8(int row0, float (&rs)[2][4]) const {
#pragma unroll
        for (int ai = 0; ai < 2; ++ai)
#pragma unroll
            for (int m = 0; m < 4; ++m) rs[ai][m] = rstd()[row0 + ai * HALF + m * 16]; } };
template <bool FOLD> struct EpiSwigluT {
    static constexpr bool PERM = true, AFTER_DRAIN = false; static constexpr int NSTORE = 8;
    bf16_t* O; int ldc; Fold F;
    __device__ __forceinline__ void operator()(const f32x4 (&acc)[2][2][4][2], const Unit& u, int wr, int wc, int fr, int fq) const {
        const int row0 = u.pm * BM + wr * 64 + fr, col0 = u.pn * HALF + wc * 32 + 8 * fq;
        f32x4 bg[2], bu[2];
        if (FOLD) { const int bidx = (u.pm * BM >= MX) ? 5 : (u.pm >> 4); const float* bp = F.bias(bidx) + u.pn * BM + wc * 32 + 8 * fq;
            bg[0] = *(const f32x4*)bp; bg[1] = *(const f32x4*)(bp + 4); bu[0] = *(const f32x4*)(bp + HALF); bu[1] = *(const f32x4*)(bp + HALF + 4); }
        float rsv[2][4]; if (FOLD) F.rows8(row0, rsv);
#pragma unroll
        for (int ai = 0; ai < 2; ++ai)
#pragma unroll
            for (int m = 0; m < 4; ++m) { const int r = row0 + ai * HALF + m * 16; bf16_t* rowp = O + (((size_t)u.pm * (ldc / BK) + (col0 >> 6)) * BM + (r & (BM - 1))) * BK + (col0 & (BK - 1));
                f32x4 g0 = acc[ai][0][m][0], g1 = acc[ai][0][m][1], u0 = acc[ai][1][m][0], u1 = acc[ai][1][m][1];
                if (FOLD) { const float rs = rsv[ai][m]; g0 = g0 * rs + bg[0]; g1 = g1 * rs + bg[1]; u0 = u0 * rs + bu[0]; u1 = u1 * rs + bu[1]; }
                u32x4 w; w.x = swiglu_pk(g0[0], g0[1], u0[0], u0[1]); w.y = swiglu_pk(g0[2], g0[3], u0[2], u0[3]);
                w.z = swiglu_pk(g1[0], g1[1], u1[0], u1[1]); w.w = swiglu_pk(g1[2], g1[3], u1[2], u1[3]);
                *(u32x4*)rowp = w; }
    }
};
template <bool SRC32, bool NEXT, bool HALFC> struct EpiResidT {
    static constexpr bool PERM = true, AFTER_DRAIN = false; static constexpr int NSTORE = 16;
    const float* xin_x; const float* xin_c; unsigned char* ws; int gate_off, psub, nsub;
    __device__ __forceinline__ void operator()(const f32x4 (&acc)[2][2][4][2], const Unit& u, int wr, int wc, int fr, int fq) const {
        const bool isc = (u.pm * BM) >= MX; const int bidx = isc ? 4 : (u.pm >> 4); const float coef = HALFC ? 0.5f : 1.0f;
        float* X = (float*)(ws + WS_X); bf16_t* XS = (bf16_t*)(ws + WS_HB); float* SS = (float*)(ws + WS_SS);
        const float* gv = (const float*)(ws + WS_MOD) + gate_off + (size_t)bidx * MODW; const float* gs = (const float*)(ws + WS_GS) + ((size_t)nsub * 5 + bidx) * D;
        const float* rg = (const float*)(ws + WS_RGS) + ((size_t)psub * 5 + bidx) * D;
        const int col0 = u.pn * BM + wc * 32 + 8 * fq; const int row0 = u.pm * BM + wr * 64 + fr;
        f32x4 gg[2][2], gsv[2][2], rgv[2][2];
#pragma unroll
        for (int bj = 0; bj < 2; ++bj)
#pragma unroll
            for (int n = 0; n < 2; ++n) { gg[bj][n] = *(const f32x4*)(gv + col0 + bj * HALF + 4 * n) * coef; if (NEXT) gsv[bj][n] = *(const f32x4*)(gs + col0 + bj * HALF + 4 * n);
                if (!SRC32) rgv[bj][n] = *(const f32x4*)(rg + col0 + bj * HALF + 4 * n); }
#pragma unroll
        for (int ai = 0; ai < 2; ++ai)
#pragma unroll
            for (int m = 0; m < 4; ++m) { const int r = row0 + ai * HALF + m * 16; float sq = 0.f;
                const float* src = (isc ? xin_c + (size_t)(r - MX) * D : xin_x + (size_t)r * D) + col0;
#pragma unroll
                for (int bj = 0; bj < 2; ++bj) { const size_t eo = (size_t)r * D + col0 + bj * HALF, xe = hb_off(r, col0 + bj * HALF); f32x4 xo0, xo1;
                    if (SRC32) { xo0 = __builtin_nontemporal_load((const f32x4*)(src + bj * HALF)); xo1 = __builtin_nontemporal_load((const f32x4*)(src + bj * HALF + 4)); }
                    else { const u32x4 w = *(const u32x4*)(XS + xe);
                        xo0 = (f32x4){__builtin_bit_cast(float, w.x << 16), __builtin_bit_cast(float, w.x & 0xffff0000u), __builtin_bit_cast(float, w.y << 16), __builtin_bit_cast(float, w.y & 0xffff0000u)} * rgv[bj][0];
                        xo1 = (f32x4){__builtin_bit_cast(float, w.z << 16), __builtin_bit_cast(float, w.z & 0xffff0000u), __builtin_bit_cast(float, w.w << 16), __builtin_bit_cast(float, w.w & 0xffff0000u)} * rgv[bj][1]; }
                    const f32x4 xn0 = xo0 + acc[ai][bj][m][0] * gg[bj][0], xn1 = xo1 + acc[ai][bj][m][1] * gg[bj][1];
                    if (NEXT) { const f32x4 y0 = xn0 * gsv[bj][0], y1 = xn1 * gsv[bj][1]; u32x4 w; w.x = cvt_pk_bf16(y0[0], y0[1]); w.y = cvt_pk_bf16(y0[2], y0[3]); w.z = cvt_pk_bf16(y1[0], y1[1]); w.w = cvt_pk_bf16(y1[2], y1[3]);
                        *(u32x4*)(XS + xe) = w; sq += ((xn0[0] * xn0[0] + xn0[1] * xn0[1]) + (xn0[2] * xn0[2] + xn0[3] * xn0[3])) + ((xn1[0] * xn1[0] + xn1[1] * xn1[1]) + (xn1[2] * xn1[2] + xn1[3] * xn1[3])); }
                    else { *(f32x4*)(X + eo) = xn0; *(f32x4*)(X + eo + 4) = xn1; } }
                if (NEXT) { sq += __shfl_xor(sq, 16); sq += __shfl_xor(sq, 32); if (fq == 0) SS[(size_t)r * 32 + u.pn * 4 + wc] = sq; }
                if (SRC32 && m == 3) asm volatile("" ::: "memory"); }
    }
};
struct EpiPartial {
    static constexpr bool PERM = false, AFTER_DRAIN = false; static constexpr int NSTORE = 32;
    float* P; int row0; size_t slice_stride;
    __device__ __forceinline__ void operator()(const f32x4 (&acc)[2][2][4][2], const Unit& u, int wr, int wc, int fr, int fq) const {
        const int sl = u.k0 < 25 * 128 ? u.k0 / (5 * 128) : 5 + (u.k0 - 25 * 128) / (6 * 128);
        float* base = P + (size_t)sl * slice_stride; const int col0 = u.pn * BM + wc * 32 + 4 * fq, r0 = u.pm * BM - row0 + wr * 64 + fr;
#pragma unroll
        for (int ai = 0; ai < 2; ++ai)
#pragma unroll
            for (int m = 0; m < 4; ++m) { float* rowp = base + (size_t)(r0 + ai * HALF + m * 16) * 2048 + col0;
#pragma unroll
                for (int bj = 0; bj < 2; ++bj)
#pragma unroll
                    for (int n = 0; n < 2; ++n) *(f32x4*)(rowp + bj * HALF + n * 16) = acc[ai][bj][m][n]; }
    }
};
template <bool FOLD> struct EpiMlstmInT {
    static constexpr bool PERM = true, AFTER_DRAIN = false; static constexpr int NSTORE = 0;
    bf16_t* O; float* G; const float* bgate; Fold F;
    __device__ __forceinline__ void operator()(const f32x4 (&acc)[2][2][4][2], const Unit& u, int wr, int wc, int fr, int fq) const {
        const int row0 = u.pm * BM + wr * 64 + fr;
        f32x4 bv[2][2];
#pragma unroll
        for (int bj = 0; bj < 2; ++bj)
#pragma unroll
            for (int n = 0; n < 2; ++n) bv[bj][n] = (f32x4){0.f, 0.f, 0.f, 0.f};
        if (FOLD) { const int bidx = (u.pm * BM >= MX) ? 5 : (u.pm >> 4); const float* bp = F.bias(bidx) + u.pn * BM + wc * 32 + 8 * fq;
#pragma unroll
            for (int bj = 0; bj < 2; ++bj)
#pragma unroll
                for (int n = 0; n < 2; ++n) bv[bj][n] = *(const f32x4*)(bp + bj * HALF + 4 * n); }
        if (u.pn < 24) {
            const bool isc = u.pm * BM >= MX; const int slot0 = isc ? CTX_SLOT0 + (u.pm - MX / BM) * 8 * 256 : (u.pm >> 4) * 8 * 4096 + (u.pm & 15) * 256, hstride = isc ? 256 : 4096, rr0 = wr * 64 + fr;
            bf16_t* pb[2];
#pragma unroll
            for (int bj = 0; bj < 2; ++bj) {
                if (u.pn < 4) pb[bj] = O + QH_OFF + ((size_t)slot0 + (size_t)(2 * u.pn + bj) * hstride) * 128 + wc * 32 + 8 * fq;
                else if (u.pn < 8) pb[bj] = O + KH_OFF + ((size_t)slot0 + (size_t)(2 * (u.pn - 4) + bj) * hstride) * 128 + wc * 32 + 8 * fq;
                else if (u.pn < 16) pb[bj] = O + VH_OFF + ((size_t)slot0 + (size_t)(u.pn - 8) * hstride) * 256 + bj * HALF + wc * 32 + 8 * fq;
                else pb[bj] = O + OG_OFF + (size_t)(u.pm * BM) * 2048 + (u.pn - 16) * BM + bj * HALF + wc * 32 + 8 * fq; }
            const int rpitch = u.pn < 8 ? 128 : (u.pn < 16 ? 256 : 2048);
#pragma unroll
            for (int ai = 0; ai < 2; ++ai) { float rs4[4];
#pragma unroll
                for (int m = 0; m < 4; ++m) rs4[m] = FOLD ? F.rstd()[u.pm * BM + rr0 + ai * HALF + m * 16] : 1.0f;
#pragma unroll
                for (int m = 0; m < 4; ++m) { const int rr = rr0 + ai * HALF + m * 16; const float rs = rs4[m];
#pragma unroll
                    for (int bj = 0; bj < 2; ++bj) { f32x4 v0 = acc[ai][bj][m][0], v1 = acc[ai][bj][m][1]; if (FOLD) { v0 = v0 * rs + bv[bj][0]; v1 = v1 * rs + bv[bj][1]; }
                        u32x4 w; w.x = cvt_pk_bf16(v0[0], v0[1]); w.y = cvt_pk_bf16(v0[2], v0[3]); w.z = cvt_pk_bf16(v1[0], v1[1]); w.w = cvt_pk_bf16(v1[2], v1[3]);
                        *(u32x4*)(pb[bj] + (size_t)rr * rpitch) = w; } } }
        } else if (wc == 0) {
            float rsv[2][4]; if (FOLD) F.rows8(row0, rsv);
            const f32x4 b0 = *(const f32x4*)(bgate + 8 * fq) + bv[0][0], b1 = *(const f32x4*)(bgate + 8 * fq + 4) + bv[0][1];
#pragma unroll
            for (int ai = 0; ai < 2; ++ai)
#pragma unroll
                for (int m = 0; m < 4; ++m) { const int r = row0 + ai * HALF + m * 16; float* rowp = G + (size_t)r * 32 + 8 * fq; const float rs = FOLD ? rsv[ai][m] : 1.0f;
                    *(f32x4*)rowp = acc[ai][0][m][0] * rs + b0; *(f32x4*)(rowp + 4) = acc[ai][0][m][1] * rs + b1; }
        }
    }
};
template <bool FOLD> struct EpiConvInT {
    static constexpr bool PERM = true, AFTER_DRAIN = false; static constexpr int NSTORE = 8;
    bf16_t* BG; bf16_t* Z; Fold F;
    __device__ __forceinline__ void operator()(const f32x4 (&acc)[2][2][4][2], const Unit& u, int wr, int wc, int fr, int fq) const {
        const int row0 = u.pm * BM + wr * 64 + fr;
        f32x4 bv[2][2];
#pragma unroll
        for (int bj = 0; bj < 2; ++bj)
#pragma unroll
            for (int n = 0; n < 2; ++n) bv[bj][n] = (f32x4){0.f, 0.f, 0.f, 0.f};
        if (FOLD) { const int bidx = (u.pm * BM >= MX) ? 5 : (u.pm >> 4); const float* bp = F.bias(bidx) + u.pn * BM + wc * 32 + 8 * fq;
#pragma unroll
            for (int bj = 0; bj < 2; ++bj)
#pragma unroll
                for (int n = 0; n < 2; ++n) bv[bj][n] = *(const f32x4*)(bp + bj * HALF + 4 * n); }
        float rsv[2][4]; if (FOLD) F.rows8(row0, rsv);
        if (u.pn < 8) {
            const int col0 = u.pn * BM + wc * 32 + 8 * fq;
#pragma unroll
            for (int ai = 0; ai < 2; ++ai)
#pragma unroll
                for (int m = 0; m < 4; ++m) { const int r = row0 + ai * HALF + m * 16; bf16_t* rowp = BG + (size_t)r * 2048 + col0; const float rs = FOLD ? rsv[ai][m] : 1.0f;
#pragma unroll
                    for (int bj = 0; bj < 2; ++bj) { f32x4 v0 = acc[ai][bj][m][0], v1 = acc[ai][bj][m][1]; if (FOLD) { v0 = v0 * rs + bv[bj][0]; v1 = v1 * rs + bv[bj][1]; }
                        u32x4 w; w.x = cvt_pk_bf16(v0[0], v0[1]); w.y = cvt_pk_bf16(v0[2], v0[3]); w.z = cvt_pk_bf16(v1[0], v1[1]); w.w = cvt_pk_bf16(v1[2], v1[3]);
                        *(u32x4*)(rowp + bj * HALF) = w; } }
        } else {
            const int col0 = (u.pn - 8) * HALF + wc * 32 + 8 * fq;
#pragma unroll
            for (int ai = 0; ai < 2; ++ai)
#pragma unroll
                for (int m = 0; m < 4; ++m) { const int r = row0 + ai * HALF + m * 16; bf16_t* rowp = Z + (size_t)r * 2048 + col0; const float rs = FOLD ? rsv[ai][m] : 1.0f;
                    f32x4 c0 = acc[ai][0][m][0], c1 = acc[ai][0][m][1], u0 = acc[ai][1][m][0], u1 = acc[ai][1][m][1];
                    if (FOLD) { c0 = c0 * rs + bv[0][0]; c1 = c1 * rs + bv[0][1]; u0 = u0 * rs + bv[1][0]; u1 = u1 * rs + bv[1][1]; }
                    const f32x4 v0 = c0 * u0, v1 = c1 * u1;
                    u32x4 w; w.x = cvt_pk_bf16(v0[0], v0[1]); w.y = cvt_pk_bf16(v0[2], v0[3]); w.z = cvt_pk_bf16(v1[0], v1[1]); w.w = cvt_pk_bf16(v1[2], v1[3]);
                    *(u32x4*)rowp = w; }
        }
    }
};

template <class Epi, class Sched, bool ALIGN_EPI = false, bool SP2 = false, bool TILED = false>
__device__ __forceinline__ void gemm_phase(PG8_LAS unsigned char* lds, const Gemm g, const Sched& S, const Epi& E) {
    const int tid = threadIdx.x, wid = __builtin_amdgcn_readfirstlane(tid >> 6), lane = tid & 63, wr = wid >> 2, wc = wid & 3, fr = lane & 15, fq = lane >> 4;
    const int K = g.K;
    unsigned voffA[2], voffB[2];
#pragma unroll
    for (int i = 0; i < 2; ++i) { int R, C; stage_rc(tid * 16 + i * 8192, R, C); const int Rb = Epi::PERM ? ((R & ~31) + perm32(R & 31)) : R;
        const int KP = TILED ? BK : K; voffA[i] = (unsigned)(R * KP + C) * 2u; voffB[i] = (unsigned)(Rb * KP + C) * 2u; }
    const size_t kstep = TILED ? (size_t)(BM * BK * 2) : (size_t)(BK * 2);
    const size_t hstep = TILED ? (size_t)(HALF * BK * 2) : (size_t)HALF * K * 2;
    const size_t tstep = TILED ? (size_t)(K / BK) * (BM * BK * 2) : 2 * hstep;
#define PG8_K0OFF(k0) (TILED ? (size_t)((k0) / BK) * (BM * BK * 2) : (size_t)(k0) * 2)
    const unsigned ldsw = (unsigned)wid * 1024u;
    const int aoff = lds_byte(wr * 64 + fr, fq * 8), boff = lds_byte(wc * 32 + fr, fq * 8);
#define PG8_SA(b, h) (((b) * 2 + (h)) * HTB)
#define PG8_SB(b, h) ((4 + (b) * 2 + (h)) * HTB)
#define PG8_STAGE(bufoff, gbase, voff) do { _Pragma("unroll") for (int _i = 0; _i < 2; ++_i) \
        __builtin_amdgcn_global_load_lds((const unsigned*)((const char*)(gbase) + (voff)[_i]), (PG8_LAS unsigned*)(lds + (bufoff) + ldsw + _i * 8192), 16, 0, 0); } while (0)
#define PG8_LDA(dst, b, h) do { _Pragma("unroll") for (int m = 0; m < 4; ++m) _Pragma("unroll") for (int k = 0; k < 2; ++k) dst[m][k] = *(const PG8_LAS bf16x8*)(lds + PG8_SA(b, h) + aoff + m * 2048 + k * 1024); } while (0)
#define PG8_LDB(dst, b, h) do { _Pragma("unroll") for (int n = 0; n < 2; ++n) _Pragma("unroll") for (int k = 0; k < 2; ++k) dst[n][k] = *(const PG8_LAS bf16x8*)(lds + PG8_SB(b, h) + boff + n * 2048 + k * 1024); } while (0)
#define PG8_MMA(ai, bj, At, Bt) do { __builtin_amdgcn_s_setprio(1); _Pragma("unroll") for (int m = 0; m < 4; ++m) _Pragma("unroll") for (int n = 0; n < 2; ++n) _Pragma("unroll") for (int k = 0; k < 2; ++k) \
        acc[ai][bj][m][n] = __builtin_amdgcn_mfma_f32_16x16x32_bf16(Bt[n][k], At[m][k], acc[ai][bj][m][n], 0, 0, 0); __builtin_amdgcn_s_setprio(0); } while (0)
#define PG8_WAIT_V(n) asm volatile("s_waitcnt vmcnt(" #n ")" ::: "memory")
#define PG8_WAIT_L(n) asm volatile("s_waitcnt lgkmcnt(" #n ")" ::: "memory")
#define PG8_WAIT_VR do { if constexpr (Epi::NSTORE == 8) PG8_WAIT_V(16); else if constexpr (Epi::NSTORE == 16) PG8_WAIT_V(24); else if constexpr (Epi::NSTORE == 32) PG8_WAIT_V(40); else PG8_WAIT_V(8); } while (0)
#define PG8_BAR __builtin_amdgcn_s_barrier()
#define PG8_SCHED __builtin_amdgcn_sched_barrier(0)
    Unit cur, nxt; int ui = 0;
    if (!S.next(0, cur)) return;
    f32x4 acc[2][2][4][2];
#pragma unroll
    for (int a = 0; a < 2; ++a)
#pragma unroll
        for (int b = 0; b < 2; ++b)
#pragma unroll
            for (int m = 0; m < 4; ++m)
#pragma unroll
                for (int n = 0; n < 2; ++n) acc[a][b][m][n] = (f32x4){0.f, 0.f, 0.f, 0.f};
    bf16x8 At[4][2], B0[2][2], B1[2][2];
    const char* cA = (const char*)g.A + (size_t)cur.pm * tstep + PG8_K0OFF(cur.k0); const char* cB = (const char*)g.Bt + (size_t)cur.pn * tstep + PG8_K0OFF(cur.k0);
    S.a_ready(cur);
    if constexpr (SP2) {
        PG8_STAGE(PG8_SB(0, 0), cB, voffB); PG8_STAGE(PG8_SB(0, 1), cB + hstep, voffB); PG8_STAGE(PG8_SA(0, 0), cA, voffA); PG8_STAGE(PG8_SA(0, 1), cA + hstep, voffA);
        if (wr == 1) PG8_BAR;
        PG8_WAIT_V(2); PG8_BAR;
        PG8_STAGE(PG8_SB(1, 0), cB + kstep, voffB); PG8_STAGE(PG8_SA(1, 0), cA + kstep, voffA); PG8_STAGE(PG8_SB(1, 1), cB + hstep + kstep, voffB);
        PG8_WAIT_V(6); PG8_BAR;
    } else {
        PG8_STAGE(PG8_SB(0, 0), cB, voffB); PG8_STAGE(PG8_SA(0, 0), cA, voffA); PG8_STAGE(PG8_SB(0, 1), cB + hstep, voffB); PG8_STAGE(PG8_SA(0, 1), cA + hstep, voffA);
        if (wr == 1) PG8_BAR;
        PG8_WAIT_V(4); PG8_BAR;
        PG8_STAGE(PG8_SB(1, 0), cB + kstep, voffB); PG8_STAGE(PG8_SA(1, 0), cA + kstep, voffA); PG8_STAGE(PG8_SB(1, 1), cB + hstep + kstep, voffB);
        PG8_WAIT_V(6); PG8_BAR;
    }
    for (;;) {
        const bool has_next = S.next(ui + 1, nxt);
        const char* nA = has_next ? (const char*)g.A + (size_t)nxt.pm * tstep + PG8_K0OFF(nxt.k0) : cA; const char* nB = has_next ? (const char*)g.Bt + (size_t)nxt.pn * tstep + PG8_K0OFF(nxt.k0) : cB;
        const int nt = cur.nt;
        static_assert(SP2, "this build keeps only the two-super-phase K-loop");
        for (int t = 0; t < nt; t += 2) {
            const bool last = (t == nt - 2);
            const char* a1 = cA + (size_t)(t + 1) * kstep;
            const char* a2 = last ? nA : cA + (size_t)(t + 2) * kstep; const char* b2 = last ? nB : cB + (size_t)(t + 2) * kstep;
            const char* a3 = a2 + kstep; const char* b3 = b2 + kstep;
            if (last && has_next) S.a_ready(nxt);
            const unsigned relax = (unsigned)__builtin_amdgcn_readfirstlane((Epi::NSTORE > 0 && t == 0 && ui > 0) ? 1 : 0);
#define PG8_WAIT_V8R do { if constexpr (Epi::NSTORE == 8) asm volatile("s_cmp_lg_u32 %0, 0\n\ts_cbranch_scc1 .Lpg8r%=\n\ts_waitcnt vmcnt(8)\n.Lpg8r%=:\n\ts_waitcnt vmcnt(16)" :: "s"(relax) : "memory", "scc"); \
        else if constexpr (Epi::NSTORE == 16) asm volatile("s_cmp_lg_u32 %0, 0\n\ts_cbranch_scc1 .Lpg8r%=\n\ts_waitcnt vmcnt(8)\n.Lpg8r%=:\n\ts_waitcnt vmcnt(24)" :: "s"(relax) : "memory", "scc"); \
        else if constexpr (Epi::NSTORE == 32) asm volatile("s_cmp_lg_u32 %0, 0\n\ts_cbranch_scc1 .Lpg8r%=\n\ts_waitcnt vmcnt(8)\n.Lpg8r%=:\n\ts_waitcnt vmcnt(40)" :: "s"(relax) : "memory", "scc"); \
        else PG8_WAIT_V(8); } while (0)
            PG8_LDB(B0, 0, 0); PG8_LDB(B1, 0, 1); PG8_SCHED; PG8_LDA(At, 0, 0); PG8_STAGE(PG8_SA(1, 1), a1 + hstep, voffA);
            PG8_WAIT_V8R; PG8_WAIT_L(0); PG8_BAR; PG8_MMA(0, 0, At, B0); PG8_MMA(0, 1, At, B1); PG8_BAR; PG8_SCHED;
            PG8_LDA(At, 0, 1); PG8_STAGE(PG8_SB(0, 0), b2, voffB); PG8_STAGE(PG8_SB(0, 1), b2 + hstep, voffB); PG8_STAGE(PG8_SA(0, 0), a2, voffA);
            PG8_WAIT_V8R; PG8_WAIT_L(0); PG8_BAR; PG8_MMA(1, 0, At, B0); PG8_MMA(1, 1, At, B1); PG8_BAR; PG8_SCHED;
            PG8_LDB(B0, 1, 0); PG8_LDB(B1, 1, 1); PG8_SCHED; PG8_LDA(At, 1, 0); PG8_STAGE(PG8_SA(0, 1), a2 + hstep, voffA);
            PG8_WAIT_V8R; PG8_WAIT_L(0); PG8_BAR; PG8_MMA(0, 0, At, B0); PG8_MMA(0, 1, At, B1); PG8_BAR; PG8_SCHED;
            PG8_LDA(At, 1, 1); PG8_STAGE(PG8_SB(1, 0), b3, voffB); PG8_STAGE(PG8_SB(1, 1), b3 + hstep, voffB); PG8_STAGE(PG8_SA(1, 0), a3, voffA);
            PG8_WAIT_V(8); PG8_WAIT_L(0); PG8_BAR; PG8_MMA(1, 0, At, B0); PG8_MMA(1, 1, At, B1); PG8_BAR; PG8_SCHED;
#undef PG8_WAIT_V8R
        }
        if constexpr (SP2 && Epi::NSTORE > 0) { if (has_next) { PG8_STAGE(PG8_SA(1, 1), nA + kstep + hstep, voffA); asm volatile("" ::: "memory"); } }
        if constexpr (ALIGN_EPI) { if (wr == 0) PG8_BAR; }
        if constexpr (!Epi::AFTER_DRAIN) { E(acc, cur, wr, wc, fr, fq); S.done(cur); }
        if (!has_next) break;
#pragma unroll
        for (int a = 0; a < 2; ++a)
#pragma unroll
            for (int b = 0; b < 2; ++b)
#pragma unroll
                for (int m = 0; m < 4; ++m)
#pragma unroll
                    for (int n = 0; n < 2; ++n) acc[a][b][m][n] = (f32x4){0.f, 0.f, 0.f, 0.f};
        cur = nxt; cA = nA; cB = nB; ++ui;
        if constexpr (ALIGN_EPI) { if (wr == 1) PG8_BAR; }
    }
    PG8_WAIT_V(0);
    if constexpr (!ALIGN_EPI) { if (wr == 0) PG8_BAR; }
    PG8_BAR;
#undef PG8_K0OFF
#undef PG8_SA
#undef PG8_SB
#undef PG8_STAGE
#undef PG8_LDA
#undef PG8_LDB
#undef PG8_MMA
#undef PG8_WAIT_V
#undef PG8_WAIT_L
#undef PG8_WAIT_VR
#undef PG8_BAR
#undef PG8_SCHED
}
}

constexpr int RING_BYTES = 131072;
constexpr int SCR_BYTES = 8 * 64 * 65 * 4;
constexpr int LDSCTL_OFF = 159744, LDS_BYTES = 163840;

#define GAS __attribute__((address_space(1)))
#define LAS __attribute__((address_space(3)))
typedef unsigned short bf16;
typedef unsigned v4u __attribute__((ext_vector_type(4)));
typedef unsigned v2u __attribute__((ext_vector_type(2)));
typedef float f32x4 __attribute__((ext_vector_type(4)));
typedef short bf16x8 __attribute__((ext_vector_type(8)));
typedef short s16x4 __attribute__((ext_vector_type(4)));
#define LDS_WAIT() asm volatile("s_waitcnt lgkmcnt(0)" ::: "memory")
__device__ __forceinline__ unsigned f2bf(float f) { unsigned u = __builtin_bit_cast(unsigned, f); return (u + 0x7fffu + ((u >> 16) & 1u)) >> 16; }
__device__ __forceinline__ unsigned pk2(float lo, float hi) { return pg8::cvt_pk_bf16(lo, hi); }
__device__ __forceinline__ float bflo(unsigned w) { return __builtin_bit_cast(float, w << 16); }
__device__ __forceinline__ float bfhi(unsigned w) { return __builtin_bit_cast(float, w & 0xffff0000u); }

#define XB_TMO      128
#define XB_XCNT(j)  (256  + 64 * (j))
#define XB_XSUB(j)  (1280 + 64 * (j))
#define XB_XGEN(j)  (2304 + 64 * (j))
#define XB_TOP      3328
#define XB_TOPGEN   3392
#define XCD_BAR_WORDS 3456
#define XB_SPIN_CAP (1u << 18)
__device__ __forceinline__ unsigned xb_ld(unsigned* p)              { return __hip_atomic_load(p, __ATOMIC_RELAXED, __HIP_MEMORY_SCOPE_AGENT); }
__device__ __forceinline__ unsigned xb_add(unsigned* p, unsigned v) { return __hip_atomic_fetch_add(p, v, __ATOMIC_RELAXED, __HIP_MEMORY_SCOPE_AGENT); }
__device__ __forceinline__ unsigned xb_xcc_id() { return (unsigned)__builtin_amdgcn_s_getreg((3 << 11) | 20) & 0xFu; }
#define XB_SPIN(cond, bar) do { unsigned _sp = 0; while (cond) { __builtin_amdgcn_s_sleep(1); \
    if ((++_sp & 255u) == 0u) { if (xb_ld(&(bar)[XB_TMO])) break; if (_sp > XB_SPIN_CAP) { atomicAdd(&(bar)[XB_TMO], 1u); break; } } } } while (0)
struct XcdBarrier { unsigned* bar; unsigned x; volatile LAS unsigned* st; };
__device__ __forceinline__ XcdBarrier xcd_barrier_post(unsigned* bar, volatile LAS unsigned* st) {
    XcdBarrier b; b.bar = bar; b.x = xb_xcc_id(); b.st = st;
    if (threadIdx.x == 0) (void)xb_add(&bar[XB_XCNT(b.x)], 1u);
    return b;
}
__device__ __forceinline__ void xcd_barrier_complete(unsigned* bar, unsigned x, unsigned& nloc, unsigned& nx) {
    const unsigned G = gridDim.x * gridDim.y * gridDim.z;
    unsigned sum, cnt, mine, sp = 0u;
    for (;;) {
        sum = 0u; cnt = 0u; mine = 0u;
#pragma unroll
        for (unsigned j = 0; j < 16; ++j) { const unsigned c = xb_ld(&bar[XB_XCNT(j)]); sum += c; cnt += (c > 0u) ? 1u : 0u; mine = (j == x) ? c : mine; }
        if (sum == G) break;
        __builtin_amdgcn_s_sleep(1);
        if ((++sp & 255u) == 0u) { if (xb_ld(&bar[XB_TMO])) break; if (sp > XB_SPIN_CAP) { atomicAdd(&bar[XB_TMO], 1u); break; } }
    }
    nloc = mine > 0u ? mine : 1u; nx = cnt > 0u ? cnt : 1u;
}
__device__ __forceinline__ void xcd_barrier(const XcdBarrier& b) {
    asm volatile("s_waitcnt vmcnt(0)" ::: "memory");
    __syncthreads();
    if (threadIdx.x == 0) {
        unsigned* bar = b.bar;
        __builtin_amdgcn_s_waitcnt(0);
        unsigned nloc = b.st[0], nx = b.st[1];
        if (nloc == 0u) { xcd_barrier_complete(bar, b.x, nloc, nx); b.st[0] = nloc; b.st[1] = nx; }
        const unsigned old = xb_add(&bar[XB_XSUB(b.x)], 1u);
        const unsigned gen = old / nloc;
        if (old + 1u == (gen + 1u) * nloc) {
            __builtin_amdgcn_fence(__ATOMIC_RELEASE, "agent");
            asm volatile("s_waitcnt vmcnt(0)" ::: "memory");
            const unsigned og = xb_add(&bar[XB_TOP], 1u);
            const unsigned tg = og / nx;
            if (og + 1u == (tg + 1u) * nx) xb_add(&bar[XB_TOPGEN], 1u);
            else XB_SPIN(xb_ld(&bar[XB_TOPGEN]) == tg, bar);
            __builtin_amdgcn_fence(__ATOMIC_ACQUIRE, "agent");
            xb_add(&bar[XB_XGEN(b.x)], 1u);
            asm volatile("s_waitcnt vmcnt(0)" ::: "memory");
        } else {
            XB_SPIN(xb_ld(&bar[XB_XGEN(b.x)]) == gen, bar);
            __builtin_amdgcn_fence(__ATOMIC_ACQUIRE, "agent");
            asm volatile("s_waitcnt vmcnt(0)" ::: "memory");
        }
    }
    __syncthreads();
}

__device__ __forceinline__ float wave_sum(float v) {
#pragma unroll
    for (int o = 1; o < 64; o <<= 1) v += __shfl_xor(v, o);
    return v;
}
template <int MAPK> __device__ __forceinline__ int wmap(int n) {
    if (MAPK == 1) { const int pn = n >> 8, r = n & 255; return ((r < 128) ? 0 : DFF) + 128 * pn + (r & 127); }
    if (MAPK == 2) { return n < 4096 ? n : (n < 6144 ? n + 32 : (n < 6176 ? n - 2048 : -1)); }
    if (MAPK == 3) { if (n < 2048) return n; const int q = n - 2048, pn = q >> 8, r = q & 255; return ((r < 128) ? 2048 : 4096) + 128 * pn + (r & 127); }
    return n;
}
template <int MAPK, bool BIAS = false> __device__ __forceinline__ void transpose_item(const float* W, int K, int Nsrc, bf16* WT, int nblk, LAS float* scr, int item, int lane, const float* shift = nullptr, float* biasp = nullptr) {
    const int kb = item / nblk, nb = item - kb * nblk, k0 = 64 * kb, n0 = 64 * nb;
    const int n = n0 + lane, sc = wmap<MAPK>(n);
    const float scale = (MAPK == 2 && n < 1024) ? 0.08838834764831845f : 1.0f;
    const float* src = W + (size_t)k0 * Nsrc + (sc >= 0 ? sc : 0);
#pragma unroll
    for (int hb = 0; hb < 2; ++hb) { float v[32];
#pragma unroll
        for (int i = 0; i < 32; ++i) v[i] = src[(size_t)(32 * hb + i) * Nsrc];
#pragma unroll
        for (int i = 0; i < 32; ++i) scr[(32 * hb + i) * 65 + lane] = (sc >= 0) ? v[i] * scale : 0.f; }
    LDS_WAIT(); asm volatile("" ::: "memory");
    if (BIAS) {
        const int fn = lane & 15, fk = lane >> 4;
        bf16x8 Af[2];
#pragma unroll
        for (int ks = 0; ks < 2; ++ks) { f32x4 s0 = (f32x4){0.f, 0.f, 0.f, 0.f}, s1 = s0; if (fn < 5) { const float* sp = shift + (size_t)fn * MODW + k0 + 32 * ks + 8 * fk; s0 = *(const f32x4*)sp; s1 = *(const f32x4*)(sp + 4); }
            const v4u w = (v4u){pk2(s0[0], s0[1]), pk2(s0[2], s0[3]), pk2(s1[0], s1[1]), pk2(s1[2], s1[3])}; Af[ks] = __builtin_bit_cast(bf16x8, w); }
#pragma unroll
        for (int nt = 0; nt < 4; ++nt) { f32x4 bacc = (f32x4){0.f, 0.f, 0.f, 0.f};
#pragma unroll
            for (int ks = 0; ks < 2; ++ks) { const LAS float* sp = scr + (32 * ks + 8 * fk) * 65 + 16 * nt + fn;
                const v4u o = (v4u){pk2(sp[0 * 65], sp[1 * 65]), pk2(sp[2 * 65], sp[3 * 65]), pk2(sp[4 * 65], sp[5 * 65]), pk2(sp[6 * 65], sp[7 * 65])};
                *(GAS v4u*)(WT + (size_t)(n0 + 16 * nt + fn) * K + k0 + 32 * ks + 8 * fk) = o;
                bacc = __builtin_amdgcn_mfma_f32_16x16x32_bf16(Af[ks], __builtin_bit_cast(bf16x8, o), bacc, 0, 0, 0); }
            float* bo = biasp + (size_t)kb * 5 * NBCOL + n0 + 16 * nt + fn;
            if (fk == 0) { bo[0] = bacc[0]; bo[NBCOL] = bacc[1]; bo[2 * (size_t)NBCOL] = bacc[2]; bo[3 * (size_t)NBCOL] = bacc[3]; } else if (fk == 1) bo[4 * (size_t)NBCOL] = bacc[0]; }
    } else {
    const int c = lane & 7;
#pragma unroll
    for (int j = 0; j < 8; ++j) { const int nn = (lane >> 3) + 8 * j; const LAS float* s = scr + (8 * c) * 65 + nn;
        v4u o; o.x = pk2(s[0 * 65], s[1 * 65]); o.y = pk2(s[2 * 65], s[3 * 65]); o.z = pk2(s[4 * 65], s[5 * 65]); o.w = pk2(s[6 * 65], s[7 * 65]);
        *(GAS v4u*)(WT + (size_t)(n0 + nn) * K + k0 + 8 * c) = o; }
    }
    LDS_WAIT(); asm volatile("" ::: "memory");
}

constexpr int TI2_STR = 272, TI2_BYTES = 64 * TI2_STR;
__device__ __forceinline__ bf16x8 tr_frag_g(LAS unsigned char* p0, LAS unsigned char* p1) {
    const s16x4 a = __builtin_amdgcn_ds_read_tr16_b64_v4i16((LAS s16x4*)p0), b = __builtin_amdgcn_ds_read_tr16_b64_v4i16((LAS s16x4*)p1);
    return (bf16x8){a[0], a[1], a[2], a[3], b[0], b[1], b[2], b[3]};
}
template <int MAPK, bool BIAS, bool TILEDW = false> __device__ __forceinline__ void transpose_item2(const float* W, int K, int Nsrc, bf16* WT, int nblk, LAS unsigned char* tile, int item, int lane, const float* shift = nullptr, float* biasp = nullptr) {
    typedef float f32x2v __attribute__((ext_vector_type(2)));
    const int kb = item / nblk, nb = item - kb * nblk, k0 = 64 * kb, n0 = 128 * nb;
    const int n = n0 + 2 * lane, sc = wmap<MAPK>(n);
    const float scale = (MAPK == 2 && n < 1024) ? 0.08838834764831845f : 1.0f;
    const float* src = W + (size_t)k0 * Nsrc + (sc >= 0 ? sc : 0);
#pragma unroll
    for (int hb = 0; hb < 2; ++hb) { f32x2v v[32];
#pragma unroll
        for (int i = 0; i < 32; ++i) v[i] = __builtin_nontemporal_load((const f32x2v*)(src + (size_t)(32 * hb + i) * Nsrc));
#pragma unroll
        for (int i = 0; i < 32; ++i) *(LAS unsigned*)(tile + (32 * hb + i) * TI2_STR + 4 * lane) = (sc >= 0) ? pk2(v[i][0] * scale, v[i][1] * scale) : 0u; }
    LDS_WAIT(); asm volatile("" ::: "memory");
    const int fn = lane & 15, fk = lane >> 4, tq = (lane & 15) >> 2, tp = lane & 3;
    bf16x8 Af[2];
    if (BIAS) {
#pragma unroll
        for (int ks = 0; ks < 2; ++ks) { f32x4 s0 = (f32x4){0.f, 0.f, 0.f, 0.f}, s1 = s0; if (fn < 5) { const float* sp = shift + (size_t)fn * MODW + k0 + 32 * ks + 8 * fk; s0 = *(const f32x4*)sp; s1 = *(const f32x4*)(sp + 4); }
            const v4u w = (v4u){pk2(s0[0], s0[1]), pk2(s0[2], s0[3]), pk2(s1[0], s1[1]), pk2(s1[2], s1[3])}; Af[ks] = __builtin_bit_cast(bf16x8, w); } }
#pragma unroll
    for (int nt = 0; nt < 8; ++nt) { f32x4 bacc = (f32x4){0.f, 0.f, 0.f, 0.f};
#pragma unroll
        for (int ks = 0; ks < 2; ++ks) { LAS unsigned char* p = tile + (32 * ks + 8 * fk + tq) * TI2_STR + (16 * nt + 4 * tp) * 2; const bf16x8 fr = tr_frag_g(p, p + 4 * TI2_STR);
            { const int nn = n0 + 16 * nt + fn; const size_t doff = TILEDW ? ((((size_t)(nn >> 8) * (K / 64) + kb) * 256 + (nn & 255)) * 64 + 32 * ks + 8 * fk) : ((size_t)nn * K + k0 + 32 * ks + 8 * fk);
              *(GAS bf16x8*)(WT + doff) = fr; }
            if (BIAS) bacc = __builtin_amdgcn_mfma_f32_16x16x32_bf16(Af[ks], fr, bacc, 0, 0, 0); }
        if (BIAS) { float* bo = biasp + (size_t)kb * 5 * NBCOL + n0 + 16 * nt + fn;
            if (fk == 0) { bo[0] = bacc[0]; bo[NBCOL] = bacc[1]; bo[2 * (size_t)NBCOL] = bacc[2]; bo[3 * (size_t)NBCOL] = bacc[3]; } else if (fk == 1) bo[4 * (size_t)NBCOL] = bacc[0]; } }
    LDS_WAIT(); asm volatile("" ::: "memory");
}

struct KArgs { const float* in[17]; float* out; unsigned char* ws; int ph_lo, ph_hi; };

__device__ __forceinline__ void normmod_phase(const float* xx, const float* xc, int rows, const float* ng, const float* modl, int j, bf16* HB, int gw, int NGW, int lane, const float* ctxP = nullptr, const float* cgate = nullptr, int first_row = 0) {
    for (int r = first_row + gw; r < rows; r += NGW) {
        const bool isc = r >= MX; const int b = isc ? 4 : (r >> 12);
        const float* src = isc ? xc + (size_t)(r - MX) * D : xx + (size_t)r * D;
        const float* shift = modl + (size_t)b * MODW + (3 * j) * D; const float* scale = shift + D;
        f32x4 v[8]; float ss = 0.f;
#pragma unroll
        for (int q = 0; q < 8; ++q) v[q] = __builtin_nontemporal_load((const f32x4*)(src + 4 * (lane + 64 * q)));
        if (ctxP && isc) {
#pragma unroll
            for (int q0 = 0; q0 < 8; q0 += 4) { f32x4 pp[4][8];
#pragma unroll
                for (int j = 0; j < 4; ++j)
#pragma unroll
                    for (int sl = 0; sl < 8; ++sl) pp[j][sl] = *(const f32x4*)(ctxP + ((size_t)sl * MC + (r - MX)) * D + 4 * (lane + 64 * (q0 + j)));
#pragma unroll
                for (int j = 0; j < 4; ++j) { const int c = 4 * (lane + 64 * (q0 + j)); f32x4 p = pp[j][0];
#pragma unroll
                    for (int sl = 1; sl < 8; ++sl) p += pp[j][sl];
                    v[q0 + j] += p * (*(const f32x4*)(cgate + c)) * 0.5f; } } }
#pragma unroll
        for (int q = 0; q < 8; ++q) ss += (v[q][0] * v[q][0] + v[q][1] * v[q][1]) + (v[q][2] * v[q][2] + v[q][3] * v[q][3]);
        const float rstd = 1.0f / sqrtf(wave_sum(ss) * (1.0f / D) + RMS_EPS);
#pragma unroll
        for (int q = 0; q < 8; ++q) { const int c = 4 * (lane + 64 * q);
            const f32x4 g4 = *(const f32x4*)(ng + c), s4 = *(const f32x4*)(scale + c), h4 = *(const f32x4*)(shift + c);
            const f32x4 y = v[q] * rstd * g4 * (s4 + 1.0f) + h4;
            v2u o; o.x = pk2(y[0], y[1]); o.y = pk2(y[2], y[3]); *(v2u*)(HB + hb_off(r, c)) = o; }
    }
}
__device__ __forceinline__ void final_norm_phase(const bf16* XS, const float* SS, float* out, int gw, int NGW, int lane) {
    for (int r = gw; r < MX; r += NGW) {
        float t = lane < 32 ? SS[(size_t)r * 32 + lane] : 0.f;
        t = wave_sum(t);
        const float rstd = 1.0f / sqrtf(t * (1.0f / D) + RMS_EPS);
        float* orow = out + (size_t)r * D;
#pragma unroll
        for (int q = 0; q < 4; ++q) { const int c = 8 * (lane + 64 * q); const v4u w = __builtin_nontemporal_load((const v4u*)(XS + hb_off(r, c)));
            __builtin_nontemporal_store((f32x4){bflo(w.x), bfhi(w.x), bflo(w.y), bfhi(w.y)} * rstd, (f32x4*)(orow + c)); __builtin_nontemporal_store((f32x4){bflo(w.z), bfhi(w.z), bflo(w.w), bfhi(w.w)} * rstd, (f32x4*)(orow + c + 4)); }
    }
}
__device__ __forceinline__ void unpack8(const v4u w, float (&f)[8]) { f[0] = bflo(w.x); f[1] = bfhi(w.x); f[2] = bflo(w.y); f[3] = bfhi(w.y); f[4] = bflo(w.z); f[5] = bfhi(w.z); f[6] = bflo(w.w); f[7] = bfhi(w.w); }
__device__ __forceinline__ void headnorm_phase(const bf16* HF, const bf16* HBW, const bf16* QKVO, const float* ng, bf16* Y, int gw, int NGW, int lane) {
    for (int r = gw; r < MX; r += NGW) {
#pragma unroll
        for (int q = 0; q < 4; ++q) { const int c = 8 * (lane + 64 * q);
            const v4u a = __builtin_nontemporal_load((const v4u*)(HF + (size_t)r * D + c)), b = __builtin_nontemporal_load((const v4u*)(HBW + (size_t)r * D + c)), o = __builtin_nontemporal_load((const v4u*)(QKVO + OG_OFF + (size_t)r * 2048 + c));
            float fa[8], fb[8], fo[8]; unpack8(a, fa); unpack8(b, fb); unpack8(o, fo);
            float s[8], ss = 0.f;
#pragma unroll
            for (int i = 0; i < 8; ++i) { s[i] = fa[i] + fb[i]; ss += s[i] * s[i]; }
#pragma unroll
            for (int of = 1; of < 32; of <<= 1) ss += __shfl_xor(ss, of);
            const float rstd = 1.0f / sqrtf(ss * (1.0f / DVH) + RMS_EPS);
            const f32x4 g0 = *(const f32x4*)(ng + c), g1 = *(const f32x4*)(ng + c + 4);
            float y[8];
#pragma unroll
            for (int i = 0; i < 8; ++i) { const float g = i < 4 ? g0[i] : g1[i - 4]; y[i] = s[i] * rstd * g * __builtin_amdgcn_rcpf(1.0f + __builtin_amdgcn_exp2f(-1.44269504f * fo[i])); }
            v4u w; w.x = pk2(y[0], y[1]); w.y = pk2(y[2], y[3]); w.z = pk2(y[4], y[5]); w.w = pk2(y[6], y[7]);
            *(v4u*)(Y + hb_off(r, c)) = w; }
    }
}
__device__ __forceinline__ void convmix_phase(const bf16* BG, const bf16* Z, const float* cw, bf16* Y, int gw, int NGW, int lane) {
    for (int r = gw; r < MX; r += NGW) { const int t = r & 63;
#pragma unroll
        for (int q = 0; q < 4; ++q) { const int c = 8 * (lane + 64 * q);
            const v4u zero = (v4u){0u, 0u, 0u, 0u};
            const v4u zc = *(const v4u*)(Z + (size_t)r * D + c), zp = t > 0 ? *(const v4u*)(Z + (size_t)(r - 1) * D + c) : zero, zn = t < 63 ? *(const v4u*)(Z + (size_t)(r + 1) * D + c) : zero;
            const v4u bg = __builtin_nontemporal_load((const v4u*)(BG + (size_t)r * D + c));
            float fc[8], fp[8], fn[8], fb[8]; unpack8(zc, fc); unpack8(zp, fp); unpack8(zn, fn); unpack8(bg, fb);
            float y[8];
#pragma unroll
            for (int h = 0; h < 2; ++h) { const f32x4 w0 = *(const f32x4*)(cw + c + 4 * h), w1 = *(const f32x4*)(cw + D + c + 4 * h), w2 = *(const f32x4*)(cw + 2 * D + c + 4 * h);
#pragma unroll
                for (int i = 0; i < 4; ++i) y[4 * h + i] = fb[4 * h + i] * (w0[i] * fp[4 * h + i] + w1[i] * fc[4 * h + i] + w2[i] * fn[4 * h + i]); }
            v4u w; w.x = pk2(y[0], y[1]); w.y = pk2(y[2], y[3]); w.z = pk2(y[4], y[5]); w.w = pk2(y[6], y[7]);
            *(v4u*)(Y + hb_off(r, c)) = w; }
    }
}

__device__ __forceinline__ void mod_partials(const KArgs& a, int l, int wv, int nwv, int lane) {
    float* modp = (float*)(a.ws + WS_MODP);
    constexpr int NCG = MODW / 256, NKS = D / 64, NIT = NCG * NKS;
    for (int it = wv; it < NIT; it += nwv) {
        const int cg = it / NKS, ks = it - cg * NKS, k0 = 64 * ks, col = 256 * cg + 4 * lane;
        float sv[5];
#pragma unroll
        for (int b = 0; b < 5; ++b) { const float cv = (b < 4) ? a.in[1][b * D + k0 + lane] : a.in[3][k0 + lane]; sv[b] = pg8::silu_f(cv); }
        f32x4 acc[5];
#pragma unroll
        for (int b = 0; b < 5; ++b) acc[b] = (f32x4){0.f, 0.f, 0.f, 0.f};
        const float* wp = a.in[4] + ((size_t)l * D + k0) * MODW + col;
#pragma unroll 8
        for (int k = 0; k < 64; ++k) { const f32x4 w = __builtin_nontemporal_load((const f32x4*)(wp + (size_t)k * MODW));
#pragma unroll
            for (int b = 0; b < 5; ++b) { const float s = __builtin_bit_cast(float, __builtin_amdgcn_readlane(__builtin_bit_cast(int, sv[b]), k)); acc[b] += w * s; } }
#pragma unroll
        for (int b = 0; b < 5; ++b) *(f32x4*)(modp + (((size_t)ks * 2 + l) * 5 + b) * MODW + col) = acc[b];
    }
}
template <int LIST> __device__ __forceinline__ void convert_list(const KArgs& a, LAS unsigned char* lds, int wv, int nwv, int wave, int lane) {
    unsigned char* ws = a.ws;
    LAS unsigned char* scr = lds + wave * TI2_BYTES;
    const float* mod = (const float*)(ws + WS_MOD); float* bp = (float*)(ws + WS_BIASP);
    constexpr int I_FI = (D / 64) * (NFI / 128), I_FO = (DFF / 64) * (D / 128), I_MI = (D / 64) * (NML / 128), I_SQ = (D / 64) * (D / 128), I_CI = (D / 64) * (NCV / 128);
    if (LIST == 0) {
        for (int it = wv; it < I_FI + I_FO; it += nwv) { int r = it;
            if (r < I_FI) { transpose_item2<1, false, true>(a.in[7], D, NFI, (bf16*)(ws + WS_WFI), NFI / 128, scr, r, lane); continue; } r -= I_FI;
            transpose_item2<0, false, true>(a.in[8], DFF, D, (bf16*)(ws + WS_WFO), D / 128, scr, r, lane); }
    } else if (LIST == 1) {
        for (int it = wv; it < I_MI + I_SQ; it += nwv) { int r = it;
            if (r < I_MI) { transpose_item2<2, true, true>(a.in[9], D, NMLSRC, (bf16*)(ws + WS_WMI), NML / 128, scr, r, lane, mod + 3 * D, bp + BOFF_MI); continue; } r -= I_MI;
            transpose_item2<0, false, true>(a.in[12], D, D, (bf16*)(ws + WS_WMO), D / 128, scr, r, lane); }
    } else {
        for (int it = wv; it < 3 * I_FI + 3 * I_FO + I_CI + I_SQ; it += nwv) { int r = it;
            if (r < 3 * I_FI) { const int mi = 1 + r / I_FI; r -= (mi - 1) * I_FI;
                const float* sh = mi == 1 ? mod + 6 * D : (mi == 2 ? mod + (size_t)5 * MODW : mod + (size_t)5 * MODW + 6 * D); float* bq = bp + (mi == 1 ? BOFF_F1 : (mi == 2 ? BOFF_F2 : BOFF_F3));
                transpose_item2<1, true, true>(a.in[7] + (size_t)mi * D * NFI, D, NFI, (bf16*)(ws + WS_WFI) + (size_t)mi * NFI * D, NFI / 128, scr, r, lane, sh, bq); continue; } r -= 3 * I_FI;
            if (r < 3 * I_FO) { const int mi = 1 + r / I_FO; r -= (mi - 1) * I_FO; transpose_item2<0, false, true>(a.in[8] + (size_t)mi * DFF * D, DFF, D, (bf16*)(ws + WS_WFO) + (size_t)mi * D * DFF, D / 128, scr, r, lane); continue; } r -= 3 * I_FO;
            if (r < I_CI) { transpose_item2<3, true, true>(a.in[13], D, NCV, (bf16*)(ws + WS_WCI), NCV / 128, scr, r, lane, mod + (size_t)5 * MODW + 3 * D, bp + BOFF_CI); continue; } r -= I_CI;
            transpose_item2<0, false, true>(a.in[15], D, D, (bf16*)(ws + WS_WCO), D / 128, scr, r, lane); }
    }
}
__device__ __forceinline__ bool tail_rank(int nwg, int G, int bx, int& rank, int& cnt) { const int rem = nwg % G; if (rem == 0) { rank = bx; cnt = G; return true; } rank = bx - rem; cnt = G - rem; return bx >= rem; }

__device__ __forceinline__ void modreduce_phase(const float* modp, const float* bmod, const float* normg, const float* fng, float* mod, float* gs, float* rgs, int gtid, int NGT) {
    constexpr int NV = 5 * MODW / 4;
    for (int i2 = gtid; i2 < 2 * NV; i2 += NGT) { const int l = i2 / NV, i = i2 - l * NV, b = i / (MODW / 4), c4 = i - b * (MODW / 4), lb = l * 5 + b;
        f32x4 pv[D / 64];
#pragma unroll
        for (int ks = 0; ks < D / 64; ++ks) pv[ks] = *(const f32x4*)(modp + ((size_t)ks * 10 + lb) * MODW + 4 * c4);
        f32x4 s = *(const f32x4*)(bmod + (size_t)l * MODW + 4 * c4);
#pragma unroll
        for (int ks = 0; ks < D / 64; ++ks) s += pv[ks];
        *(f32x4*)(mod + (size_t)lb * MODW + 4 * c4) = s;
        if (l == 1 && c4 < D / 4) *(f32x4*)(gs + ((size_t)6 * 5 + b) * D + 4 * c4) = *(const f32x4*)(fng + 4 * c4);
        const int seg = (4 * c4) / D, col = 4 * c4 - seg * D;
        if (seg % 3 == 1) { const int j = seg / 3; const f32x4 gv = *(const f32x4*)(normg + (size_t)(l * 3 + j) * D + col) * (s + 1.0f); const size_t o = ((size_t)(l * 3 + j) * 5 + b) * D + col;
            *(f32x4*)(gs + o) = gv; *(f32x4*)(rgs + o) = (f32x4){gv[0] != 0.f ? 1.0f / gv[0] : 0.f, gv[1] != 0.f ? 1.0f / gv[1] : 0.f, gv[2] != 0.f ? 1.0f / gv[2] : 0.f, gv[3] != 0.f ? 1.0f / gv[3] : 0.f}; } }
}
__device__ __forceinline__ void rowstat_phase(const float* SS, float* rstd, bool ctx_ones, int gtid, int NGT) {
    for (int r = gtid; r < MX; r += NGT) { float t = 0.f;
#pragma unroll
        for (int q = 0; q < 8; ++q) { const f32x4 v = *(const f32x4*)(SS + (size_t)r * 32 + 4 * q); t += (v[0] + v[1]) + (v[2] + v[3]); }
        rstd[r] = 1.0f / sqrtf(t * (1.0f / D) + RMS_EPS); }
    if (ctx_ones) for (int r = MX + gtid; r < MT; r += NGT) rstd[r] = 1.0f;
}
__device__ __forceinline__ void panel_rstd(const pg8::StaticOrder& S, const float* SS, float* rstd, int tid) {
    pg8::Unit u; int last = -1;
    for (int i = 0; S.next(i, u); ++i) { if (u.pm == last) continue; last = u.pm;
        if (tid < 256) { const int r = u.pm * 256 + tid; float t = 0.f;
#pragma unroll
            for (int q = 0; q < 8; ++q) { const f32x4 v = *(const f32x4*)(SS + (size_t)r * 32 + 4 * q); t += (v[0] + v[1]) + (v[2] + v[3]); }
            rstd[r] = 1.0f / sqrtf(t * (1.0f / D) + RMS_EPS); } }
    asm volatile("s_waitcnt vmcnt(0)" ::: "memory"); __syncthreads();
}
__device__ __forceinline__ void biasreduce_phase(const float* biasp, float* bias, int gtid, int NGT) {
    constexpr int NV = NBCOL / 4;
    for (int i = gtid; i < 6 * NV; i += NGT) { const int b = i / NV, c4 = i - b * NV; f32x4 s = (f32x4){0.f, 0.f, 0.f, 0.f};
        if (b < 5) for (int kb = 0; kb < D / 64; ++kb) s += *(const f32x4*)(biasp + ((size_t)kb * 5 + b) * NBCOL + 4 * c4);
        *(f32x4*)(bias + (size_t)b * NBCOL + 4 * c4) = s; }
}

constexpr int SQ_OFF = 0, SK_OFF = 18432, SKW_OFF = 36864, SV_OFF = 54272, SCB_OFF = 65536, SP_OFF = 87296, STAB_OFF = 96512, SCH_OFF = 148736, SHS_OFF = 149824;
constexpr int QSTR = 272, QKSTR = 288, VSTR = 160, PSTR = 144, CBSZ = 21760, NTOK = 68 * 64;
static_assert(SCH_OFF + 4 * 68 * 4 <= SHS_OFF && SHS_OFF + 64 * 144 <= LDSCTL_OFF, "scan LDS");

#define VROW(r) ((r) * VSTR + ((r) >> 3) * 128)
#define SCAN_BAR() do { asm volatile("s_waitcnt lgkmcnt(0)" ::: "memory"); __builtin_amdgcn_s_barrier(); asm volatile("" ::: "memory"); } while (0)
__device__ __forceinline__ bf16x8 tr_frag(LAS unsigned char* p0, LAS unsigned char* p1) {
    const s16x4 a = __builtin_amdgcn_ds_read_tr16_b64_v4i16((LAS s16x4*)p0), b = __builtin_amdgcn_ds_read_tr16_b64_v4i16((LAS s16x4*)p1);
    return (bf16x8){a[0], a[1], a[2], a[3], b[0], b[1], b[2], b[3]};
}
__device__ __forceinline__ float fexp(float x) { return __builtin_amdgcn_exp2f(1.44269504f * x); }

template <int PROBE> __device__ __forceinline__ void scan_phase(LAS unsigned char* lds, const bf16* QKVO, const float* GATES, bf16* HF, bf16* HBW, int vcu, int G, int tid, int lane, int wave) {
    const int fr = lane & 15, fq = lane >> 4, tq = (lane & 15) >> 2, tp = lane & 3;
    LAS float* cjA = (LAS float*)(lds + STAB_OFF); LAS float* cmA = cjA + NTOK; LAS float* bsA = cmA + NTOK;
    LAS float* chM = (LAS float*)(lds + SCH_OFF); LAS float* chML = chM + 68; LAS float* chBE = chML + 68; LAS float* chMC = chBE + 68;
    for (int u = vcu; u < 256; u += G) {
        const int sl = u & 3, dir = (u >> 2) & 1, h = (u >> 3) & 7, b = u >> 6, e0 = 64 * sl;
        bf16* HO = dir ? HBW : HF;
        const int prow = tid >> 4, pch = tid & 15, vrow = tid >> 3, vch = tid & 7;
        auto row_of = [&](int st) { const bool isc = st < 4; const int ci = isc ? st : st - 4, n = isc ? 4 : 64, ch = dir ? (n - 1 - ci) : ci; return (isc ? MX + b * CTXL : b * SEQ) + ch * 64; };
        f32x4 Cacc[5];
#pragma unroll
        for (int e = 0; e < 5; ++e) Cacc[e] = (f32x4){0.f, 0.f, 0.f, 0.f};
        SCAN_BAR();
        {
            float gi[9], gf[9];
#pragma unroll
            for (int q = 0; q < 9; ++q) { const int st = wave + NWAVES * q; if (st < 68) { const float* gp = GATES + (size_t)(row_of(st) + lane) * 32 + (2 * dir) * 8 + h; gi[q] = gp[0]; gf[q] = gp[8]; } else { gi[q] = 0.f; gf[q] = 0.f; } }
#pragma unroll
            for (int q = 0; q < 9; ++q) { const int st = wave + NWAVES * q; if (st < 68) {
                const float ax = fabsf(gf[q]), ee = fexp(-ax), l1p = (ee < 1e-3f) ? ee * (1.0f - 0.5f * ee) : __logf(1.0f + ee);
                const float f = fminf(gf[q], 0.f) - l1p;
                float bs = f;
#pragma unroll
                for (int o = 1; o < 64; o <<= 1) { const float t = dir ? __shfl_down(bs, o) : __shfl_up(bs, o); const bool ok = dir ? (lane + o < 64) : (lane >= o); bs += ok ? t : 0.f; }
                const float cj = gi[q] - bs; float cm = cj;
#pragma unroll
                for (int o = 1; o < 64; o <<= 1) { const float t = dir ? __shfl_down(cm, o) : __shfl_up(cm, o); const bool ok = dir ? (lane + o < 64) : (lane >= o); cm = ok ? fmaxf(cm, t) : cm; }
                cjA[st * 64 + lane] = cj; cmA[st * 64 + lane] = cm; bsA[st * 64 + lane] = bs;
                if (lane == (dir ? 0 : 63)) { chBE[st] = bs; chMC[st] = cm; } } }
        }
        for (int i = tid; i < CBSZ / 16; i += 512) *(LAS v4u*)(lds + SCB_OFF + 16 * i) = (v4u){0u, 0u, 0u, 0u};
        if (tid < 128) { const int r = tid >> 1; *(LAS v4u*)(lds + SV_OFF + VROW(r) + (8 + (tid & 1)) * 16) = (tid & 1) ? (v4u){0u, 0u, 0u, 0u} : (v4u){0x3F80u, 0u, 0u, 0u}; }
        v4u rq[2][2], rk[2][2], rv[2];
        auto slot_of = [&](int st) { const bool isc = st < 4; const int ci = isc ? st : st - 4, n = isc ? 4 : 64, ch = dir ? (n - 1 - ci) : ci; return (isc ? CTX_SLOT0 + (b * 8 + h) * CTXL : (b * 8 + h) * SEQ) + ch * 64; };
        auto load_qk = [&](int st_, v4u (&q)[2], v4u (&k)[2]) { { const int st = st_ < 68 ? st_ : 67; const size_t e0q = (size_t)slot_of(st) * DKH;
#pragma unroll
            for (int i = 0; i < 2; ++i) { q[i] = *(const v4u*)(QKVO + QH_OFF + e0q + (size_t)(tid + 512 * i) * 8); k[i] = *(const v4u*)(QKVO + KH_OFF + e0q + (size_t)(tid + 512 * i) * 8); } } };
        auto load_v = [&](int st_, v4u& v) { const int st = st_ < 68 ? st_ : 67; v = __builtin_nontemporal_load((const v4u*)(QKVO + VH_OFF + ((size_t)slot_of(st) + vrow) * DVH + e0 + vch * 8)); };
        { v4u q0[2], k0[2];
          load_qk(0, q0, k0); load_qk(1, rq[1], rk[1]); load_qk(2, rq[0], rk[0]);
          load_v(0, rv[0]); load_v(1, rv[1]);
#pragma unroll
          for (int i = 0; i < 2; ++i) { *(LAS v4u*)(lds + SQ_OFF + (prow + 32 * i) * QKSTR + pch * 16) = q0[i]; *(LAS v4u*)(lds + SK_OFF + (prow + 32 * i) * QKSTR + pch * 16) = k0[i]; } }
        SCAN_BAR();
        if (wave == 0) {
            int ln = lane; asm volatile("" : "+v"(ln));
            const float mc0 = chMC[ln], be0 = chBE[ln], mc1 = chMC[64 + (ln & 3)], be1 = chBE[64 + (ln & 3)];
            float m = -1e30f;
#pragma unroll 1
            for (int st = 0; st < 64; ++st) {
                const float c = __builtin_bit_cast(float, __builtin_amdgcn_readlane(__builtin_bit_cast(int, mc0), st)), e = __builtin_bit_cast(float, __builtin_amdgcn_readlane(__builtin_bit_cast(int, be0), st));
                const float ML = fmaxf(m, c); if (ln == st) { chM[st] = m; chML[st] = ML; } m = e + ML; }
#pragma unroll 1
            for (int st = 0; st < 4; ++st) {
                const float c = __builtin_bit_cast(float, __builtin_amdgcn_readlane(__builtin_bit_cast(int, mc1), st)), e = __builtin_bit_cast(float, __builtin_amdgcn_readlane(__builtin_bit_cast(int, be1), st));
                const float ML = fmaxf(m, c); if (ln == st) { chM[64 + st] = m; chML[64 + st] = ML; } m = e + ML; } }
        SCAN_BAR();
        const int sb = wave & 3, hf = wave >> 2, s_pos = 16 * sb + fr;
        auto step = [&](const int st, const bool isc, v4u (&RQ)[2], v4u (&RK)[2], v4u& RV) {
            const float m_t = chM[st], ML_t = chML[st];
            if (!isc) { const v4u hw = *(const LAS v4u*)(lds + SHS_OFF + (tid >> 3) * PSTR + (tid & 7) * 16); *(v4u*)(HO + (size_t)(row_of(st > 4 ? st - 1 : st) + (tid >> 3)) * D + h * DVH + e0 + (tid & 7) * 8) = hw; }
            bf16x8 Yq[4], Xk[2][4]; f32x4 c4[2]; float cms = 0.f;
            if (!isc) {
#pragma unroll
                for (int ks = 0; ks < 4; ++ks) Yq[ks] = *(const LAS bf16x8*)(lds + SQ_OFF + s_pos * QKSTR + (32 * ks + 8 * fq) * 2);
#pragma unroll
                for (int jj = 0; jj < 2; ++jj)
#pragma unroll
                    for (int ks = 0; ks < 4; ++ks) Xk[jj][ks] = *(const LAS bf16x8*)(lds + SK_OFF + (16 * (2 * hf + jj) + fr) * QKSTR + (32 * ks + 8 * fq) * 2);
#pragma unroll
                for (int jj = 0; jj < 2; ++jj) c4[jj] = *(const LAS f32x4*)(cjA + st * 64 + 16 * (2 * hf + jj) + 4 * fq);
                cms = cmA[st * 64 + s_pos];
            }
            __builtin_amdgcn_sched_barrier(0);
            auto kwblock = [&]() {
                v4u kraw[2]; float cjw[2];
#pragma unroll
                for (int i = 0; i < 2; ++i) { const int r = prow + 32 * i; kraw[i] = *(const LAS v4u*)(lds + SK_OFF + r * QKSTR + pch * 16); cjw[i] = cjA[st * 64 + r]; }
#pragma unroll
                for (int i = 0; i < 2; ++i) { const int r = prow + 32 * i; const float wj = fexp(cjw[i] - ML_t);
                    float kf[8]; unpack8(kraw[i], kf); v4u kw; kw.x = pk2(kf[0] * wj, kf[1] * wj); kw.y = pk2(kf[2] * wj, kf[3] * wj); kw.z = pk2(kf[4] * wj, kf[5] * wj); kw.w = pk2(kf[6] * wj, kf[7] * wj);
                    *(LAS v4u*)(lds + SKW_OFF + r * QSTR + pch * 16) = kw; }
                };
            *(LAS v4u*)(lds + SV_OFF + VROW(vrow) + vch * 16) = RV;
            load_v(st + 2, RV);
            if (isc || hf == 0) { kwblock(); __builtin_amdgcn_sched_barrier(0); }
            f32x4 a2[3]; float Ms = 0.f;
            if (!isc) {
                Ms = fmaxf(m_t, cms);
                f32x4 sacc[2];
#pragma unroll
                for (int jj = 0; jj < 2; ++jj) { sacc[jj] = (f32x4){0.f, 0.f, 0.f, 0.f};
#pragma unroll
                    for (int ks = 0; ks < 4; ++ks) sacc[jj] = __builtin_amdgcn_mfma_f32_16x16x32_bf16(Xk[jj][ks], Yq[ks], sacc[jj], 0, 0, 0); }
                __builtin_amdgcn_sched_barrier(0);
                auto pmath = [&]() {
#pragma unroll
                    for (int jj = 0; jj < 2; ++jj) { const int jb = 2 * hf + jj; float p[4];
#pragma unroll
                        for (int r = 0; r < 4; ++r) { const int j_pos = 16 * jb + 4 * fq + r; const bool ok = dir ? (j_pos >= s_pos) : (j_pos <= s_pos); p[r] = sacc[jj][r] * fexp(ok ? (c4[jj][r] - Ms) : -1e30f); }
                        v2u pw; pw.x = pk2(p[0], p[1]); pw.y = pk2(p[2], p[3]);
                        *(LAS v2u*)(lds + SP_OFF + s_pos * PSTR + (16 * jb + 4 * fq) * 2) = pw; } };
                auto qcmma = [&]() {
                    bf16x8 Xc[3][4];
#pragma unroll
                    for (int ti = 0; ti < 3; ++ti) { const int e = (ti == 2) ? 4 : 2 * hf + ti;
#pragma unroll
                        for (int ks = 0; ks < 4; ++ks) Xc[ti][ks] = *(const LAS bf16x8*)(lds + SCB_OFF + (16 * e + fr) * QSTR + (32 * ks + 8 * fq) * 2); }
                    __builtin_amdgcn_sched_barrier(0);
#pragma unroll
                    for (int ti = 0; ti < 3; ++ti) { a2[ti] = (f32x4){0.f, 0.f, 0.f, 0.f};
#pragma unroll
                        for (int ks = 0; ks < 4; ++ks) a2[ti] = __builtin_amdgcn_mfma_f32_16x16x32_bf16(Xc[ti][ks], Yq[ks], a2[ti], 0, 0, 0); } };
                if (hf == 0) { pmath(); qcmma(); } else { qcmma(); __builtin_amdgcn_sched_barrier(0); pmath(); kwblock(); }
            }
            SCAN_BAR();
            {
                const float decay = fexp(m_t - ML_t);
                bf16x8 Xkw[2], Yp[2], Yv[5][2]; float bss = 0.f;
#pragma unroll
                for (int ks = 0; ks < 2; ++ks) { LAS unsigned char* p = lds + SKW_OFF + (32 * ks + 8 * fq + tq) * QSTR + (16 * wave + 4 * tp) * 2; Xkw[ks] = tr_frag(p, p + 4 * QSTR); }
#pragma unroll
                for (int e = 0; e < 5; ++e)
#pragma unroll
                    for (int ks = 0; ks < 2; ++ks) { LAS unsigned char* p = lds + SV_OFF + VROW(32 * ks + 8 * fq + tq) + (16 * e + 4 * tp) * 2; Yv[e][ks] = tr_frag(p, p + 4 * VSTR); }
                if (!isc) {
#pragma unroll
                    for (int ks = 0; ks < 2; ++ks) Yp[ks] = *(const LAS bf16x8*)(lds + SP_OFF + s_pos * PSTR + (32 * ks + 8 * fq) * 2);
                    bss = bsA[st * 64 + s_pos];
                }
                __builtin_amdgcn_sched_barrier(0);
                f32x4 o[3];
#pragma unroll
                for (int e = 0; e < 5; ++e) {
                    if (!isc && (e == 4 || hf == (e >> 1))) { const int ti = (e == 4) ? 2 : (e & 1); f32x4 a1 = (f32x4){0.f, 0.f, 0.f, 0.f};
#pragma unroll
                        for (int ks = 0; ks < 2; ++ks) a1 = __builtin_amdgcn_mfma_f32_16x16x32_bf16(Yv[e][ks], Yp[ks], a1, 0, 0, 0);
                        o[ti] = a1; }
                    Cacc[e] = Cacc[e] * decay;
#pragma unroll
                    for (int ks = 0; ks < 2; ++ks) Cacc[e] = __builtin_amdgcn_mfma_f32_16x16x32_bf16(Xkw[ks], Yv[e][ks], Cacc[e], 0, 0, 0); }
#pragma unroll
                for (int e = 0; e < 5; ++e) { v2u cw; cw.x = pk2(Cacc[e][0], Cacc[e][1]); cw.y = pk2(Cacc[e][2], Cacc[e][3]);
                    *(LAS v2u*)(lds + SCB_OFF + (16 * e + fr) * QSTR + (16 * wave + 4 * fq) * 2) = cw; }
#pragma unroll
                for (int i = 0; i < 2; ++i) { *(LAS v4u*)(lds + SQ_OFF + (prow + 32 * i) * QKSTR + pch * 16) = RQ[i]; *(LAS v4u*)(lds + SK_OFF + (prow + 32 * i) * QKSTR + pch * 16) = RK[i]; }
                load_qk(st + 3, RQ, RK);
                if (!isc) {
                    const float wint = fexp(m_t - Ms), hden = fexp(-(bss + Ms));
#pragma unroll
                    for (int ti = 0; ti < 3; ++ti) o[ti] = o[ti] + a2[ti] * wint;
                    const float den = __shfl(o[2][0], fr);
                    const float inv = 1.0f / fmaxf(fabsf(den), hden);
#pragma unroll
                    for (int ti = 0; ti < 2; ++ti) { const int e = 2 * hf + ti; const f32x4 hv = o[ti] * inv; v2u w; w.x = pk2(hv[0], hv[1]); w.y = pk2(hv[2], hv[3]);
                        *(LAS v2u*)(lds + SHS_OFF + s_pos * PSTR + (16 * e + 4 * fq) * 2) = w; }
                }
            }
            SCAN_BAR();
        };
        step(0, true, rq[1], rk[1], rv[0]); step(1, true, rq[0], rk[0], rv[1]); step(2, true, rq[1], rk[1], rv[0]); step(3, true, rq[0], rk[0], rv[1]);
        for (int g = 1; g < 17; ++g) { const int st = 4 * g;
            step(st, false, rq[1], rk[1], rv[0]); step(st + 1, false, rq[0], rk[0], rv[1]); step(st + 2, false, rq[1], rk[1], rv[0]); step(st + 3, false, rq[0], rk[0], rv[1]); }
        { const v4u hw = *(const LAS v4u*)(lds + SHS_OFF + (tid >> 3) * PSTR + (tid & 7) * 16); *(v4u*)(HO + (size_t)(row_of(67) + (tid >> 3)) * D + h * DVH + e0 + (tid & 7) * 8) = hw; }
    }
}

constexpr int NPHASES = 24;
__global__ void __launch_bounds__(NWAVES * 64, 2) fwd_kernel(KArgs a) {
    extern __shared__ __attribute__((aligned(16))) unsigned char lds_raw[];
    LAS unsigned char* lds = (LAS unsigned char*)lds_raw;
    const int tid = threadIdx.x, lane = tid & 63, wave = __builtin_amdgcn_readfirstlane(tid >> 6);
    const int G = gridDim.x, bx = blockIdx.x, vcu = (G % 8 == 0) ? (bx % 8) * (G / 8) + bx / 8 : bx;
    const int gw = vcu * NWAVES + wave, NGW = G * NWAVES;
    unsigned char* ws = a.ws;
    unsigned* ctl = (unsigned*)(ws + WS_CTL);
    volatile LAS unsigned* MISC = (volatile LAS unsigned*)(lds + LDSCTL_OFF);
    for (int u = tid; u < (LDS_BYTES - LDSCTL_OFF) / 4; u += NWAVES * 64) ((LAS unsigned*)(lds + LDSCTL_OFF))[u] = 0u;
    __syncthreads();
    XcdBarrier bar; bar.bar = ctl + CW_BAR; bar.x = 0; bar.st = nullptr;
#if !MK_PER_PHASE
    bar = xcd_barrier_post(ctl + CW_BAR, MISC + 8);
#endif
    const int lo = a.ph_lo, hi = a.ph_hi;
#define IN(k) (lo <= (k) && (k) < hi)
#if MK_PER_PHASE
#define SEAM(k) do { } while (0)
#else
#define SEAM(k) do { if (IN(k) && IN((k) + 1)) xcd_barrier(bar); } while (0)
#endif
#define x_in (a.in[0])
#define ctx_in (a.in[2])
#define X ((float*)(ws + WS_X))
#define HB ((bf16*)(ws + WS_HB))
#define ACT ((bf16*)(ws + WS_ACT))
#define QKVO ((bf16*)(ws + WS_QKVO))
#define GATES ((float*)(ws + WS_GATES))
#define HF ((bf16*)(ws + WS_HF))
#define HBW ((bf16*)(ws + WS_HBW))
#define mod ((const float*)(ws + WS_MOD))
#define WFI ((const bf16*)(ws + WS_WFI))
#define WFO ((const bf16*)(ws + WS_WFO))
#define normg (a.in[6])
#define GS ((float*)(ws + WS_GS))
#define SS ((float*)(ws + WS_SS))
#define RSTD ((float*)(ws + WS_RSTD))
#define BIAS ((float*)(ws + WS_BIAS))
#define YB ((bf16*)(ws + WS_ACT))
#define BG ((bf16*)(ws + WS_QKVO))
#define ZB ((bf16*)(ws + WS_QKVO) + (size_t)MX * D)
    const int gtid = bx * NWAVES * 64 + tid, NGT = G * NWAVES * 64;
    if (IN(0)) { mod_partials(a, 0, gw, NGW, lane); mod_partials(a, 1, gw, NGW, lane); convert_list<0>(a, lds, gw, NGW, wave, lane); }
    SEAM(0);
    if (IN(1)) modreduce_phase((const float*)(ws + WS_MODP), a.in[5], normg, a.in[16], (float*)(ws + WS_MOD), GS, (float*)(ws + WS_RGS), gtid, NGT);
    SEAM(1);
#define FFN_UP(p, wi, rows, FOLDV, boff) do { if (IN(p)) { pg8::Gemm g{HB, WFI + (size_t)(wi) * NFI * D, rows, NFI, D}; pg8::StaticOrder S; S.init(rows, NFI, G, bx, D); if (FOLDV) panel_rstd(S, SS, RSTD, tid); \
        pg8::EpiSwigluT<FOLDV> E{ACT, DFF, pg8::Fold{ws, (boff)}}; pg8::gemm_phase<pg8::EpiSwigluT<FOLDV>, pg8::StaticOrder, true, true, true>(lds, g, S, E); } SEAM(p); } while (0)
#define FFN_DOWN(p, wi, l, j, SRCV, NEXTV, nsub) do { if (IN(p)) { pg8::Gemm g{ACT, WFO + (size_t)(wi) * D * DFF, MX, D, DFF}; pg8::StaticOrder S; S.init(MX, D, G, bx, DFF, 4); \
        pg8::EpiResidT<SRCV, NEXTV, true> E{x_in, ctx_in, ws, (l) * 5 * MODW + (3 * (j) + 2) * D, (l) * 3 + (j), (nsub)}; \
        pg8::gemm_phase<pg8::EpiResidT<SRCV, NEXTV, true>, pg8::StaticOrder, true, true, true>(lds, g, S, E); } } while (0)

    if (IN(2)) { normmod_phase(x_in, ctx_in, MT, normg + (0 * 3 + 0) * D, mod, 0, HB, gw, NGW, lane);
        convert_list<1>(a, lds, gw, NGW, wave, lane); convert_list<2>(a, lds, gw, NGW, wave, lane); }
    SEAM(2);
    if (IN(3)) { pg8::Gemm g{HB, WFI, MT, NFI, D}; pg8::StaticOrder S; S.init(MT, NFI, G, bx, D);
        pg8::EpiSwigluT<false> E{ACT, DFF, pg8::Fold{ws, 0}}; pg8::gemm_phase<pg8::EpiSwigluT<false>, pg8::StaticOrder, true, true, true>(lds, g, S, E);
        { int rank, cnt; if (tail_rank((MT / 256) * (NFI / 256), G, bx, rank, cnt)) biasreduce_phase((const float*)(ws + WS_BIASP), BIAS, rank * NWAVES * 64 + tid, cnt * NWAVES * 64); } }
    SEAM(3);
    if (IN(4)) { FFN_DOWN(4, 0, 0, 0, true, true, 1);
        { pg8::Gemm g{ACT, WFO, MT, D, DFF}; pg8::SplitKOrder S{G, bx, MX / 256};
          pg8::EpiPartial E{(float*)(ws + WS_CTXP), MX, (size_t)MC * D};
          pg8::gemm_phase<pg8::EpiPartial, pg8::SplitKOrder, true, true, true>(lds, g, S, E); } }
    SEAM(4);
    if (IN(5)) { rowstat_phase(SS, RSTD, true, gtid, NGT);
        normmod_phase(X, ctx_in, MT, normg + (0 * 3 + 1) * D, mod, 1, HB, gw, NGW, lane, (const float*)(ws + WS_CTXP), mod + (size_t)4 * MODW + (3 * 0 + 2) * D, MX); }
    SEAM(5);
    if (IN(6)) { pg8::Gemm g{HB, (const bf16*)(ws + WS_WMI), MT, NML, D}; pg8::StaticOrder S; S.init(MT, NML, G, bx, D); pg8::EpiMlstmInT<true> E{QKVO, GATES, a.in[10], pg8::Fold{ws, BOFF_MI}};
        pg8::gemm_phase<pg8::EpiMlstmInT<true>, pg8::StaticOrder, true, true, true>(lds, g, S, E); }
    SEAM(6);
    if (PROBE_DUP == 6) { pg8::Gemm g{HB, (const bf16*)(ws + WS_WMI), MT, NML, D}; pg8::StaticOrder S; S.init(MT, NML, G, bx, D); pg8::EpiMlstmInT<true> E{QKVO, GATES, a.in[10], pg8::Fold{ws, BOFF_MI}};
        pg8::gemm_phase<pg8::EpiMlstmInT<true>, pg8::StaticOrder, true, true, true>(lds, g, S, E); xcd_barrier(bar); }
    if (IN(7)) scan_phase<0>(lds, QKVO, GATES, HF, HBW, vcu, G, tid, lane, wave);
    SEAM(7);
    if (IN(8)) headnorm_phase(HF, HBW, QKVO, a.in[11], YB, gw, NGW, lane);
    SEAM(8);
    if (PROBE_DUP == 8) { headnorm_phase(HF, HBW, QKVO, a.in[11], YB, gw, NGW, lane); xcd_barrier(bar); }
    if (IN(9)) { pg8::Gemm g{YB, (const bf16*)(ws + WS_WMO), MX, D, D}; pg8::StaticOrder S; S.init(MX, D, G, bx, D, 4);
        pg8::EpiResidT<false, true, false> E{x_in, ctx_in, ws, (3 * 1 + 2) * D, 1, 2};
        pg8::gemm_phase<pg8::EpiResidT<false, true, false>, pg8::StaticOrder, true, true, true>(lds, g, S, E); }
    SEAM(9);
    FFN_UP(11, 1, MX, true, BOFF_F1);
    FFN_DOWN(12, 1, 0, 2, false, true, 3); SEAM(12);
    if (PROBE_DUP == 12) { pg8::Gemm g{ACT, WFO + (size_t)1 * D * DFF, MX, D, DFF}; pg8::StaticOrder S; S.init(MX, D, G, bx, DFF); pg8::EpiPartial E{(float*)(ws + WS_QKVO), 0, (size_t)0};
        pg8::gemm_phase<pg8::EpiPartial, pg8::StaticOrder, true, true, true>(lds, g, S, E); xcd_barrier(bar); }
    FFN_UP(14, 2, MX, true, BOFF_F2);
    FFN_DOWN(15, 2, 1, 0, false, true, 4); SEAM(15);
    if (IN(17)) { pg8::Gemm g{HB, (const bf16*)(ws + WS_WCI), MX, NCV, D}; pg8::StaticOrder S; S.init(MX, NCV, G, bx, D); panel_rstd(S, SS, RSTD, tid); pg8::EpiConvInT<true> E{BG, ZB, pg8::Fold{ws, BOFF_CI}};
        pg8::gemm_phase<pg8::EpiConvInT<true>, pg8::StaticOrder, true, true, true>(lds, g, S, E); }
    SEAM(17);
    if (IN(18)) convmix_phase(BG, ZB, a.in[14], YB, gw, NGW, lane);
    SEAM(18);
    if (IN(19)) { pg8::Gemm g{YB, (const bf16*)(ws + WS_WCO), MX, D, D}; pg8::StaticOrder S; S.init(MX, D, G, bx, D, 4);
        pg8::EpiResidT<false, true, false> E{x_in, ctx_in, ws, 5 * MODW + (3 * 1 + 2) * D, 4, 5};
        pg8::gemm_phase<pg8::EpiResidT<false, true, false>, pg8::StaticOrder, true, true, true>(lds, g, S, E); }
    SEAM(19);
    FFN_UP(21, 3, MX, true, BOFF_F3);
    FFN_DOWN(22, 3, 1, 2, false, true, 6); SEAM(22);
    if (IN(23)) final_norm_phase(HB, SS, a.out, gw, NGW, lane);
#undef FFN_UP
#undef FFN_DOWN
#undef x_in
#undef ctx_in
#undef X
#undef HB
#undef ACT
#undef QKVO
#undef GATES
#undef HF
#undef HBW
#undef mod
#undef WFI
#undef WFO
#undef normg
#undef GS
#undef SS
#undef RSTD
#undef BIAS
#undef YB
#undef BG
#undef ZB
#undef IN
#undef SEAM
}

extern "C" void kernel_launch(void* const* d_in, const int* in_sizes, int n_in, void* d_out, int out_size, void* d_ws, size_t ws_size, hipStream_t stream) {
    static int grid = 0;
    if (grid == 0) {
        if (n_in != 17 || in_sizes[0] != MX * D || out_size != MX * D || ws_size < WS_END) { fprintf(stderr, "kernel_launch: unexpected shapes (n_in %d, in0 %d, out %d, ws %zu)\n", n_in, n_in > 0 ? in_sizes[0] : -1, out_size, ws_size); grid = -1; return; }
        int dev = 0, cus = 0, per_cu = 0;
        if (hipGetDevice(&dev) != hipSuccess || hipDeviceGetAttribute(&cus, hipDeviceAttributeMultiprocessorCount, dev) != hipSuccess) { fprintf(stderr, "kernel_launch: device query failed\n"); grid = -1; return; }
        if (hipFuncSetAttribute((const void*)fwd_kernel, hipFuncAttributeMaxDynamicSharedMemorySize, LDS_BYTES) != hipSuccess) { fprintf(stderr, "kernel_launch: hipFuncSetAttribute failed\n"); grid = -1; return; }
        if (hipOccupancyMaxActiveBlocksPerMultiprocessor(&per_cu, (const void*)fwd_kernel, NWAVES * 64, LDS_BYTES) != hipSuccess || per_cu < 1) { fprintf(stderr, "kernel_launch: occupancy query reports %d workgroups per CU\n", per_cu); }
        (void)hipGetLastError();
        grid = cus;
    }
    if (grid < 0) return;
    if (hipMemsetAsync((char*)d_ws + WS_CTL, 0, CTL_ZERO_BYTES, stream) != hipSuccess) { fprintf(stderr, "kernel_launch: memset failed\n"); return; }
    KArgs a{};
    for (int i = 0; i < 17; ++i) a.in[i] = (const float*)d_in[i];
    a.out = (float*)d_out; a.ws = (unsigned char*)d_ws;
#if MK_PER_PHASE
    for (int p = 0; p < NPHASES; ++p) { a.ph_lo = p; a.ph_hi = p + 1; hipLaunchKernelGGL(fwd_kernel, dim3(grid), dim3(NWAVES * 64), LDS_BYTES, stream, a); }
#else
    a.ph_lo = 0; a.ph_hi = NPHASES;
    hipLaunchKernelGGL(fwd_kernel, dim3(grid), dim3(NWAVES * 64), LDS_BYTES, stream, a);
#endif
    const hipError_t le = hipPeekAtLastError();
    if (le != hipSuccess) fprintf(stderr, "kernel_launch: launch failed: %s\n", hipGetErrorName(le));
}
```

```cpp
#include <hip/hip_runtime.h>
#include <cstdio>
#include <cstdint>

#ifndef PROBE_DUP
#define PROBE_DUP -1
#endif
#ifndef TAILS
#define TAILS 0
#endif
#ifndef MK_PER_PHASE
#define MK_PER_PHASE 0
#endif

constexpr int NWAVES = 8;
constexpr int BATCH = 4, SEQ = 4096, D = 2048, CTXL = 256, NH = 8, DKH = 128, DVH = 256, DFF = 5504;
constexpr int MX = BATCH * SEQ, MC = BATCH * CTXL, MT = MX + MC;
constexpr int NFI = 2 * DFF;
constexpr int NML = 6400, NMLSRC = 6176, NCV = 6144;
constexpr int MODW = 9 * D;
constexpr float RMS_EPS = 1e-6f;
__host__ __device__ __forceinline__ size_t hb_off(int r, int c) { return (((size_t)(r >> 8) * (D / 64) + (c >> 6)) * 256 + (r & 255)) * 64 + (c & 63); }

constexpr size_t MiB = 1u << 20;
constexpr size_t WS_CTL = 0, CTL_ZERO_BYTES = 64 * 1024;
constexpr size_t WS_MOD = 1 * MiB;
constexpr size_t WS_WFI = 2 * MiB;
constexpr size_t WS_WFO = 174 * MiB;
constexpr size_t WS_WMI = 260 * MiB;
constexpr size_t WS_WMO = 285 * MiB;
constexpr size_t WS_WCI = 293 * MiB;
constexpr size_t WS_WCO = 317 * MiB;
constexpr size_t WS_X = 326 * MiB;
constexpr size_t WS_HB = 462 * MiB;
constexpr size_t WS_ACT = 530 * MiB;
constexpr size_t WS_QKVO = 713 * MiB;
constexpr size_t QH_OFF = 0, KH_OFF = (size_t)17408 * 1024, VH_OFF = (size_t)17408 * 2048, OG_OFF = (size_t)17408 * 4096;
constexpr int CTX_SLOT0 = 4 * 8 * 4096;
constexpr size_t WS_GATES = 917 * MiB;
constexpr size_t WS_HF = 920 * MiB, WS_HBW = 984 * MiB;
constexpr size_t WS_MODP = WS_HF;
constexpr size_t WS_CTXP = 1048 * MiB;
constexpr int NBCOL = 45568;
constexpr int BOFF_MI = 0, BOFF_F1 = 6400, BOFF_F2 = 17408, BOFF_CI = 28416, BOFF_F3 = 34560;
constexpr size_t WS_BIASP = 1112 * MiB;
constexpr size_t WS_BIAS = 1142 * MiB;
constexpr size_t WS_GS = 1144 * MiB;
constexpr size_t WS_RGS = 1144 * MiB + 512 * 1024;
constexpr size_t WS_SS = 1145 * MiB;
constexpr size_t WS_RSTD = 1148 * MiB;
constexpr size_t WS_END = 1149 * MiB;
constexpr int CW_BAR = 4096;

namespace pg8 {
#define PG8_LAS __attribute__((address_space(3)))
typedef unsigned short bf16_t;
typedef short bf16x8 __attribute__((ext_vector_type(8)));
typedef float f32x4 __attribute__((ext_vector_type(4)));
typedef unsigned u32x4 __attribute__((ext_vector_type(4)));
constexpr int BM = 256, BK = 64, HALF = 128, HTB = HALF * BK * 2, STAGE_BYTES = 8 * HTB, NXCD = 8, WGM = 8;

__host__ __device__ __forceinline__ int lds_byte(int r, int c) { const int st = (r >> 4) * 2 + (c >> 5), rr = r & 15, cc = c & 31, ob = rr * 64 + cc * 2; return st * 1024 + (ob ^ (((ob >> 9) & 1) << 5)); }
__host__ __device__ __forceinline__ void stage_rc(int b, int& R, int& C) { const int st = b / 1024, sb = b % 1024, swz = sb ^ (((sb >> 9) & 1) << 5); R = (st >> 1) * 16 + swz / 64; C = (st & 1) * 32 + (swz % 64) / 2; }
__host__ __device__ __forceinline__ int perm32(int rho) { const int n = rho >> 4, i = rho & 15; return 8 * (i >> 2) + 4 * n + (i & 3); }

struct Unit { int pm, pn, k0, nt; };
struct Gemm { const bf16_t* A; const bf16_t* Bt; int M, N, K; };

struct StaticOrder {
    int nM, nN, nwg, G, c, ntk, wgm;
    __host__ __device__ void init(int M, int N, int G_, int c_, int K_, int wgm_ = WGM) { nM = M / BM; nN = N / BM; nwg = nM * nN; G = G_; c = c_; ntk = K_ / BK; wgm = wgm_; }
    __host__ __device__ bool next(int i, Unit& u) const {
        const long L = (long)i * G + c; if (L >= nwg) return false;
        int wgid = (int)L; { const int q = nwg / NXCD, r = nwg % NXCD, xcd = wgid % NXCD, off = wgid / NXCD; wgid = (xcd < r ? xcd * (q + 1) : r * (q + 1) + (xcd - r) * q) + off; }
        const int nig = wgm * nN, gid = wgid / nig, fm = gid * wgm, gsz = (nM - fm) < wgm ? (nM - fm) : wgm;
        u.pm = fm + ((wgid % nig) % gsz); u.pn = (wgid % nig) / gsz; u.k0 = 0; u.nt = ntk; return true;
    }
    __device__ __forceinline__ void a_ready(const Unit&) const {}
    __device__ __forceinline__ void done(const Unit&) const {}
};

typedef __bf16 bf16x2_t __attribute__((ext_vector_type(2)));
typedef float f32x2_t __attribute__((ext_vector_type(2)));
struct SplitKOrder {
    int G, c, pm0;
    __device__ __forceinline__ bool next(int i, Unit& u) const { const long L = (long)i * G + c; if (L >= 256) return false; const int w = (int)L, sl = w & 7, tile = w >> 3;
        u.pm = pm0 + (tile >> 3); u.pn = tile & 7; const int p0 = sl < 5 ? 5 * sl : 25 + 6 * (sl - 5), np = sl < 5 ? 5 : 6; u.k0 = p0 * 128; u.nt = np * 2; return true; }
    __device__ __forceinline__ void a_ready(const Unit&) const {}
    __device__ __forceinline__ void done(const Unit&) const {}
};
__device__ __forceinline__ unsigned cvt_pk_bf16(float lo, float hi) { const f32x2_t v = {lo, hi}; const bf16x2_t b = __builtin_convertvector(v, bf16x2_t); return __builtin_bit_cast(unsigned, b); }
__device__ __forceinline__ float silu_f(float x) { return x * __builtin_amdgcn_rcpf(1.0f + __builtin_amdgcn_exp2f(-1.44269504f * x)); }
__device__ __forceinline__ unsigned swiglu_pk(float ga, float gb, float ua, float ub) {
    const f32x2_t g = {ga, gb}, u = {ua, ub}; const f32x2_t t = g * (f32x2_t){-1.44269504f, -1.44269504f};
    const f32x2_t e = {__builtin_amdgcn_exp2f(t[0]), __builtin_amdgcn_exp2f(t[1])}; const f32x2_t d = e + (f32x2_t){1.0f, 1.0f};
    const f32x2_t r = {__builtin_amdgcn_rcpf(d[0]), __builtin_amdgcn_rcpf(d[1])}; const f32x2_t o = (g * u) * r;
    const bf16x2_t b = __builtin_convertvector(o, bf16x2_t); return __builtin_bit_cast(unsigned, b); }


struct Fold { const unsigned char* ws; int boff;
    __device__ __forceinline__ const float* rstd() const { return (const float*)(ws + WS_RSTD); }
    __device__ __forceinline__ const float* bias(int bidx) const { return (const float*)(ws + WS_BIAS) + (size_t)bidx * NBCOL + boff; }
    __device__ __forceinline__ void rows8(int row0, float (&rs)[2][4]) const {
#pragma unroll
        for (int ai = 0; ai < 2; ++ai)
#pragma unroll
            for (int m = 0; m < 4; ++m) rs[ai][m] = rstd()[row0 + ai * HALF + m * 16]; } };
template <bool FOLD> struct EpiSwigluT {
    static constexpr bool PERM = true, AFTER_DRAIN = false; static constexpr int NSTORE = 8;
    bf16_t* O; int ldc; Fold F;
    __device__ __forceinline__ void operator()(const f32x4 (&acc)[2][2][4][2], const Unit& u, int wr, int wc, int fr, int fq) const {
        const int row0 = u.pm * BM + wr * 64 + fr, col0 = u.pn * HALF + wc * 32 + 8 * fq;
        f32x4 bg[2], bu[2];
        if (FOLD) { const int bidx = (u.pm * BM >= MX) ? 5 : (u.pm >> 4); const float* bp = F.bias(bidx) + u.pn * BM + wc * 32 + 8 * fq;
            bg[0] = *(const f32x4*)bp; bg[1] = *(const f32x4*)(bp + 4); bu[0] = *(const f32x4*)(bp + HALF); bu[1] = *(const f32x4*)(bp + HALF + 4); }
        float rsv[2][4]; if (FOLD) F.rows8(row0, rsv);
#pragma unroll
        for (int ai = 0; ai < 2; ++ai)
#pragma unroll
            for (int m = 0; m < 4; ++m) { const int r = row0 + ai * HALF + m * 16; bf16_t* rowp = O + (((size_t)u.pm * (ldc / BK) + (col0 >> 6)) * BM + (r & (BM - 1))) * BK + (col0 & (BK - 1));
                f32x4 g0 = acc[ai][0][m][0], g1 = acc[ai][0][m][1], u0 = acc[ai][1][m][0], u1 = acc[ai][1][m][1];
                if (FOLD) { const float rs = rsv[ai][m]; g0 = g0 * rs + bg[0]; g1 = g1 * rs + bg[1]; u0 = u0 * rs + bu[0]; u1 = u1 * rs + bu[1]; }
                u32x4 w; w.x = swiglu_pk(g0[0], g0[1], u0[0], u0[1]); w.y = swiglu_pk(g0[2], g0[3], u0[2], u0[3]);
                w.z = swiglu_pk(g1[0], g1[1], u1[0], u1[1]); w.w = swiglu_pk(g1[2], g1[3], u1[2], u1[3]);
                *(u32x4*)rowp = w; }
    }
};
template <bool SRC32, bool NEXT, bool HALFC> struct EpiResidT {
    static constexpr bool PERM = true, AFTER_DRAIN = false; static constexpr int NSTORE = 16;
    const float* xin_x; const float* xin_c; unsigned char* ws; int gate_off, psub, nsub;
    __device__ __forceinline__ void operator()(const f32x4 (&acc)[2][2][4][2], const Unit& u, int wr, int wc, int fr, int fq) const {
        const bool isc = (u.pm * BM) >= MX; const int bidx = isc ? 4 : (u.pm >> 4); const float coef = HALFC ? 0.5f : 1.0f;
        float* X = (float*)(ws + WS_X); bf16_t* XS = (bf16_t*)(ws + WS_HB); float* SS = (float*)(ws + WS_SS);
        const float* gv = (const float*)(ws + WS_MOD) + gate_off + (size_t)bidx * MODW; const float* gs = (const float*)(ws + WS_GS) + ((size_t)nsub * 5 + bidx) * D;
        const float* rg = (const float*)(ws + WS_RGS) + ((size_t)psub * 5 + bidx) * D;
        const int col0 = u.pn * BM + wc * 32 + 8 * fq; const int row0 = u.pm * BM + wr * 64 + fr;
        f32x4 gg[2][2], gsv[2][2], rgv[2][2];
#pragma unroll
        for (int bj = 0; bj < 2; ++bj)
#pragma unroll
            for (int n = 0; n < 2; ++n) { gg[bj][n] = *(const f32x4*)(gv + col0 + bj * HALF + 4 * n) * coef; if (NEXT) gsv[bj][n] = *(const f32x4*)(gs + col0 + bj * HALF + 4 * n);
                if (!SRC32) rgv[bj][n] = *(const f32x4*)(rg + col0 + bj * HALF + 4 * n); }
#pragma unroll
        for (int ai = 0; ai < 2; ++ai)
#pragma unroll
            for (int m = 0; m < 4; ++m) { const int r = row0 + ai * HALF + m * 16; float sq = 0.f;
                const float* src = (isc ? xin_c + (size_t)(r - MX) * D : xin_x + (size_t)r * D) + col0;
#pragma unroll
                for (int bj = 0; bj < 2; ++bj) { const size_t eo = (size_t)r * D + col0 + bj * HALF, xe = hb_off(r, col0 + bj * HALF); f32x4 xo0, xo1;
                    if (SRC32) { xo0 = __builtin_nontemporal_load((const f32x4*)(src + bj * HALF)); xo1 = __builtin_nontemporal_load((const f32x4*)(src + bj * HALF + 4)); }
                    else { const u32x4 w = *(const u32x4*)(XS + xe);
                        xo0 = (f32x4){__builtin_bit_cast(float, w.x << 16), __builtin_bit_cast(float, w.x & 0xffff0000u), __builtin_bit_cast(float, w.y << 16), __builtin_bit_cast(float, w.y & 0xffff0000u)} * rgv[bj][0];
                        xo1 = (f32x4){__builtin_bit_cast(float, w.z << 16), __builtin_bit_cast(float, w.z & 0xffff0000u), __builtin_bit_cast(float, w.w << 16), __builtin_bit_cast(float, w.w & 0xffff0000u)} * rgv[bj][1]; }
                    const f32x4 xn0 = xo0 + acc[ai][bj][m][0] * gg[bj][0], xn1 = xo1 + acc[ai][bj][m][1] * gg[bj][1];
                    if (NEXT) { const f32x4 y0 = xn0 * gsv[bj][0], y1 = xn1 * gsv[bj][1]; u32x4 w; w.x = cvt_pk_bf16(y0[0], y0[1]); w.y = cvt_pk_bf16(y0[2], y0[3]); w.z = cvt_pk_bf16(y1[0], y1[1]); w.w = cvt_pk_bf16(y1[2], y1[3]);
                        *(u32x4*)(XS + xe) = w; sq += ((xn0[0] * xn0[0] + xn0[1] * xn0[1]) + (xn0[2] * xn0[2] + xn0[3] * xn0[3])) + ((xn1[0] * xn1[0] + xn1[1] * xn1[1]) + (xn1[2] * xn1[2] + xn1[3] * xn1[3])); }
                    else { *(f32x4*)(X + eo) = xn0; *(f32x4*)(X + eo + 4) = xn1; } }
                if (NEXT) { sq += __shfl_xor(sq, 16); sq += __shfl_xor(sq, 32); if (fq == 0) SS[(size_t)r * 32 + u.pn * 4 + wc] = sq; }
                if (SRC32 && m == 3) asm volatile("" ::: "memory"); }
    }
};
struct EpiPartial {
    static constexpr bool PERM = false, AFTER_DRAIN = false; static constexpr int NSTORE = 32;
    float* P; int row0; size_t slice_stride;
    __device__ __forceinline__ void operator()(const f32x4 (&acc)[2][2][4][2], const Unit& u, int wr, int wc, int fr, int fq) const {
        const int sl = u.k0 < 25 * 128 ? u.k0 / (5 * 128) : 5 + (u.k0 - 25 * 128) / (6 * 128);
        float* base = P + (size_t)sl * slice_stride; const int col0 = u.pn * BM + wc * 32 + 4 * fq, r0 = u.pm * BM - row0 + wr * 64 + fr;
#pragma unroll
        for (int ai = 0; ai < 2; ++ai)
#pragma unroll
            for (int m = 0; m < 4; ++m) { float* rowp = base + (size_t)(r0 + ai * HALF + m * 16) * 2048 + col0;
#pragma unroll
                for (int bj = 0; bj < 2; ++bj)
#pragma unroll
                    for (int n = 0; n < 2; ++n) *(f32x4*)(rowp + bj * HALF + n * 16) = acc[ai][bj][m][n]; }
    }
};
template <bool FOLD> struct EpiMlstmInT {
    static constexpr bool PERM = true, AFTER_DRAIN = false; static constexpr int NSTORE = 0;
    bf16_t* O; float* G; const float* bgate; Fold F;
    __device__ __forceinline__ void operator()(const f32x4 (&acc)[2][2][4][2], const Unit& u, int wr, int wc, int fr, int fq) const {
        const int row0 = u.pm * BM + wr * 64 + fr;
        f32x4 bv[2][2];
#pragma unroll
        for (int bj = 0; bj < 2; ++bj)
#pragma unroll
            for (int n = 0; n < 2; ++n) bv[bj][n] = (f32x4){0.f, 0.f, 0.f, 0.f};
        if (FOLD) { const int bidx = (u.pm * BM >= MX) ? 5 : (u.pm >> 4); const float* bp = F.bias(bidx) + u.pn * BM + wc * 32 + 8 * fq;
#pragma unroll
            for (int bj = 0; bj < 2; ++bj)
#pragma unroll
                for (int n = 0; n < 2; ++n) bv[bj][n] = *(const f32x4*)(bp + bj * HALF + 4 * n); }
        if (u.pn < 24) {
            const bool isc = u.pm * BM >= MX; const int slot0 = isc ? CTX_SLOT0 + (u.pm - MX / BM) * 8 * 256 : (u.pm >> 4) * 8 * 4096 + (u.pm & 15) * 256, hstride = isc ? 256 : 4096, rr0 = wr * 64 + fr;
            bf16_t* pb[2];
#pragma unroll
            for (int bj = 0; bj < 2; ++bj) {
                if (u.pn < 4) pb[bj] = O + QH_OFF + ((size_t)slot0 + (size_t)(2 * u.pn + bj) * hstride) * 128 + wc * 32 + 8 * fq;
                else if (u.pn < 8) pb[bj] = O + KH_OFF + ((size_t)slot0 + (size_t)(2 * (u.pn - 4) + bj) * hstride) * 128 + wc * 32 + 8 * fq;
                else if (u.pn < 16) pb[bj] = O + VH_OFF + ((size_t)slot0 + (size_t)(u.pn - 8) * hstride) * 256 + bj * HALF + wc * 32 + 8 * fq;
                else pb[bj] = O + OG_OFF + (size_t)(u.pm * BM) * 2048 + (u.pn - 16) * BM + bj * HALF + wc * 32 + 8 * fq; }
            const int rpitch = u.pn < 8 ? 128 : (u.pn < 16 ? 256 : 2048);
#pragma unroll
            for (int ai = 0; ai < 2; ++ai) { float rs4[4];
#pragma unroll
                for (int m = 0; m < 4; ++m) rs4[m] = FOLD ? F.rstd()[u.pm * BM + rr0 + ai * HALF + m * 16] : 1.0f;
#pragma unroll
                for (int m = 0; m < 4; ++m) { const int rr = rr0 + ai * HALF + m * 16; const float rs = rs4[m];
#pragma unroll
                    for (int bj = 0; bj < 2; ++bj) { f32x4 v0 = acc[ai][bj][m][0], v1 = acc[ai][bj][m][1]; if (FOLD) { v0 = v0 * rs + bv[bj][0]; v1 = v1 * rs + bv[bj][1]; }
                        u32x4 w; w.x = cvt_pk_bf16(v0[0], v0[1]); w.y = cvt_pk_bf16(v0[2], v0[3]); w.z = cvt_pk_bf16(v1[0], v1[1]); w.w = cvt_pk_bf16(v1[2], v1[3]);
                        *(u32x4*)(pb[bj] + (size_t)rr * rpitch) = w; } } }
        } else if (wc == 0) {
            float rsv[2][4]; if (FOLD) F.rows8(row0, rsv);
            const f32x4 b0 = *(const f32x4*)(bgate + 8 * fq) + bv[0][0], b1 = *(const f32x4*)(bgate + 8 * fq + 4) + bv[0][1];
#pragma unroll
            for (int ai = 0; ai < 2; ++ai)
#pragma unroll
                for (int m = 0; m < 4; ++m) { const int r = row0 + ai * HALF + m * 16; float* rowp = G + (size_t)r * 32 + 8 * fq; const float rs = FOLD ? rsv[ai][m] : 1.0f;
                    *(f32x4*)rowp = acc[ai][0][m][0] * rs + b0; *(f32x4*)(rowp + 4) = acc[ai][0][m][1] * rs + b1; }
        }
    }
};
template <bool FOLD> struct EpiConvInT {
    static constexpr bool PERM = true, AFTER_DRAIN = false; static constexpr int NSTORE = 8;
    bf16_t* BG; bf16_t* Z; Fold F;
    __device__ __forceinline__ void operator()(const f32x4 (&acc)[2][2][4][2], const Unit& u, int wr, int wc, int fr, int fq) const {
        const int row0 = u.pm * BM + wr * 64 + fr;
        f32x4 bv[2][2];
#pragma unroll
        for (int bj = 0; bj < 2; ++bj)
#pragma unroll
            for (int n = 0; n < 2; ++n) bv[bj][n] = (f32x4){0.f, 0.f, 0.f, 0.f};
        if (FOLD) { const int bidx = (u.pm * BM >= MX) ? 5 : (u.pm >> 4); const float* bp = F.bias(bidx) + u.pn * BM + wc * 32 + 8 * fq;
#pragma unroll
            for (int bj = 0; bj < 2; ++bj)
#pragma unroll
                for (int n = 0; n < 2; ++n) bv[bj][n] = *(const f32x4*)(bp + bj * HALF + 4 * n); }
        float rsv[2][4]; if (FOLD) F.rows8(row0, rsv);
        if (u.pn < 8) {
            const int col0 = u.pn * BM + wc * 32 + 8 * fq;
#pragma unroll
            for (int ai = 0; ai < 2; ++ai)
#pragma unroll
                for (int m = 0; m < 4; ++m) { const int r = row0 + ai * HALF + m * 16; bf16_t* rowp = BG + (size_t)r * 2048 + col0; const float rs = FOLD ? rsv[ai][m] : 1.0f;
#pragma unroll
                    for (int bj = 0; bj < 2; ++bj) { f32x4 v0 = acc[ai][bj][m][0], v1 = acc[ai][bj][m][1]; if (FOLD) { v0 = v0 * rs + bv[bj][0]; v1 = v1 * rs + bv[bj][1]; }
                        u32x4 w; w.x = cvt_pk_bf16(v0[0], v0[1]); w.y = cvt_pk_bf16(v0[2], v0[3]); w.z = cvt_pk_bf16(v1[0], v1[1]); w.w = cvt_pk_bf16(v1[2], v1[3]);
                        *(u32x4*)(rowp + bj * HALF) = w; } }
        } else {
            const int col0 = (u.pn - 8) * HALF + wc * 32 + 8 * fq;
#pragma unroll
            for (int ai = 0; ai < 2; ++ai)
#pragma unroll
                for (int m = 0; m < 4; ++m) { const int r = row0 + ai * HALF + m * 16; bf16_t* rowp = Z + (size_t)r * 2048 + col0; const float rs = FOLD ? rsv[ai][m] : 1.0f;
                    f32x4 c0 = acc[ai][0][m][0], c1 = acc[ai][0][m][1], u0 = acc[ai][1][m][0], u1 = acc[ai][1][m][1];
                    if (FOLD) { c0 = c0 * rs + bv[0][0]; c1 = c1 * rs + bv[0][1]; u0 = u0 * rs + bv[1][0]; u1 = u1 * rs + bv[1][1]; }
                    const f32x4 v0 = c0 * u0, v1 = c1 * u1;
                    u32x4 w; w.x = cvt_pk_bf16(v0[0], v0[1]); w.y = cvt_pk_bf16(v0[2], v0[3]); w.z = cvt_pk_bf16(v1[0], v1[1]); w.w = cvt_pk_bf16(v1[2], v1[3]);
                    *(u32x4*)rowp = w; }
        }
    }
};

template <class Epi, class Sched, bool ALIGN_EPI = false, bool SP2 = false, bool TILED = false>
__device__ __forceinline__ void gemm_phase(PG8_LAS unsigned char* lds, const Gemm g, const Sched& S, const Epi& E) {
    const int tid = threadIdx.x, wid = __builtin_amdgcn_readfirstlane(tid >> 6), lane = tid & 63, wr = wid >> 2, wc = wid & 3, fr = lane & 15, fq = lane >> 4;
    const int K = g.K;
    unsigned voffA[2], voffB[2];
#pragma unroll
    for (int i = 0; i < 2; ++i) { int R, C; stage_rc(tid * 16 + i * 8192, R, C); const int Rb = Epi::PERM ? ((R & ~31) + perm32(R & 31)) : R;
        const int KP = TILED ? BK : K; voffA[i] = (unsigned)(R * KP + C) * 2u; voffB[i] = (unsigned)(Rb * KP + C) * 2u; }
    const size_t kstep = TILED ? (size_t)(BM * BK * 2) : (size_t)(BK * 2);
    const size_t hstep = TILED ? (size_t)(HALF * BK * 2) : (size_t)HALF * K * 2;
    const size_t tstep = TILED ? (size_t)(K / BK) * (BM * BK * 2) : 2 * hstep;
#define PG8_K0OFF(k0) (TILED ? (size_t)((k0) / BK) * (BM * BK * 2) : (size_t)(k0) * 2)
    const unsigned ldsw = (unsigned)wid * 1024u;
    const int aoff = lds_byte(wr * 64 + fr, fq * 8), boff = lds_byte(wc * 32 + fr, fq * 8);
#define PG8_SA(b, h) (((b) * 2 + (h)) * HTB)
#define PG8_SB(b, h) ((4 + (b) * 2 + (h)) * HTB)
#define PG8_STAGE(bufoff, gbase, voff) do { _Pragma("unroll") for (int _i = 0; _i < 2; ++_i) \
        __builtin_amdgcn_global_load_lds((const unsigned*)((const char*)(gbase) + (voff)[_i]), (PG8_LAS unsigned*)(lds + (bufoff) + ldsw + _i * 8192), 16, 0, 0); } while (0)
#define PG8_LDA(dst, b, h) do { _Pragma("unroll") for (int m = 0; m < 4; ++m) _Pragma("unroll") for (int k = 0; k < 2; ++k) dst[m][k] = *(const PG8_LAS bf16x8*)(lds + PG8_SA(b, h) + aoff + m * 2048 + k * 1024); } while (0)
#define PG8_LDB(dst, b, h) do { _Pragma("unroll") for (int n = 0; n < 2; ++n) _Pragma("unroll") for (int k = 0; k < 2; ++k) dst[n][k] = *(const PG8_LAS bf16x8*)(lds + PG8_SB(b, h) + boff + n * 2048 + k * 1024); } while (0)
#define PG8_MMA(ai, bj, At, Bt) do { __builtin_amdgcn_s_setprio(1); _Pragma("unroll") for (int m = 0; m < 4; ++m) _Pragma("unroll") for (int n = 0; n < 2; ++n) _Pragma("unroll") for (int k = 0; k < 2; ++k) \
        acc[ai][bj][m][n] = __builtin_amdgcn_mfma_f32_16x16x32_bf16(Bt[n][k], At[m][k], acc[ai][bj][m][n], 0, 0, 0); __builtin_amdgcn_s_setprio(0); } while (0)
#define PG8_WAIT_V(n) asm volatile("s_waitcnt vmcnt(" #n ")" ::: "memory")
#define PG8_WAIT_L(n) asm volatile("s_waitcnt lgkmcnt(" #n ")" ::: "memory")
#define PG8_WAIT_VR do { if constexpr (Epi::NSTORE == 8) PG8_WAIT_V(16); else if constexpr (Epi::NSTORE == 16) PG8_WAIT_V(24); else if constexpr (Epi::NSTORE == 32) PG8_WAIT_V(40); else PG8_WAIT_V(8); } while (0)
#define PG8_BAR __builtin_amdgcn_s_barrier()
#define PG8_SCHED __builtin_amdgcn_sched_barrier(0)
    Unit cur, nxt; int ui = 0;
    if (!S.next(0, cur)) return;
    f32x4 acc[2][2][4][2];
#pragma unroll
    for (int a = 0; a < 2; ++a)
#pragma unroll
        for (int b = 0; b < 2; ++b)
#pragma unroll
            for (int m = 0; m < 4; ++m)
#pragma unroll
                for (int n = 0; n < 2; ++n) acc[a][b][m][n] = (f32x4){0.f, 0.f, 0.f, 0.f};
    bf16x8 At[4][2], B0[2][2], B1[2][2];
    const char* cA = (const char*)g.A + (size_t)cur.pm * tstep + PG8_K0OFF(cur.k0); const char* cB = (const char*)g.Bt + (size_t)cur.pn * tstep + PG8_K0OFF(cur.k0);
    S.a_ready(cur);
    if constexpr (SP2) {
        PG8_STAGE(PG8_SB(0, 0), cB, voffB); PG8_STAGE(PG8_SB(0, 1), cB + hstep, voffB); PG8_STAGE(PG8_SA(0, 0), cA, voffA); PG8_STAGE(PG8_SA(0, 1), cA + hstep, voffA);
        if (wr == 1) PG8_BAR;
        PG8_WAIT_V(2); PG8_BAR;
        PG8_STAGE(PG8_SB(1, 0), cB + kstep, voffB); PG8_STAGE(PG8_SA(1, 0), cA + kstep, voffA); PG8_STAGE(PG8_SB(1, 1), cB + hstep + kstep, voffB);
        PG8_WAIT_V(6); PG8_BAR;
    } else {
        PG8_STAGE(PG8_SB(0, 0), cB, voffB); PG8_STAGE(PG8_SA(0, 0), cA, voffA); PG8_STAGE(PG8_SB(0, 1), cB + hstep, voffB); PG8_STAGE(PG8_SA(0, 1), cA + hstep, voffA);
        if (wr == 1) PG8_BAR;
        PG8_WAIT_V(4); PG8_BAR;
        PG8_STAGE(PG8_SB(1, 0), cB + kstep, voffB); PG8_STAGE(PG8_SA(1, 0), cA + kstep, voffA); PG8_STAGE(PG8_SB(1, 1), cB + hstep + kstep, voffB);
        PG8_WAIT_V(6); PG8_BAR;
    }
    for (;;) {
        const bool has_next = S.next(ui + 1, nxt);
        const char* nA = has_next ? (const char*)g.A + (size_t)nxt.pm * tstep + PG8_K0OFF(nxt.k0) : cA; const char* nB = has_next ? (const char*)g.Bt + (size_t)nxt.pn * tstep + PG8_K0OFF(nxt.k0) : cB;
        const int nt = cur.nt;
        static_assert(SP2, "this build keeps only the two-super-phase K-loop");
        for (int t = 0; t < nt; t += 2) {
            const bool last = (t == nt - 2);
            const char* a1 = cA + (size_t)(t + 1) * kstep;
            const char* a2 = last ? nA : cA + (size_t)(t + 2) * kstep; const char* b2 = last ? nB : cB + (size_t)(t + 2) * kstep;
            const char* a3 = a2 + kstep; const char* b3 = b2 + kstep;
            if (last && has_next) S.a_ready(nxt);
            const unsigned relax = (unsigned)__builtin_amdgcn_readfirstlane((Epi::NSTORE > 0 && t == 0 && ui > 0) ? 1 : 0);
#define PG8_WAIT_V8R do { if constexpr (Epi::NSTORE == 8) asm volatile("s_cmp_lg_u32 %0, 0\n\ts_cbranch_scc1 .Lpg8r%=\n\ts_waitcnt vmcnt(8)\n.Lpg8r%=:\n\ts_waitcnt vmcnt(16)" :: "s"(relax) : "memory", "scc"); \
        else if constexpr (Epi::NSTORE == 16) asm volatile("s_cmp_lg_u32 %0, 0\n\ts_cbranch_scc1 .Lpg8r%=\n\ts_waitcnt vmcnt(8)\n.Lpg8r%=:\n\ts_waitcnt vmcnt(24)" :: "s"(relax) : "memory", "scc"); \
        else if constexpr (Epi::NSTORE == 32) asm volatile("s_cmp_lg_u32 %0, 0\n\ts_cbranch_scc1 .Lpg8r%=\n\ts_waitcnt vmcnt(8)\n.Lpg8r%=:\n\ts_waitcnt vmcnt(40)" :: "s"(relax) : "memory", "scc"); \
        else PG8_WAIT_V(8); } while (0)
            PG8_LDB(B0, 0, 0); PG8_LDB(B1, 0, 1); PG8_SCHED; PG8_LDA(At, 0, 0); PG8_STAGE(PG8_SA(1, 1), a1 + hstep, voffA);
            PG8_WAIT_V8R; PG8_WAIT_L(0); PG8_BAR; PG8_MMA(0, 0, At, B0); PG8_MMA(0, 1, At, B1); PG8_BAR; PG8_SCHED;
            PG8_LDA(At, 0, 1); PG8_STAGE(PG8_SB(0, 0), b2, voffB); PG8_STAGE(PG8_SB(0, 1), b2 + hstep, voffB); PG8_STAGE(PG8_SA(0, 0), a2, voffA);
            PG8_WAIT_V8R; PG8_WAIT_L(0); PG8_BAR; PG8_MMA(1, 0, At, B0); PG8_MMA(1, 1, At, B1); PG8_BAR; PG8_SCHED;
            PG8_LDB(B0, 1, 0); PG8_LDB(B1, 1, 1); PG8_SCHED; PG8_LDA(At, 1, 0); PG8_STAGE(PG8_SA(0, 1), a2 + hstep, voffA);
            PG8_WAIT_V8R; PG8_WAIT_L(0); PG8_BAR; PG8_MMA(0, 0, At, B0); PG8_MMA(0, 1, At, B1); PG8_BAR; PG8_SCHED;
            PG8_LDA(At, 1, 1); PG8_STAGE(PG8_SB(1, 0), b3, voffB); PG8_STAGE(PG8_SB(1, 1), b3 + hstep, voffB); PG8_STAGE(PG8_SA(1, 0), a3, voffA);
            PG8_WAIT_V(8); PG8_WAIT_L(0); PG8_BAR; PG8_MMA(1, 0, At, B0); PG8_MMA(1, 1, At, B1); PG8_BAR; PG8_SCHED;
#undef PG8_WAIT_V8R
        }
        if constexpr (SP2 && Epi::NSTORE > 0) { if (has_next) { PG8_STAGE(PG8_SA(1, 1), nA + kstep + hstep, voffA); asm volatile("" ::: "memory"); } }
        if constexpr (ALIGN_EPI) { if (wr == 0) PG8_BAR; }
        if constexpr (!Epi::AFTER_DRAIN) { E(acc, cur, wr, wc, fr, fq); S.done(cur); }
        if (!has_next) break;
#pragma unroll
        for (int a = 0; a < 2; ++a)
#pragma unroll
            for (int b = 0; b < 2; ++b)
#pragma unroll
                for (int m = 0; m < 4; ++m)
#pragma unroll
                    for (int n = 0; n < 2; ++n) acc[a][b][m][n] = (f32x4){0.f, 0.f, 0.f, 0.f};
        cur = nxt; cA = nA; cB = nB; ++ui;
        if constexpr (ALIGN_EPI) { if (wr == 1) PG8_BAR; }
    }
    PG8_WAIT_V(0);
    if constexpr (!ALIGN_EPI) { if (wr == 0) PG8_BAR; }
    PG8_BAR;
#undef PG8_K0OFF
#undef PG8_SA
#undef PG8_SB
#undef PG8_STAGE
#undef PG8_LDA
#undef PG8_LDB
#undef PG8_MMA
#undef PG8_WAIT_V
#undef PG8_WAIT_L
#undef PG8_WAIT_VR
#undef PG8_BAR
#undef PG8_SCHED
}
}

constexpr int RING_BYTES = 131072;
constexpr int SCR_BYTES = 8 * 64 * 65 * 4;
constexpr int LDSCTL_OFF = 159744, LDS_BYTES = 163840;

#define GAS __attribute__((address_space(1)))
#define LAS __attribute__((address_space(3)))
typedef unsigned short bf16;
typedef unsigned v4u __attribute__((ext_vector_type(4)));
typedef unsigned v2u __attribute__((ext_vector_type(2)));
typedef float f32x4 __attribute__((ext_vector_type(4)));
typedef short bf16x8 __attribute__((ext_vector_type(8)));
typedef short s16x4 __attribute__((ext_vector_type(4)));
#define LDS_WAIT() asm volatile("s_waitcnt lgkmcnt(0)" ::: "memory")
__device__ __forceinline__ unsigned f2bf(float f) { unsigned u = __builtin_bit_cast(unsigned, f); return (u + 0x7fffu + ((u >> 16) & 1u)) >> 16; }
__device__ __forceinline__ unsigned pk2(float lo, float hi) { return pg8::cvt_pk_bf16(lo, hi); }
__device__ __forceinline__ float bflo(unsigned w) { return __builtin_bit_cast(float, w << 16); }
__device__ __forceinline__ float bfhi(unsigned w) { return __builtin_bit_cast(float, w & 0xffff0000u); }

#define XB_TMO      128
#define XB_XCNT(j)  (256  + 64 * (j))
#define XB_XSUB(j)  (1280 + 64 * (j))
#define XB_XGEN(j)  (2304 + 64 * (j))
#define XB_TOP      3328
#define XB_TOPGEN   3392
#define XCD_BAR_WORDS 3456
#define XB_SPIN_CAP (1u << 18)
__device__ __forceinline__ unsigned xb_ld(unsigned* p)              { return __hip_atomic_load(p, __ATOMIC_RELAXED, __HIP_MEMORY_SCOPE_AGENT); }
__device__ __forceinline__ unsigned xb_add(unsigned* p, unsigned v) { return __hip_atomic_fetch_add(p, v, __ATOMIC_RELAXED, __HIP_MEMORY_SCOPE_AGENT); }
__device__ __forceinline__ unsigned xb_xcc_id() { return (unsigned)__builtin_amdgcn_s_getreg((3 << 11) | 20) & 0xFu; }
#define XB_SPIN(cond, bar) do { unsigned _sp = 0; while (cond) { __builtin_amdgcn_s_sleep(1); \
    if ((++_sp & 255u) == 0u) { if (xb_ld(&(bar)[XB_TMO])) break; if (_sp > XB_SPIN_CAP) { atomicAdd(&(bar)[XB_TMO], 1u); break; } } } } while (0)
struct XcdBarrier { unsigned* bar; unsigned x; volatile LAS unsigned* st; };
__device__ __forceinline__ XcdBarrier xcd_barrier_post(unsigned* bar, volatile LAS unsigned* st) {
    XcdBarrier b; b.bar = bar; b.x = xb_xcc_id(); b.st = st;
    if (threadIdx.x == 0) (void)xb_add(&bar[XB_XCNT(b.x)], 1u);
    return b;
}
__device__ __forceinline__ void xcd_barrier_complete(unsigned* bar, unsigned x, unsigned& nloc, unsigned& nx) {
    const unsigned G = gridDim.x * gridDim.y * gridDim.z;
    unsigned sum, cnt, mine, sp = 0u;
    for (;;) {
        sum = 0u; cnt = 0u; mine = 0u;
#pragma unroll
        for (unsigned j = 0; j < 16; ++j) { const unsigned c = xb_ld(&bar[XB_XCNT(j)]); sum += c; cnt += (c > 0u) ? 1u : 0u; mine = (j == x) ? c : mine; }
        if (sum == G) break;
        __builtin_amdgcn_s_sleep(1);
        if ((++sp & 255u) == 0u) { if (xb_ld(&bar[XB_TMO])) break; if (sp > XB_SPIN_CAP) { atomicAdd(&bar[XB_TMO], 1u); break; } }
    }
    nloc = mine > 0u ? mine : 1u; nx = cnt > 0u ? cnt : 1u;
}
__device__ __forceinline__ void xcd_barrier(const XcdBarrier& b) {
    asm volatile("s_waitcnt vmcnt(0)" ::: "memory");
    __syncthreads();
    if (threadIdx.x == 0) {
        unsigned* bar = b.bar;
        __builtin_amdgcn_s_waitcnt(0);
        unsigned nloc = b.st[0], nx = b.st[1];
        if (nloc == 0u) { xcd_barrier_complete(bar, b.x, nloc, nx); b.st[0] = nloc; b.st[1] = nx; }
        const unsigned old = xb_add(&bar[XB_XSUB(b.x)], 1u);
        const unsigned gen = old / nloc;
        if (old + 1u == (gen + 1u) * nloc) {
            __builtin_amdgcn_fence(__ATOMIC_RELEASE, "agent");
            asm volatile("s_waitcnt vmcnt(0)" ::: "memory");
            const unsigned og = xb_add(&bar[XB_TOP], 1u);
            const unsigned tg = og / nx;
            if (og + 1u == (tg + 1u) * nx) xb_add(&bar[XB_TOPGEN], 1u);
            else XB_SPIN(xb_ld(&bar[XB_TOPGEN]) == tg, bar);
            __builtin_amdgcn_fence(__ATOMIC_ACQUIRE, "agent");
            xb_add(&bar[XB_XGEN(b.x)], 1u);
            asm volatile("s_waitcnt vmcnt(0)" ::: "memory");
        } else {
            XB_SPIN(xb_ld(&bar[XB_XGEN(b.x)]) == gen, bar);
            __builtin_amdgcn_fence(__ATOMIC_ACQUIRE, "agent");
            asm volatile("s_waitcnt vmcnt(0)" ::: "memory");
        }
    }
    __syncthreads();
}

__device__ __forceinline__ float wave_sum(float v) {
#pragma unroll
    for (int o = 1; o < 64; o <<= 1) v += __shfl_xor(v, o);
    return v;
}
template <int MAPK> __device__ __forceinline__ int wmap(int n) {
    if (MAPK == 1) { const int pn = n >> 8, r = n & 255; return ((r < 128) ? 0 : DFF) + 128 * pn + (r & 127); }
    if (MAPK == 2) { return n < 4096 ? n : (n < 6144 ? n + 32 : (n < 6176 ? n - 2048 : -1)); }
    if (MAPK == 3) { if (n < 2048) return n; const int q = n - 2048, pn = q >> 8, r = q & 255; return ((r < 128) ? 2048 : 4096) + 128 * pn + (r & 127); }
    return n;
}
template <int MAPK, bool BIAS = false> __device__ __forceinline__ void transpose_item(const float* W, int K, int Nsrc, bf16* WT, int nblk, LAS float* scr, int item, int lane, const float* shift = nullptr, float* biasp = nullptr) {
    const int kb = item / nblk, nb = item - kb * nblk, k0 = 64 * kb, n0 = 64 * nb;
    const int n = n0 + lane, sc = wmap<MAPK>(n);
    const float scale = (MAPK == 2 && n < 1024) ? 0.08838834764831845f : 1.0f;
    const float* src = W + (size_t)k0 * Nsrc + (sc >= 0 ? sc : 0);
#pragma unroll
    for (int hb = 0; hb < 2; ++hb) { float v[32];
#pragma unroll
        for (int i = 0; i < 32; ++i) v[i] = src[(size_t)(32 * hb + i) * Nsrc];
#pragma unroll
        for (int i = 0; i < 32; ++i) scr[(32 * hb + i) * 65 + lane] = (sc >= 0) ? v[i] * scale : 0.f; }
    LDS_WAIT(); asm volatile("" ::: "memory");
    if (BIAS) {
        const int fn = lane & 15, fk = lane >> 4;
        bf16x8 Af[2];
#pragma unroll
        for (int ks = 0; ks < 2; ++ks) { f32x4 s0 = (f32x4){0.f, 0.f, 0.f, 0.f}, s1 = s0; if (fn < 5) { const float* sp = shift + (size_t)fn * MODW + k0 + 32 * ks + 8 * fk; s0 = *(const f32x4*)sp; s1 = *(const f32x4*)(sp + 4); }
            const v4u w = (v4u){pk2(s0[0], s0[1]), pk2(s0[2], s0[3]), pk2(s1[0], s1[1]), pk2(s1[2], s1[3])}; Af[ks] = __builtin_bit_cast(bf16x8, w); }
#pragma unroll
        for (int nt = 0; nt < 4; ++nt) { f32x4 bacc = (f32x4){0.f, 0.f, 0.f, 0.f};
#pragma unroll
            for (int ks = 0; ks < 2; ++ks) { const LAS float* sp = scr + (32 * ks + 8 * fk) * 65 + 16 * nt + fn;
                const v4u o = (v4u){pk2(sp[0 * 65], sp[1 * 65]), pk2(sp[2 * 65], sp[3 * 65]), pk2(sp[4 * 65], sp[5 * 65]), pk2(sp[6 * 65], sp[7 * 65])};
                *(GAS v4u*)(WT + (size_t)(n0 + 16 * nt + fn) * K + k0 + 32 * ks + 8 * fk) = o;
                bacc = __builtin_amdgcn_mfma_f32_16x16x32_bf16(Af[ks], __builtin_bit_cast(bf16x8, o), bacc, 0, 0, 0); }
            float* bo = biasp + (size_t)kb * 5 * NBCOL + n0 + 16 * nt + fn;
            if (fk == 0) { bo[0] = bacc[0]; bo[NBCOL] = bacc[1]; bo[2 * (size_t)NBCOL] = bacc[2]; bo[3 * (size_t)NBCOL] = bacc[3]; } else if (fk == 1) bo[4 * (size_t)NBCOL] = bacc[0]; }
    } else {
    const int c = lane & 7;
#pragma unroll
    for (int j = 0; j < 8; ++j) { const int nn = (lane >> 3) + 8 * j; const LAS float* s = scr + (8 * c) * 65 + nn;
        v4u o; o.x = pk2(s[0 * 65], s[1 * 65]); o.y = pk2(s[2 * 65], s[3 * 65]); o.z = pk2(s[4 * 65], s[5 * 65]); o.w = pk2(s[6 * 65], s[7 * 65]);
        *(GAS v4u*)(WT + (size_t)(n0 + nn) * K + k0 + 8 * c) = o; }
    }
    LDS_WAIT(); asm volatile("" ::: "memory");
}

constexpr int TI2_STR = 272, TI2_BYTES = 64 * TI2_STR;
__device__ __forceinline__ bf16x8 tr_frag_g(LAS unsigned char* p0, LAS unsigned char* p1) {
    const s16x4 a = __builtin_amdgcn_ds_read_tr16_b64_v4i16((LAS s16x4*)p0), b = __builtin_amdgcn_ds_read_tr16_b64_v4i16((LAS s16x4*)p1);
    return (bf16x8){a[0], a[1], a[2], a[3], b[0], b[1], b[2], b[3]};
}
template <int MAPK, bool BIAS, bool TILEDW = false> __device__ __forceinline__ void transpose_item2(const float* W, int K, int Nsrc, bf16* WT, int nblk, LAS unsigned char* tile, int item, int lane, const float* shift = nullptr, float* biasp = nullptr) {
    typedef float f32x2v __attribute__((ext_vector_type(2)));
    const int kb = item / nblk, nb = item - kb * nblk, k0 = 64 * kb, n0 = 128 * nb;
    const int n = n0 + 2 * lane, sc = wmap<MAPK>(n);
    const float scale = (MAPK == 2 && n < 1024) ? 0.08838834764831845f : 1.0f;
    const float* src = W + (size_t)k0 * Nsrc + (sc >= 0 ? sc : 0);
#pragma unroll
    for (int hb = 0; hb < 2; ++hb) { f32x2v v[32];
#pragma unroll
        for (int i = 0; i < 32; ++i) v[i] = __builtin_nontemporal_load((const f32x2v*)(src + (size_t)(32 * hb + i) * Nsrc));
#pragma unroll
        for (int i = 0; i < 32; ++i) *(LAS unsigned*)(tile + (32 * hb + i) * TI2_STR + 4 * lane) = (sc >= 0) ? pk2(v[i][0] * scale, v[i][1] * scale) : 0u; }
    LDS_WAIT(); asm volatile("" ::: "memory");
    const int fn = lane & 15, fk = lane >> 4, tq = (lane & 15) >> 2, tp = lane & 3;
    bf16x8 Af[2];
    if (BIAS) {
#pragma unroll
        for (int ks = 0; ks < 2; ++ks) { f32x4 s0 = (f32x4){0.f, 0.f, 0.f, 0.f}, s1 = s0; if (fn < 5) { const float* sp = shift + (size_t)fn * MODW + k0 + 32 * ks + 8 * fk; s0 = *(const f32x4*)sp; s1 = *(const f32x4*)(sp + 4); }
            const v4u w = (v4u){pk2(s0[0], s0[1]), pk2(s0[2], s0[3]), pk2(s1[0], s1[1]), pk2(s1[2], s1[3])}; Af[ks] = __builtin_bit_cast(bf16x8, w); } }
#pragma unroll
    for (int nt = 0; nt < 8; ++nt) { f32x4 bacc = (f32x4){0.f, 0.f, 0.f, 0.f};
#pragma unroll
        for (int ks = 0; ks < 2; ++ks) { LAS unsigned char* p = tile + (32 * ks + 8 * fk + tq) * TI2_STR + (16 * nt + 4 * tp) * 2; const bf16x8 fr = tr_frag_g(p, p + 4 * TI2_STR);
            { const int nn = n0 + 16 * nt + fn; const size_t doff = TILEDW ? ((((size_t)(nn >> 8) * (K / 64) + kb) * 256 + (nn & 255)) * 64 + 32 * ks + 8 * fk) : ((size_t)nn * K + k0 + 32 * ks + 8 * fk);
              *(GAS bf16x8*)(WT + doff) = fr; }
            if (BIAS) bacc = __builtin_amdgcn_mfma_f32_16x16x32_bf16(Af[ks], fr, bacc, 0, 0, 0); }
        if (BIAS) { float* bo = biasp + (size_t)kb * 5 * NBCOL + n0 + 16 * nt + fn;
            if (fk == 0) { bo[0] = bacc[0]; bo[NBCOL] = bacc[1]; bo[2 * (size_t)NBCOL] = bacc[2]; bo[3 * (size_t)NBCOL] = bacc[3]; } else if (fk == 1) bo[4 * (size_t)NBCOL] = bacc[0]; } }
    LDS_WAIT(); asm volatile("" ::: "memory");
}

struct KArgs { const float* in[17]; float* out; unsigned char* ws; int ph_lo, ph_hi; };

__device__ __forceinline__ void normmod_phase(const float* xx, const float* xc, int rows, const float* ng, const float* modl, int j, bf16* HB, int gw, int NGW, int lane, const float* ctxP = nullptr, const float* cgate = nullptr, int first_row = 0) {
    for (int r = first_row + gw; r < rows; r += NGW) {
        const bool isc = r >= MX; const int b = isc ? 4 : (r >> 12);
        const float* src = isc ? xc + (size_t)(r - MX) * D : xx + (size_t)r * D;
        const float* shift = modl + (size_t)b * MODW + (3 * j) * D; const float* scale = shift + D;
        f32x4 v[8]; float ss = 0.f;
#pragma unroll
        for (int q = 0; q < 8; ++q) v[q] = __builtin_nontemporal_load((const f32x4*)(src + 4 * (lane + 64 * q)));
        if (ctxP && isc) {
#pragma unroll
            for (int q0 = 0; q0 < 8; q0 += 4) { f32x4 pp[4][8];
#pragma unroll
                for (int j = 0; j < 4; ++j)
#pragma unroll
                    for (int sl = 0; sl < 8; ++sl) pp[j][sl] = *(const f32x4*)(ctxP + ((size_t)sl * MC + (r - MX)) * D + 4 * (lane + 64 * (q0 + j)));
#pragma unroll
                for (int j = 0; j < 4; ++j) { const int c = 4 * (lane + 64 * (q0 + j)); f32x4 p = pp[j][0];
#pragma unroll
                    for (int sl = 1; sl < 8; ++sl) p += pp[j][sl];
                    v[q0 + j] += p * (*(const f32x4*)(cgate + c)) * 0.5f; } } }
#pragma unroll
        for (int q = 0; q < 8; ++q) ss += (v[q][0] * v[q][0] + v[q][1] * v[q][1]) + (v[q][2] * v[q][2] + v[q][3] * v[q][3]);
        const float rstd = 1.0f / sqrtf(wave_sum(ss) * (1.0f / D) + RMS_EPS);
#pragma unroll
        for (int q = 0; q < 8; ++q) { const int c = 4 * (lane + 64 * q);
            const f32x4 g4 = *(const f32x4*)(ng + c), s4 = *(const f32x4*)(scale + c), h4 = *(const f32x4*)(shift + c);
            const f32x4 y = v[q] * rstd * g4 * (s4 + 1.0f) + h4;
            v2u o; o.x = pk2(y[0], y[1]); o.y = pk2(y[2], y[3]); *(v2u*)(HB + hb_off(r, c)) = o; }
    }
}
__device__ __forceinline__ void final_norm_phase(const bf16* XS, const float* SS, float* out, int gw, int NGW, int lane) {
    for (int r = gw; r < MX; r += NGW) {
        float t = lane < 32 ? SS[(size_t)r * 32 + lane] : 0.f;
        t = wave_sum(t);
        const float rstd = 1.0f / sqrtf(t * (1.0f / D) + RMS_EPS);
        float* orow = out + (size_t)r * D;
#pragma unroll
        for (int q = 0; q < 4; ++q) { const int c = 8 * (lane + 64 * q); const v4u w = __builtin_nontemporal_load((const v4u*)(XS + hb_off(r, c)));
            __builtin_nontemporal_store((f32x4){bflo(w.x), bfhi(w.x), bflo(w.y), bfhi(w.y)} * rstd, (f32x4*)(orow + c)); __builtin_nontemporal_store((f32x4){bflo(w.z), bfhi(w.z), bflo(w.w), bfhi(w.w)} * rstd, (f32x4*)(orow + c + 4)); }
    }
}
__device__ __forceinline__ void unpack8(const v4u w, float (&f)[8]) { f[0] = bflo(w.x); f[1] = bfhi(w.x); f[2] = bflo(w.y); f[3] = bfhi(w.y); f[4] = bflo(w.z); f[5] = bfhi(w.z); f[6] = bflo(w.w); f[7] = bfhi(w.w); }
__device__ __forceinline__ void headnorm_phase(const bf16* HF, const bf16* HBW, const bf16* QKVO, const float* ng, bf16* Y, int gw, int NGW, int lane) {
    for (int r = gw; r < MX; r += NGW) {
#pragma unroll
        for (int q = 0; q < 4; ++q) { const int c = 8 * (lane + 64 * q);
            const v4u a = __builtin_nontemporal_load((const v4u*)(HF + (size_t)r * D + c)), b = __builtin_nontemporal_load((const v4u*)(HBW + (size_t)r * D + c)), o = __builtin_nontemporal_load((const v4u*)(QKVO + OG_OFF + (size_t)r * 2048 + c));
            float fa[8], fb[8], fo[8]; unpack8(a, fa); unpack8(b, fb); unpack8(o, fo);
            float s[8], ss = 0.f;
#pragma unroll
            for (int i = 0; i < 8; ++i) { s[i] = fa[i] + fb[i]; ss += s[i] * s[i]; }
#pragma unroll
            for (int of = 1; of < 32; of <<= 1) ss += __shfl_xor(ss, of);
            const float rstd = 1.0f / sqrtf(ss * (1.0f / DVH) + RMS_EPS);
            const f32x4 g0 = *(const f32x4*)(ng + c), g1 = *(const f32x4*)(ng + c + 4);
            float y[8];
#pragma unroll
            for (int i = 0; i < 8; ++i) { const float g = i < 4 ? g0[i] : g1[i - 4]; y[i] = s[i] * rstd * g * __builtin_amdgcn_rcpf(1.0f + __builtin_amdgcn_exp2f(-1.44269504f * fo[i])); }
            v4u w; w.x = pk2(y[0], y[1]); w.y = pk2(y[2], y[3]); w.z = pk2(y[4], y[5]); w.w = pk2(y[6], y[7]);
            *(v4u*)(Y + hb_off(r, c)) = w; }
    }
}
__device__ __forceinline__ void convmix_phase(const bf16* BG, const bf16* Z, const float* cw, bf16* Y, int gw, int NGW, int lane) {
    for (int r = gw; r < MX; r += NGW) { const int t = r & 63;
#pragma unroll
        for (int q = 0; q < 4; ++q) { const int c = 8 * (lane + 64 * q);
            const v4u zero = (v4u){0u, 0u, 0u, 0u};
            const v4u zc = *(const v4u*)(Z + (size_t)r * D + c), zp = t > 0 ? *(const v4u*)(Z + (size_t)(r - 1) * D + c) : zero, zn = t < 63 ? *(const v4u*)(Z + (size_t)(r + 1) * D + c) : zero;
            const v4u bg = __builtin_nontemporal_load((const v4u*)(BG + (size_t)r * D + c));
            float fc[8], fp[8], fn[8], fb[8]; unpack8(zc, fc); unpack8(zp, fp); unpack8(zn, fn); unpack8(bg, fb);
            float y[8];
#pragma unroll
            for (int h = 0; h < 2; ++h) { const f32x4 w0 = *(const f32x4*)(cw + c + 4 * h), w1 = *(const f32x4*)(cw + D + c + 4 * h), w2 = *(const f32x4*)(cw + 2 * D + c + 4 * h);
#pragma unroll
                for (int i = 0; i < 4; ++i) y[4 * h + i] = fb[4 * h + i] * (w0[i] * fp[4 * h + i] + w1[i] * fc[4 * h + i] + w2[i] * fn[4 * h + i]); }
            v4u w; w.x = pk2(y[0], y[1]); w.y = pk2(y[2], y[3]); w.z = pk2(y[4], y[5]); w.w = pk2(y[6], y[7]);
            *(v4u*)(Y + hb_off(r, c)) = w; }
    }
}

__device__ __forceinline__ void mod_partials(const KArgs& a, int l, int wv, int nwv, int lane) {
    float* modp = (float*)(a.ws + WS_MODP);
    constexpr int NCG = MODW / 256, NKS = D / 64, NIT = NCG * NKS;
    for (int it = wv; it < NIT; it += nwv) {
        const int cg = it / NKS, ks = it - cg * NKS, k0 = 64 * ks, col = 256 * cg + 4 * lane;
        float sv[5];
#pragma unroll
        for (int b = 0; b < 5; ++b) { const float cv = (b < 4) ? a.in[1][b * D + k0 + lane] : a.in[3][k0 + lane]; sv[b] = pg8::silu_f(cv); }
        f32x4 acc[5];
#pragma unroll
        for (int b = 0; b < 5; ++b) acc[b] = (f32x4){0.f, 0.f, 0.f, 0.f};
        const float* wp = a.in[4] + ((size_t)l * D + k0) * MODW + col;
#pragma unroll 8
        for (int k = 0; k < 64; ++k) { const f32x4 w = __builtin_nontemporal_load((const f32x4*)(wp + (size_t)k * MODW));
#pragma unroll
            for (int b = 0; b < 5; ++b) { const float s = __builtin_bit_cast(float, __builtin_amdgcn_readlane(__builtin_bit_cast(int, sv[b]), k)); acc[b] += w * s; } }
#pragma unroll
        for (int b = 0; b < 5; ++b) *(f32x4*)(modp + (((size_t)ks * 2 + l) * 5 + b) * MODW + col) = acc[b];
    }
}
template <int LIST> __device__ __forceinline__ void convert_list(const KArgs& a, LAS unsigned char* lds, int wv, int nwv, int wave, int lane) {
    unsigned char* ws = a.ws;
    LAS unsigned char* scr = lds + wave * TI2_BYTES;
    const float* mod = (const float*)(ws + WS_MOD); float* bp = (float*)(ws + WS_BIASP);
    constexpr int I_FI = (D / 64) * (NFI / 128), I_FO = (DFF / 64) * (D / 128), I_MI = (D / 64) * (NML / 128), I_SQ = (D / 64) * (D / 128), I_CI = (D / 64) * (NCV / 128);
    if (LIST == 0) {
        for (int it = wv; it < I_FI + I_FO; it += nwv) { int r = it;
            if (r < I_FI) { transpose_item2<1, false, true>(a.in[7], D, NFI, (bf16*)(ws + WS_WFI), NFI / 128, scr, r, lane); continue; } r -= I_FI;
            transpose_item2<0, false, true>(a.in[8], DFF, D, (bf16*)(ws + WS_WFO), D / 128, scr, r, lane); }
    } else if (LIST == 1) {
        for (int it = wv; it < I_MI + I_SQ; it += nwv) { int r = it;
            if (r < I_MI) { transpose_item2<2, true, true>(a.in[9], D, NMLSRC, (bf16*)(ws + WS_WMI), NML / 128, scr, r, lane, mod + 3 * D, bp + BOFF_MI); continue; } r -= I_MI;
            transpose_item2<0, false, true>(a.in[12], D, D, (bf16*)(ws + WS_WMO), D / 128, scr, r, lane); }
    } else {
        for (int it = wv; it < 3 * I_FI + 3 * I_FO + I_CI + I_SQ; it += nwv) { int r = it;
            if (r < 3 * I_FI) { const int mi = 1 + r / I_FI; r -= (mi - 1) * I_FI;
                const float* sh = mi == 1 ? mod + 6 * D : (mi == 2 ? mod + (size_t)5 * MODW : mod + (size_t)5 * MODW + 6 * D); float* bq = bp + (mi == 1 ? BOFF_F1 : (mi == 2 ? BOFF_F2 : BOFF_F3));
                transpose_item2<1, true, true>(a.in[7] + (size_t)mi * D * NFI, D, NFI, (bf16*)(ws + WS_WFI) + (size_t)mi * NFI * D, NFI / 128, scr, r, lane, sh, bq); continue; } r -= 3 * I_FI;
            if (r < 3 * I_FO) { const int mi = 1 + r / I_FO; r -= (mi - 1) * I_FO; transpose_item2<0, false, true>(a.in[8] + (size_t)mi * DFF * D, DFF, D, (bf16*)(ws + WS_WFO) + (size_t)mi * D * DFF, D / 128, scr, r, lane); continue; } r -= 3 * I_FO;
            if (r < I_CI) { transpose_item2<3, true, true>(a.in[13], D, NCV, (bf16*)(ws + WS_WCI), NCV / 128, scr, r, lane, mod + (size_t)5 * MODW + 3 * D, bp + BOFF_CI); continue; } r -= I_CI;
            transpose_item2<0, false, true>(a.in[15], D, D, (bf16*)(ws + WS_WCO), D / 128, scr, r, lane); }
    }
}
__device__ __forceinline__ bool tail_rank(int nwg, int G, int bx, int& rank, int& cnt) { const int rem = nwg % G; if (rem == 0) { rank = bx; cnt = G; return true; } rank = bx - rem; cnt = G - rem; return bx >= rem; }

__device__ __forceinline__ void modreduce_phase(const float* modp, const float* bmod, const float* normg, const float* fng, float* mod, float* gs, float* rgs, int gtid, int NGT) {
    constexpr int NV = 5 * MODW / 4;
    for (int i2 = gtid; i2 < 2 * NV; i2 += NGT) { const int l = i2 / NV, i = i2 - l * NV, b = i / (MODW / 4), c4 = i - b * (MODW / 4), lb = l * 5 + b;
        f32x4 pv[D / 64];
#pragma unroll
        for (int ks = 0; ks < D / 64; ++ks) pv[ks] = *(const f32x4*)(modp + ((size_t)ks * 10 + lb) * MODW + 4 * c4);
        f32x4 s = *(const f32x4*)(bmod + (size_t)l * MODW + 4 * c4);
#pragma unroll
        for (int ks = 0; ks < D / 64; ++ks) s += pv[ks];
        *(f32x4*)(mod + (size_t)lb * MODW + 4 * c4) = s;
        if (l == 1 && c4 < D / 4) *(f32x4*)(gs + ((size_t)6 * 5 + b) * D + 4 * c4) = *(const f32x4*)(fng + 4 * c4);
        const int seg = (4 * c4) / D, col = 4 * c4 - seg * D;
        if (seg % 3 == 1) { const int j = seg / 3; const f32x4 gv = *(const f32x4*)(normg + (size_t)(l * 3 + j) * D + col) * (s + 1.0f); const size_t o = ((size_t)(l * 3 + j) * 5 + b) * D + col;
            *(f32x4*)(gs + o) = gv; *(f32x4*)(rgs + o) = (f32x4){gv[0] != 0.f ? 1.0f / gv[0] : 0.f, gv[1] != 0.f ? 1.0f / gv[1] : 0.f, gv[2] != 0.f ? 1.0f / gv[2] : 0.f, gv[3] != 0.f ? 1.0f / gv[3] : 0.f}; } }
}
__device__ __forceinline__ void rowstat_phase(const float* SS, float* rstd, bool ctx_ones, int gtid, int NGT) {
    for (int r = gtid; r < MX; r += NGT) { float t = 0.f;
#pragma unroll
        for (int q = 0; q < 8; ++q) { const f32x4 v = *(const f32x4*)(SS + (size_t)r * 32 + 4 * q); t += (v[0] + v[1]) + (v[2] + v[3]); }
        rstd[r] = 1.0f / sqrtf(t * (1.0f / D) + RMS_EPS); }
    if (ctx_ones) for (int r = MX + gtid; r < MT; r += NGT) rstd[r] = 1.0f;
}
__device__ __forceinline__ void panel_rstd(const pg8::StaticOrder& S, const float* SS, float* rstd, int tid) {
    pg8::Unit u; int last = -1;
    for (int i = 0; S.next(i, u); ++i) { if (u.pm == last) continue; last = u.pm;
        if (tid < 256) { const int r = u.pm * 256 + tid; float t = 0.f;
#pragma unroll
            for (int q = 0; q < 8; ++q) { const f32x4 v = *(const f32x4*)(SS + (size_t)r * 32 + 4 * q); t += (v[0] + v[1]) + (v[2] + v[3]); }
            rstd[r] = 1.0f / sqrtf(t * (1.0f / D) + RMS_EPS); } }
    asm volatile("s_waitcnt vmcnt(0)" ::: "memory"); __syncthreads();
}
__device__ __forceinline__ void biasreduce_phase(const float* biasp, float* bias, int gtid, int NGT) {
    constexpr int NV = NBCOL / 4;
    for (int i = gtid; i < 6 * NV; i += NGT) { const int b = i / NV, c4 = i - b * NV; f32x4 s = (f32x4){0.f, 0.f, 0.f, 0.f};
        if (b < 5) for (int kb = 0; kb < D / 64; ++kb) s += *(const f32x4*)(biasp + ((size_t)kb * 5 + b) * NBCOL + 4 * c4);
        *(f32x4*)(bias + (size_t)b * NBCOL + 4 * c4) = s; }
}

constexpr int SQ_OFF = 0, SK_OFF = 18432, SKW_OFF = 36864, SV_OFF = 54272, SCB_OFF = 65536, SP_OFF = 87296, STAB_OFF = 96512, SCH_OFF = 148736, SHS_OFF = 149824;
constexpr int QSTR = 272, QKSTR = 288, VSTR = 176, PSTR = 144, CBSZ = 21760, NTOK = 68 * 64;
static_assert(SCH_OFF + 4 * 68 * 4 <= SHS_OFF && SHS_OFF + 64 * 144 <= LDSCTL_OFF, "scan LDS");

#define SCAN_BAR() do { asm volatile("s_waitcnt lgkmcnt(0)" ::: "memory"); __builtin_amdgcn_s_barrier(); asm volatile("" ::: "memory"); } while (0)
__device__ __forceinline__ bf16x8 tr_frag(LAS unsigned char* p0, LAS unsigned char* p1) {
    const s16x4 a = __builtin_amdgcn_ds_read_tr16_b64_v4i16((LAS s16x4*)p0), b = __builtin_amdgcn_ds_read_tr16_b64_v4i16((LAS s16x4*)p1);
    return (bf16x8){a[0], a[1], a[2], a[3], b[0], b[1], b[2], b[3]};
}
__device__ __forceinline__ float fexp(float x) { return __builtin_amdgcn_exp2f(1.44269504f * x); }

template <int PROBE> __device__ __forceinline__ void scan_phase(LAS unsigned char* lds, const bf16* QKVO, const float* GATES, bf16* HF, bf16* HBW, int vcu, int G, int tid, int lane, int wave) {
    const int fr = lane & 15, fq = lane >> 4, tq = (lane & 15) >> 2, tp = lane & 3;
    LAS float* cjA = (LAS float*)(lds + STAB_OFF); LAS float* cmA = cjA + NTOK; LAS float* bsA = cmA + NTOK;
    LAS float* chM = (LAS float*)(lds + SCH_OFF); LAS float* chML = chM + 68; LAS float* chBE = chML + 68; LAS float* chMC = chBE + 68;
    for (int u = vcu; u < 256; u += G) {
        const int sl = u & 3, dir = (u >> 2) & 1, h = (u >> 3) & 7, b = u >> 6, e0 = 64 * sl;
        bf16* HO = dir ? HBW : HF;
        const int prow = tid >> 4, pch = tid & 15, vrow = tid >> 3, vch = tid & 7;
        auto row_of = [&](int st) { const bool isc = st < 4; const int ci = isc ? st : st - 4, n = isc ? 4 : 64, ch = dir ? (n - 1 - ci) : ci; return (isc ? MX + b * CTXL : b * SEQ) + ch * 64; };
        f32x4 Cacc[5];
#pragma unroll
        for (int e = 0; e < 5; ++e) Cacc[e] = (f32x4){0.f, 0.f, 0.f, 0.f};
        SCAN_BAR();
        {
            float gi[9], gf[9];
#pragma unroll
            for (int q = 0; q < 9; ++q) { const int st = wave + NWAVES * q; if (st < 68) { const float* gp = GATES + (size_t)(row_of(st) + lane) * 32 + (2 * dir) * 8 + h; gi[q] = gp[0]; gf[q] = gp[8]; } else { gi[q] = 0.f; gf[q] = 0.f; } }
#pragma unroll
            for (int q = 0; q < 9; ++q) { const int st = wave + NWAVES * q; if (st < 68) {
                const float ax = fabsf(gf[q]), ee = fexp(-ax), l1p = (ee < 1e-3f) ? ee * (1.0f - 0.5f * ee) : __logf(1.0f + ee);
                const float f = fminf(gf[q], 0.f) - l1p;
                float bs = f;
#pragma unroll
                for (int o = 1; o < 64; o <<= 1) { const float t = dir ? __shfl_down(bs, o) : __shfl_up(bs, o); const bool ok = dir ? (lane + o < 64) : (lane >= o); bs += ok ? t : 0.f; }
                const float cj = gi[q] - bs; float cm = cj;
#pragma unroll
                for (int o = 1; o < 64; o <<= 1) { const float t = dir ? __shfl_down(cm, o) : __shfl_up(cm, o); const bool ok = dir ? (lane + o < 64) : (lane >= o); cm = ok ? fmaxf(cm, t) : cm; }
                cjA[st * 64 + lane] = cj; cmA[st * 64 + lane] = cm; bsA[st * 64 + lane] = bs;
                if (lane == (dir ? 0 : 63)) { chBE[st] = bs; chMC[st] = cm; } } }
        }
        for (int i = tid; i < CBSZ / 16; i += 512) *(LAS v4u*)(lds + SCB_OFF + 16 * i) = (v4u){0u, 0u, 0u, 0u};
        if (tid < 128) { const int r = tid >> 1; *(LAS v4u*)(lds + SV_OFF + r * VSTR + (8 + (tid & 1)) * 16) = (tid & 1) ? (v4u){0u, 0u, 0u, 0u} : (v4u){0x3F80u, 0u, 0u, 0u}; }
        v4u rq[2][2], rk[2][2], rv[2];
        auto slot_of = [&](int st) { const bool isc = st < 4; const int ci = isc ? st : st - 4, n = isc ? 4 : 64, ch = dir ? (n - 1 - ci) : ci; return (isc ? CTX_SLOT0 + (b * 8 + h) * CTXL : (b * 8 + h) * SEQ) + ch * 64; };
        auto load_qk = [&](int st_, v4u (&q)[2], v4u (&k)[2]) { { const int st = st_ < 68 ? st_ : 67; const size_t e0q = (size_t)slot_of(st) * DKH;
#pragma unroll
            for (int i = 0; i < 2; ++i) { q[i] = *(const v4u*)(QKVO + QH_OFF + e0q + (size_t)(tid + 512 * i) * 8); k[i] = *(const v4u*)(QKVO + KH_OFF + e0q + (size_t)(tid + 512 * i) * 8); } } };
        auto load_v = [&](int st_, v4u& v) { const int st = st_ < 68 ? st_ : 67; v = __builtin_nontemporal_load((const v4u*)(QKVO + VH_OFF + ((size_t)slot_of(st) + vrow) * DVH + e0 + vch * 8)); };
        { v4u q0[2], k0[2];
          load_qk(0, q0, k0); load_qk(1, rq[1], rk[1]); load_qk(2, rq[0], rk[0]);
          load_v(0, rv[0]); load_v(1, rv[1]);
#pragma unroll
          for (int i = 0; i < 2; ++i) { *(LAS v4u*)(lds + SQ_OFF + (prow + 32 * i) * QKSTR + pch * 16) = q0[i]; *(LAS v4u*)(lds + SK_OFF + (prow + 32 * i) * QKSTR + pch * 16) = k0[i]; } }
        SCAN_BAR();
        if (wave == 0) {
            int ln = lane; asm volatile("" : "+v"(ln));
            const float mc0 = chMC[ln], be0 = chBE[ln], mc1 = chMC[64 + (ln & 3)], be1 = chBE[64 + (ln & 3)];
            float m = -1e30f;
#pragma unroll 1
            for (int st = 0; st < 64; ++st) {
                const float c = __builtin_bit_cast(float, __builtin_amdgcn_readlane(__builtin_bit_cast(int, mc0), st)), e = __builtin_bit_cast(float, __builtin_amdgcn_readlane(__builtin_bit_cast(int, be0), st));
                const float ML = fmaxf(m, c); if (ln == st) { chM[st] = m; chML[st] = ML; } m = e + ML; }
#pragma unroll 1
            for (int st = 0; st < 4; ++st) {
                const float c = __builtin_bit_cast(float, __builtin_amdgcn_readlane(__builtin_bit_cast(int, mc1), st)), e = __builtin_bit_cast(float, __builtin_amdgcn_readlane(__builtin_bit_cast(int, be1), st));
                const float ML = fmaxf(m, c); if (ln == st) { chM[64 + st] = m; chML[64 + st] = ML; } m = e + ML; } }
        SCAN_BAR();
        const int sb = wave & 3, hf = wave >> 2, s_pos = 16 * sb + fr, cbh = ((fr >> 2) ^ (fr >> 3)) & 1;
        auto step = [&](const int st, const bool isc, v4u (&RQ)[2], v4u (&RK)[2], v4u& RV) {
            const float m_t = chM[st], ML_t = chML[st];
            if (!isc) { const v4u hw = *(const LAS v4u*)(lds + SHS_OFF + (tid >> 3) * PSTR + (tid & 7) * 16); *(v4u*)(HO + (size_t)(row_of(st > 4 ? st - 1 : st) + (tid >> 3)) * D + h * DVH + e0 + (tid & 7) * 8) = hw; }
            bf16x8 Yq[4], Xk[2][4]; f32x4 c4[2]; float cms = 0.f;
            if (!isc) {
#pragma unroll
                for (int ks = 0; ks < 4; ++ks) Yq[ks] = *(const LAS bf16x8*)(lds + SQ_OFF + s_pos * QKSTR + (32 * ks + 8 * fq) * 2);
#pragma unroll
                for (int jj = 0; jj < 2; ++jj)
#pragma unroll
                    for (int ks = 0; ks < 4; ++ks) Xk[jj][ks] = *(const LAS bf16x8*)(lds + SK_OFF + (16 * (2 * hf + jj) + fr) * QKSTR + (32 * ks + 8 * fq) * 2);
#pragma unroll
                for (int jj = 0; jj < 2; ++jj) c4[jj] = *(const LAS f32x4*)(cjA + st * 64 + 16 * (2 * hf + jj) + 4 * fq);
                cms = cmA[st * 64 + s_pos];
            }
            __builtin_amdgcn_sched_barrier(0);
            auto kwblock = [&]() {
                v4u kraw[2]; float cjw[2];
#pragma unroll
                for (int i = 0; i < 2; ++i) { const int r = prow + 32 * i; kraw[i] = *(const LAS v4u*)(lds + SK_OFF + r * QKSTR + pch * 16); cjw[i] = cjA[st * 64 + r]; }
#pragma unroll
                for (int i = 0; i < 2; ++i) { const int r = prow + 32 * i; const float wj = fexp(cjw[i] - ML_t);
                    float kf[8]; unpack8(kraw[i], kf); v4u kw; kw.x = pk2(kf[0] * wj, kf[1] * wj); kw.y = pk2(kf[2] * wj, kf[3] * wj); kw.z = pk2(kf[4] * wj, kf[5] * wj); kw.w = pk2(kf[6] * wj, kf[7] * wj);
                    *(LAS v4u*)(lds + SKW_OFF + r * QSTR + pch * 16) = kw; }
                };
            *(LAS v4u*)(lds + SV_OFF + vrow * VSTR + vch * 16) = RV;
            load_v(st + 2, RV);
            if (isc || hf == 0) { kwblock(); __builtin_amdgcn_sched_barrier(0); }
            f32x4 a2[3]; float Ms = 0.f;
            if (!isc) {
                Ms = fmaxf(m_t, cms);
                f32x4 sacc[2];
#pragma unroll
                for (int jj = 0; jj < 2; ++jj) { sacc[jj] = (f32x4){0.f, 0.f, 0.f, 0.f};
#pragma unroll
                    for (int ks = 0; ks < 4; ++ks) sacc[jj] = __builtin_amdgcn_mfma_f32_16x16x32_bf16(Xk[jj][ks], Yq[ks], sacc[jj], 0, 0, 0); }
                __builtin_amdgcn_sched_barrier(0);
                auto pmath = [&]() {
#pragma unroll
                    for (int jj = 0; jj < 2; ++jj) { const int jb = 2 * hf + jj; float p[4];
#pragma unroll
                        for (int r = 0; r < 4; ++r) { const int j_pos = 16 * jb + 4 * fq + r; const bool ok = dir ? (j_pos >= s_pos) : (j_pos <= s_pos); p[r] = sacc[jj][r] * fexp(ok ? (c4[jj][r] - Ms) : -1e30f); }
                        v2u pw; pw.x = pk2(p[0], p[1]); pw.y = pk2(p[2], p[3]);
                        *(LAS v2u*)(lds + SP_OFF + s_pos * PSTR + (16 * jb + 4 * fq) * 2) = pw; } };
                auto qcmma = [&]() {
                    bf16x8 Xc[3][4];
#pragma unroll
                    for (int ti = 0; ti < 3; ++ti) { const int e = (ti == 2) ? 4 : 2 * hf + ti;
#pragma unroll
                        for (int ks = 0; ks < 4; ++ks) Xc[ti][ks] = *(const LAS bf16x8*)(lds + SCB_OFF + (16 * e + fr) * QSTR + 64 * ks + ((fq ^ cbh) * 16)); }
                    __builtin_amdgcn_sched_barrier(0);
#pragma unroll
                    for (int ti = 0; ti < 3; ++ti) { a2[ti] = (f32x4){0.f, 0.f, 0.f, 0.f};
#pragma unroll
                        for (int ks = 0; ks < 4; ++ks) a2[ti] = __builtin_amdgcn_mfma_f32_16x16x32_bf16(Xc[ti][ks], Yq[ks], a2[ti], 0, 0, 0); } };
                if (hf == 0) { pmath(); qcmma(); } else { qcmma(); __builtin_amdgcn_sched_barrier(0); pmath(); kwblock(); }
            }
            SCAN_BAR();
            {
                const float decay = fexp(m_t - ML_t);
                bf16x8 Xkw[2], Yp[2], Yv[5][2]; float bss = 0.f;
#pragma unroll
                for (int ks = 0; ks < 2; ++ks) { LAS unsigned char* p = lds + SKW_OFF + (32 * ks + 8 * fq + tq) * QSTR + (16 * wave + 4 * tp) * 2; Xkw[ks] = tr_frag(p, p + 4 * QSTR); }
#pragma unroll
                for (int e = 0; e < 5; ++e)
#pragma unroll
                    for (int ks = 0; ks < 2; ++ks) { LAS unsigned char* p = lds + SV_OFF + (32 * ks + 8 * fq + tq) * VSTR + (16 * e + 4 * tp) * 2; Yv[e][ks] = tr_frag(p, p + 4 * VSTR); }
                if (!isc) {
#pragma unroll
                    for (int ks = 0; ks < 2; ++ks) Yp[ks] = *(const LAS bf16x8*)(lds + SP_OFF + s_pos * PSTR + (32 * ks + 8 * fq) * 2);
                    bss = bsA[st * 64 + s_pos];
                }
                __builtin_amdgcn_sched_barrier(0);
                f32x4 o[3];
#pragma unroll
                for (int e = 0; e < 5; ++e) {
                    if (!isc && (e == 4 || hf == (e >> 1))) { const int ti = (e == 4) ? 2 : (e & 1); f32x4 a1 = (f32x4){0.f, 0.f, 0.f, 0.f};
#pragma unroll
                        for (int ks = 0; ks < 2; ++ks) a1 = __builtin_amdgcn_mfma_f32_16x16x32_bf16(Yv[e][ks], Yp[ks], a1, 0, 0, 0);
                        o[ti] = a1; }
                    Cacc[e] = Cacc[e] * decay;
#pragma unroll
                    for (int ks = 0; ks < 2; ++ks) Cacc[e] = __builtin_amdgcn_mfma_f32_16x16x32_bf16(Xkw[ks], Yv[e][ks], Cacc[e], 0, 0, 0); }
#pragma unroll
                for (int e = 0; e < 5; ++e) { v2u cw; cw.x = pk2(Cacc[e][0], Cacc[e][1]); cw.y = pk2(Cacc[e][2], Cacc[e][3]);
                    *(LAS v2u*)(lds + SCB_OFF + (16 * e + fr) * QSTR + (((2 * wave + (fq >> 1)) ^ cbh) * 16) + (fq & 1) * 8) = cw; }
#pragma unroll
                for (int i = 0; i < 2; ++i) { *(LAS v4u*)(lds + SQ_OFF + (prow + 32 * i) * QKSTR + pch * 16) = RQ[i]; *(LAS v4u*)(lds + SK_OFF + (prow + 32 * i) * QKSTR + pch * 16) = RK[i]; }
                load_qk(st + 3, RQ, RK);
                if (!isc) {
                    const float wint = fexp(m_t - Ms), hden = fexp(-(bss + Ms));
#pragma unroll
                    for (int ti = 0; ti < 3; ++ti) o[ti] = o[ti] + a2[ti] * wint;
                    const float den = __shfl(o[2][0], fr);
                    const float inv = 1.0f / fmaxf(fabsf(den), hden);
#pragma unroll
                    for (int ti = 0; ti < 2; ++ti) { const int e = 2 * hf + ti; const f32x4 hv = o[ti] * inv; v2u w; w.x = pk2(hv[0], hv[1]); w.y = pk2(hv[2], hv[3]);
                        *(LAS v2u*)(lds + SHS_OFF + s_pos * PSTR + (16 * e + 4 * fq) * 2) = w; }
                }
            }
            SCAN_BAR();
        };
        step(0, true, rq[1], rk[1], rv[0]); step(1, true, rq[0], rk[0], rv[1]); step(2, true, rq[1], rk[1], rv[0]); step(3, true, rq[0], rk[0], rv[1]);
        for (int g = 1; g < 17; ++g) { const int st = 4 * g;
            step(st, false, rq[1], rk[1], rv[0]); step(st + 1, false, rq[0], rk[0], rv[1]); step(st + 2, false, rq[1], rk[1], rv[0]); step(st + 3, false, rq[0], rk[0], rv[1]); }
        { const v4u hw = *(const LAS v4u*)(lds + SHS_OFF + (tid >> 3) * PSTR + (tid & 7) * 16); *(v4u*)(HO + (size_t)(row_of(67) + (tid >> 3)) * D + h * DVH + e0 + (tid & 7) * 8) = hw; }
    }
}

constexpr int NPHASES = 24;
__global__ void __launch_bounds__(NWAVES * 64, 2) fwd_kernel(KArgs a) {
    extern __shared__ __attribute__((aligned(16))) unsigned char lds_raw[];
    LAS unsigned char* lds = (LAS unsigned char*)lds_raw;
    const int tid = threadIdx.x, lane = tid & 63, wave = __builtin_amdgcn_readfirstlane(tid >> 6);
    const int G = gridDim.x, bx = blockIdx.x, vcu = (G % 8 == 0) ? (bx % 8) * (G / 8) + bx / 8 : bx;
    const int gw = vcu * NWAVES + wave, NGW = G * NWAVES;
    unsigned char* ws = a.ws;
    unsigned* ctl = (unsigned*)(ws + WS_CTL);
    volatile LAS unsigned* MISC = (volatile LAS unsigned*)(lds + LDSCTL_OFF);
    for (int u = tid; u < (LDS_BYTES - LDSCTL_OFF) / 4; u += NWAVES * 64) ((LAS unsigned*)(lds + LDSCTL_OFF))[u] = 0u;
    __syncthreads();
    XcdBarrier bar; bar.bar = ctl + CW_BAR; bar.x = 0; bar.st = nullptr;
#if !MK_PER_PHASE
    bar = xcd_barrier_post(ctl + CW_BAR, MISC + 8);
#endif
    const int lo = a.ph_lo, hi = a.ph_hi;
#define IN(k) (lo <= (k) && (k) < hi)
#if MK_PER_PHASE
#define SEAM(k) do { } while (0)
#else
#define SEAM(k) do { if (IN(k) && IN((k) + 1)) xcd_barrier(bar); } while (0)
#endif
#define x_in (a.in[0])
#define ctx_in (a.in[2])
#define X ((float*)(ws + WS_X))
#define HB ((bf16*)(ws + WS_HB))
#define ACT ((bf16*)(ws + WS_ACT))
#define QKVO ((bf16*)(ws + WS_QKVO))
#define GATES ((float*)(ws + WS_GATES))
#define HF ((bf16*)(ws + WS_HF))
#define HBW ((bf16*)(ws + WS_HBW))
#define mod ((const float*)(ws + WS_MOD))
#define WFI ((const bf16*)(ws + WS_WFI))
#define WFO ((const bf16*)(ws + WS_WFO))
#define normg (a.in[6])
#define GS ((float*)(ws + WS_GS))
#define SS ((float*)(ws + WS_SS))
#define RSTD ((float*)(ws + WS_RSTD))
#define BIAS ((float*)(ws + WS_BIAS))
#define YB ((bf16*)(ws + WS_ACT))
#define BG ((bf16*)(ws + WS_QKVO))
#define ZB ((bf16*)(ws + WS_QKVO) + (size_t)MX * D)
    const int gtid = bx * NWAVES * 64 + tid, NGT = G * NWAVES * 64;
    if (IN(0)) { mod_partials(a, 0, gw, NGW, lane); mod_partials(a, 1, gw, NGW, lane); convert_list<0>(a, lds, gw, NGW, wave, lane); }
    SEAM(0);
    if (IN(1)) modreduce_phase((const float*)(ws + WS_MODP), a.in[5], normg, a.in[16], (float*)(ws + WS_MOD), GS, (float*)(ws + WS_RGS), gtid, NGT);
    SEAM(1);
#define FFN_UP(p, wi, rows, FOLDV, boff) do { if (IN(p)) { pg8::Gemm g{HB, WFI + (size_t)(wi) * NFI * D, rows, NFI, D}; pg8::StaticOrder S; S.init(rows, NFI, G, bx, D); if (FOLDV) panel_rstd(S, SS, RSTD, tid); \
        pg8::EpiSwigluT<FOLDV> E{ACT, DFF, pg8::Fold{ws, (boff)}}; pg8::gemm_phase<pg8::EpiSwigluT<FOLDV>, pg8::StaticOrder, true, true, true>(lds, g, S, E); } SEAM(p); } while (0)
#define FFN_DOWN(p, wi, l, j, SRCV, NEXTV, nsub) do { if (IN(p)) { pg8::Gemm g{ACT, WFO + (size_t)(wi) * D * DFF, MX, D, DFF}; pg8::StaticOrder S; S.init(MX, D, G, bx, DFF, 4); \
        pg8::EpiResidT<SRCV, NEXTV, true> E{x_in, ctx_in, ws, (l) * 5 * MODW + (3 * (j) + 2) * D, (l) * 3 + (j), (nsub)}; \
        pg8::gemm_phase<pg8::EpiResidT<SRCV, NEXTV, true>, pg8::StaticOrder, true, true, true>(lds, g, S, E); } } while (0)

    if (IN(2)) { normmod_phase(x_in, ctx_in, MT, normg + (0 * 3 + 0) * D, mod, 0, HB, gw, NGW, lane);
        convert_list<1>(a, lds, gw, NGW, wave, lane); convert_list<2>(a, lds, gw, NGW, wave, lane); }
    SEAM(2);
    if (IN(3)) { pg8::Gemm g{HB, WFI, MT, NFI, D}; pg8::StaticOrder S; S.init(MT, NFI, G, bx, D);
        pg8::EpiSwigluT<false> E{ACT, DFF, pg8::Fold{ws, 0}}; pg8::gemm_phase<pg8::EpiSwigluT<false>, pg8::StaticOrder, true, true, true>(lds, g, S, E);
        { int rank, cnt; if (tail_rank((MT / 256) * (NFI / 256), G, bx, rank, cnt)) biasreduce_phase((const float*)(ws + WS_BIASP), BIAS, rank * NWAVES * 64 + tid, cnt * NWAVES * 64); } }
    SEAM(3);
    if (IN(4)) { FFN_DOWN(4, 0, 0, 0, true, true, 1);
        { pg8::Gemm g{ACT, WFO, MT, D, DFF}; pg8::SplitKOrder S{G, bx, MX / 256};
          pg8::EpiPartial E{(float*)(ws + WS_CTXP), MX, (size_t)MC * D};
          pg8::gemm_phase<pg8::EpiPartial, pg8::SplitKOrder, true, true, true>(lds, g, S, E); } }
    SEAM(4);
    if (IN(5)) { rowstat_phase(SS, RSTD, true, gtid, NGT);
        normmod_phase(X, ctx_in, MT, normg + (0 * 3 + 1) * D, mod, 1, HB, gw, NGW, lane, (const float*)(ws + WS_CTXP), mod + (size_t)4 * MODW + (3 * 0 + 2) * D, MX); }
    SEAM(5);
    if (IN(6)) { pg8::Gemm g{HB, (const bf16*)(ws + WS_WMI), MT, NML, D}; pg8::StaticOrder S; S.init(MT, NML, G, bx, D); pg8::EpiMlstmInT<true> E{QKVO, GATES, a.in[10], pg8::Fold{ws, BOFF_MI}};
        pg8::gemm_phase<pg8::EpiMlstmInT<true>, pg8::StaticOrder, true, true, true>(lds, g, S, E); }
    SEAM(6);
    if (PROBE_DUP == 6) { pg8::Gemm g{HB, (const bf16*)(ws + WS_WMI), MT, NML, D}; pg8::StaticOrder S; S.init(MT, NML, G, bx, D); pg8::EpiMlstmInT<true> E{QKVO, GATES, a.in[10], pg8::Fold{ws, BOFF_MI}};
        pg8::gemm_phase<pg8::EpiMlstmInT<true>, pg8::StaticOrder, true, true, true>(lds, g, S, E); xcd_barrier(bar); }
    if (IN(7)) scan_phase<0>(lds, QKVO, GATES, HF, HBW, vcu, G, tid, lane, wave);
    SEAM(7);
    if (IN(8)) headnorm_phase(HF, HBW, QKVO, a.in[11], YB, gw, NGW, lane);
    SEAM(8);
    if (PROBE_DUP == 8) { headnorm_phase(HF, HBW, QKVO, a.in[11], YB, gw, NGW, lane); xcd_barrier(bar); }
    if (IN(9)) { pg8::Gemm g{YB, (const bf16*)(ws + WS_WMO), MX, D, D}; pg8::StaticOrder S; S.init(MX, D, G, bx, D, 4);
        pg8::EpiResidT<false, true, false> E{x_in, ctx_in, ws, (3 * 1 + 2) * D, 1, 2};
        pg8::gemm_phase<pg8::EpiResidT<false, true, false>, pg8::StaticOrder, true, true, true>(lds, g, S, E); }
    SEAM(9);
    FFN_UP(11, 1, MX, true, BOFF_F1);
    FFN_DOWN(12, 1, 0, 2, false, true, 3); SEAM(12);
    if (PROBE_DUP == 12) { pg8::Gemm g{ACT, WFO + (size_t)1 * D * DFF, MX, D, DFF}; pg8::StaticOrder S; S.init(MX, D, G, bx, DFF); pg8::EpiPartial E{(float*)(ws + WS_QKVO), 0, (size_t)0};
        pg8::gemm_phase<pg8::EpiPartial, pg8::StaticOrder, true, true, true>(lds, g, S, E); xcd_barrier(bar); }
    FFN_UP(14, 2, MX, true, BOFF_F2);
    FFN_DOWN(15, 2, 1, 0, false, true, 4); SEAM(15);
    if (IN(17)) { pg8::Gemm g{HB, (const bf16*)(ws + WS_WCI), MX, NCV, D}; pg8::StaticOrder S; S.init(MX, NCV, G, bx, D); panel_rstd(S, SS, RSTD, tid); pg8::EpiConvInT<true> E{BG, ZB, pg8::Fold{ws, BOFF_CI}};
        pg8::gemm_phase<pg8::EpiConvInT<true>, pg8::StaticOrder, true, true, true>(lds, g, S, E); }
    SEAM(17);
    if (IN(18)) convmix_phase(BG, ZB, a.in[14], YB, gw, NGW, lane);
    SEAM(18);
    if (IN(19)) { pg8::Gemm g{YB, (const bf16*)(ws + WS_WCO), MX, D, D}; pg8::StaticOrder S; S.init(MX, D, G, bx, D, 4);
        pg8::EpiResidT<false, true, false> E{x_in, ctx_in, ws, 5 * MODW + (3 * 1 + 2) * D, 4, 5};
        pg8::gemm_phase<pg8::EpiResidT<false, true, false>, pg8::StaticOrder, true, true, true>(lds, g, S, E); }
    SEAM(19);
    FFN_UP(21, 3, MX, true, BOFF_F3);
    FFN_DOWN(22, 3, 1, 2, false, true, 6); SEAM(22);
    if (IN(23)) final_norm_phase(HB, SS, a.out, gw, NGW, lane);
#undef FFN_UP
#undef FFN_DOWN
#undef x_in
#undef ctx_in
#undef X
#undef HB
#undef ACT
#undef QKVO
#undef GATES
#undef HF
#undef HBW
#undef mod
#undef WFI
#undef WFO
#undef normg
#undef GS
#undef SS
#undef RSTD
#undef BIAS
#undef YB
#undef BG
#undef ZB
#undef IN
#undef SEAM
}

extern "C" void kernel_launch(void* const* d_in, const int* in_sizes, int n_in, void* d_out, int out_size, void* d_ws, size_t ws_size, hipStream_t stream) {
    static int grid = 0;
    if (grid == 0) {
        if (n_in != 17 || in_sizes[0] != MX * D || out_size != MX * D || ws_size < WS_END) { fprintf(stderr, "kernel_launch: unexpected shapes (n_in %d, in0 %d, out %d, ws %zu)\n", n_in, n_in > 0 ? in_sizes[0] : -1, out_size, ws_size); grid = -1; return; }
        int dev = 0, cus = 0, per_cu = 0;
        if (hipGetDevice(&dev) != hipSuccess || hipDeviceGetAttribute(&cus, hipDeviceAttributeMultiprocessorCount, dev) != hipSuccess) { fprintf(stderr, "kernel_launch: device query failed\n"); grid = -1; return; }
        if (hipFuncSetAttribute((const void*)fwd_kernel, hipFuncAttributeMaxDynamicSharedMemorySize, LDS_BYTES) != hipSuccess) { fprintf(stderr, "kernel_launch: hipFuncSetAttribute failed\n"); grid = -1; return; }
        if (hipOccupancyMaxActiveBlocksPerMultiprocessor(&per_cu, (const void*)fwd_kernel, NWAVES * 64, LDS_BYTES) != hipSuccess || per_cu < 1) { fprintf(stderr, "kernel_launch: occupancy query reports %d workgroups per CU\n", per_cu); }
        (void)hipGetLastError();
        grid = cus;
    }
    if (grid < 0) return;
    if (hipMemsetAsync((char*)d_ws + WS_CTL, 0, CTL_ZERO_BYTES, stream) != hipSuccess) { fprintf(stderr, "kernel_launch: memset failed\n"); return; }
    KArgs a{};
    for (int i = 0; i < 17; ++i) a.in[i] = (const float*)d_in[i];
    a.out = (float*)d_out; a.ws = (unsigned char*)d_ws;
#if MK_PER_PHASE
    for (int p = 0; p < NPHASES; ++p) { a.ph_lo = p; a.ph_hi = p + 1; hipLaunchKernelGGL(fwd_kernel, dim3(grid), dim3(NWAVES * 64), LDS_BYTES, stream, a); }
#else
    a.ph_lo = 0; a.ph_hi = NPHASES;
    hipLaunchKernelGGL(fwd_kernel, dim3(grid), dim3(NWAVES * 64), LDS_BYTES, stream, a);
#endif
    const hipError_t le = hipPeekAtLastError();
    if (le != hipSuccess) fprintf(stderr, "kernel_launch: launch failed: %s\n", hipGetErrorName(le));
}
```

```cpp
#include <hip/hip_runtime.h>
#include <cstdio>
#include <cstdint>

#ifndef PROBE_DUP
#define PROBE_DUP -1
#endif
#ifndef TAILS
#define TAILS 0
#endif
#ifndef MK_PER_PHASE
#define MK_PER_PHASE 0
#endif

constexpr int NWAVES = 8;
constexpr int BATCH = 4, SEQ = 4096, D = 2048, CTXL = 256, NH = 8, DKH = 128, DVH = 256, DFF = 5504;
constexpr int MX = BATCH * SEQ, MC = BATCH * CTXL, MT = MX + MC;
constexpr int NFI = 2 * DFF;
constexpr int NML = 6400, NMLSRC = 6176, NCV = 6144;
constexpr int MODW = 9 * D;
constexpr float RMS_EPS = 1e-6f;
__host__ __device__ __forceinline__ size_t hb_off(int r, int c) { return (((size_t)(r >> 8) * (D / 64) + (c >> 6)) * 256 + (r & 255)) * 64 + (c & 63); }

constexpr size_t MiB = 1u << 20;
constexpr size_t WS_CTL = 0, CTL_ZERO_BYTES = 64 * 1024;
constexpr size_t WS_MOD = 1 * MiB;
constexpr size_t WS_WFI = 2 * MiB;
constexpr size_t WS_WFO = 174 * MiB;
constexpr size_t WS_WMI = 260 * MiB;
constexpr size_t WS_WMO = 285 * MiB;
constexpr size_t WS_WCI = 293 * MiB;
constexpr size_t WS_WCO = 317 * MiB;
constexpr size_t WS_X = 326 * MiB;
constexpr size_t WS_HB = 462 * MiB;
constexpr size_t WS_ACT = 530 * MiB;
constexpr size_t WS_QKVO = 713 * MiB;
constexpr size_t QH_OFF = 0, KH_OFF = (size_t)17408 * 1024, VH_OFF = (size_t)17408 * 2048, OG_OFF = (size_t)17408 * 4096;
constexpr int CTX_SLOT0 = 4 * 8 * 4096;
constexpr size_t WS_GATES = 917 * MiB;
constexpr size_t WS_HF = 920 * MiB, WS_HBW = 984 * MiB;
constexpr size_t WS_MODP = WS_HF;
constexpr size_t WS_CTXP = 1048 * MiB;
constexpr int NBCOL = 45568;
constexpr int BOFF_MI = 0, BOFF_F1 = 6400, BOFF_F2 = 17408, BOFF_CI = 28416, BOFF_F3 = 34560;
constexpr size_t WS_BIASP = 1112 * MiB;
constexpr size_t WS_BIAS = 1142 * MiB;
constexpr size_t WS_GS = 1144 * MiB;
constexpr size_t WS_RGS = 1144 * MiB + 512 * 1024;
constexpr size_t WS_SS = 1145 * MiB;
constexpr size_t WS_RSTD = 1148 * MiB;
constexpr size_t WS_END = 1149 * MiB;
constexpr int CW_BAR = 4096;

namespace pg8 {
#define PG8_LAS __attribute__((address_space(3)))
typedef unsigned short bf16_t;
typedef short bf16x8 __attribute__((ext_vector_type(8)));
typedef float f32x4 __attribute__((ext_vector_type(4)));
typedef unsigned u32x4 __attribute__((ext_vector_type(4)));
constexpr int BM = 256, BK = 64, HALF = 128, HTB = HALF * BK * 2, STAGE_BYTES = 8 * HTB, NXCD = 8, WGM = 8;

__host__ __device__ __forceinline__ int lds_byte(int r, int c) { const int st = (r >> 4) * 2 + (c >> 5), rr = r & 15, cc = c & 31, ob = rr * 64 + cc * 2; return st * 1024 + (ob ^ (((ob >> 9) & 1) << 5)); }
__host__ __device__ __forceinline__ void stage_rc(int b, int& R, int& C) { const int st = b / 1024, sb = b % 1024, swz = sb ^ (((sb >> 9) & 1) << 5); R = (st >> 1) * 16 + swz / 64; C = (st & 1) * 32 + (swz % 64) / 2; }
__host__ __device__ __forceinline__ int perm32(int rho) { const int n = rho >> 4, i = rho & 15; return 8 * (i >> 2) + 4 * n + (i & 3); }

struct Unit { int pm, pn, k0, nt; };
struct Gemm { const bf16_t* A; const bf16_t* Bt; int M, N, K; };

struct StaticOrder {
    int nM, nN, nwg, G, c, ntk, wgm;
    __host__ __device__ void init(int M, int N, int G_, int c_, int K_, int wgm_ = WGM) { nM = M / BM; nN = N / BM; nwg = nM * nN; G = G_; c = c_; ntk = K_ / BK; wgm = wgm_; }
    __host__ __device__ bool next(int i, Unit& u) const {
        const long L = (long)i * G + c; if (L >= nwg) return false;
        int wgid = (int)L; { const int q = nwg / NXCD, r = nwg % NXCD, xcd = wgid % NXCD, off = wgid / NXCD; wgid = (xcd < r ? xcd * (q + 1) : r * (q + 1) + (xcd - r) * q) + off; }
        const int nig = wgm * nN, gid = wgid / nig, fm = gid * wgm, gsz = (nM - fm) < wgm ? (nM - fm) : wgm;
        u.pm = fm + ((wgid % nig) % gsz); u.pn = (wgid % nig) / gsz; u.k0 = 0; u.nt = ntk; return true;
    }
    __device__ __forceinline__ void a_ready(const Unit&) const {}
    __device__ __forceinline__ void done(const Unit&) const {}
};

typedef __bf16 bf16x2_t __attribute__((ext_vector_type(2)));
typedef float f32x2_t __attribute__((ext_vector_type(2)));
struct SplitKOrder {
    int G, c, pm0;
    __device__ __forceinline__ bool next(int i, Unit& u) const { const long L = (long)i * G + c; if (L >= 256) return false; const int w = (int)L, sl = w & 7, tile = w >> 3;
        u.pm = pm0 + (tile >> 3); u.pn = tile & 7; const int p0 = sl < 5 ? 5 * sl : 25 + 6 * (sl - 5), np = sl < 5 ? 5 : 6; u.k0 = p0 * 128; u.nt = np * 2; return true; }
    __device__ __forceinline__ void a_ready(const Unit&) const {}
    __device__ __forceinline__ void done(const Unit&) const {}
};
__device__ __forceinline__ unsigned cvt_pk_bf16(float lo, float hi) { const f32x2_t v = {lo, hi}; const bf16x2_t b = __builtin_convertvector(v, bf16x2_t); return __builtin_bit_cast(unsigned, b); }
__device__ __forceinline__ float silu_f(float x) { return x * __builtin_amdgcn_rcpf(1.0f + __builtin_amdgcn_exp2f(-1.44269504f * x)); }
__device__ __forceinline__ unsigned swiglu_pk(float ga, float gb, float ua, float ub) {
    const f32x2_t g = {ga, gb}, u = {ua, ub}; const f32x2_t t = g * (f32x2_t){-1.44269504f, -1.44269504f};
    const f32x2_t e = {__builtin_amdgcn_exp2f(t[0]), __builtin_amdgcn_exp2f(t[1])}; const f32x2_t d = e + (f32x2_t){1.0f, 1.0f};
    const f32x2_t r = {__builtin_amdgcn_rcpf(d[0]), __builtin_amdgcn_rcpf(d[1])}; const f32x2_t o = (g * u) * r;
    const bf16x2_t b = __builtin_convertvector(o, bf16x2_t); return __builtin_bit_cast(unsigned, b); }


struct Fold { const unsigned char* ws; int boff;
    __device__ __forceinline__ const float* rstd() const { return (const float*)(ws + WS_RSTD); }
    __device__ __forceinline__ const float* bias(int bidx) const { return (const float*)(ws + WS_BIAS) + (size_t)bidx * NBCOL + boff; }
    __device__ __forceinline__ void rows8(int row0, float (&rs)[2][4]) const {
#pragma unroll
        for (int ai = 0; ai < 2; ++ai)
#pragma unroll
            for (int m = 0; m < 4; ++m) rs[ai][m] = rstd()[row0 + ai * HALF + m * 16]; } };
template <bool FOLD> struct EpiSwigluT {
    static constexpr bool PERM = true, AFTER_DRAIN = false; static constexpr int NSTORE = 8;
    bf16_t* O; int ldc; Fold F;
    __device__ __forceinline__ void operator()(const f32x4 (&acc)[2][2][4][2], const Unit& u, int wr, int wc, int fr, int fq) const {
        const int row0 = u.pm * BM + wr * 64 + fr, col0 = u.pn * HALF + wc * 32 + 8 * fq;
        f32x4 bg[2], bu[2];
        if (FOLD) { const int bidx = (u.pm * BM >= MX) ? 5 : (u.pm >> 4); const float* bp = F.bias(bidx) + u.pn * BM + wc * 32 + 8 * fq;
            bg[0] = *(const f32x4*)bp; bg[1] = *(const f32x4*)(bp + 4); bu[0] = *(const f32x4*)(bp + HALF); bu[1] = *(const f32x4*)(bp + HALF + 4); }
        float rsv[2][4]; if (FOLD) F.rows8(row0, rsv);
#pragma unroll
        for (int ai = 0; ai < 2; ++ai)
#pragma unroll
            for (int m = 0; m < 4; ++m) { const int r = row0 + ai * HALF + m * 16; bf16_t* rowp = O + (((size_t)u.pm * (ldc / BK) + (col0 >> 6)) * BM + (r & (BM - 1))) * BK + (col0 & (BK - 1));
                f32x4 g0 = acc[ai][0][m][0], g1 = acc[ai][0][m][1], u0 = acc[ai][1][m][0], u1 = acc[ai][1][m][1];
                if (FOLD) { const float rs = rsv[ai][m]; g0 = g0 * rs + bg[0]; g1 = g1 * rs + bg[1]; u0 = u0 * rs + bu[0]; u1 = u1 * rs + bu[1]; }
                u32x4 w; w.x = swiglu_pk(g0[0], g0[1], u0[0], u0[1]); w.y = swiglu_pk(g0[2], g0[3], u0[2], u0[3]);
                w.z = swiglu_pk(g1[0], g1[1], u1[0], u1[1]); w.w = swiglu_pk(g1[2], g1[3], u1[2], u1[3]);
                *(u32x4*)rowp = w; }
    }
};
template <bool SRC32, bool NEXT, bool HALFC> struct EpiResidT {
    static constexpr bool PERM = true, AFTER_DRAIN = false; static constexpr int NSTORE = 16;
    const float* xin_x; const float* xin_c; unsigned char* ws; int gate_off, psub, nsub;
    __device__ __forceinline__ void operator()(const f32x4 (&acc)[2][2][4][2], const Unit& u, int wr, int wc, int fr, int fq) const {
        const bool isc = (u.pm * BM) >= MX; const int bidx = isc ? 4 : (u.pm >> 4); const float coef = HALFC ? 0.5f : 1.0f;
        float* X = (float*)(ws + WS_X); bf16_t* XS = (bf16_t*)(ws + WS_HB); float* SS = (float*)(ws + WS_SS);
        const float* gv = (const float*)(ws + WS_MOD) + gate_off + (size_t)bidx * MODW; const float* gs = (const float*)(ws + WS_GS) + ((size_t)nsub * 5 + bidx) * D;
        const float* rg = (const float*)(ws + WS_RGS) + ((size_t)psub * 5 + bidx) * D;
        const int col0 = u.pn * BM + wc * 32 + 8 * fq; const int row0 = u.pm * BM + wr * 64 + fr;
        f32x4 gg[2][2], gsv[2][2], rgv[2][2];
#pragma unroll
        for (int bj = 0; bj < 2; ++bj)
#pragma unroll
            for (int n = 0; n < 2; ++n) { gg[bj][n] = *(const f32x4*)(gv + col0 + bj * HALF + 4 * n) * coef; if (NEXT) gsv[bj][n] = *(const f32x4*)(gs + col0 + bj * HALF + 4 * n);
                if (!SRC32) rgv[bj][n] = *(const f32x4*)(rg + col0 + bj * HALF + 4 * n); }
#pragma unroll
        for (int ai = 0; ai < 2; ++ai)
#pragma unroll
            for (int m = 0; m < 4; ++m) { const int r = row0 + ai * HALF + m * 16; float sq = 0.f;
                const float* src = (isc ? xin_c + (size_t)(r - MX) * D : xin_x + (size_t)r * D) + col0;
#pragma unroll
                for (int bj = 0; bj < 2; ++bj) { const size_t eo = (size_t)r * D + col0 + bj * HALF, xe = hb_off(r, col0 + bj * HALF); f32x4 xo0, xo1;
                    if (SRC32) { xo0 = __builtin_nontemporal_load((const f32x4*)(src + bj * HALF)); xo1 = __builtin_nontemporal_load((const f32x4*)(src + bj * HALF + 4)); }
                    else { const u32x4 w = *(const u32x4*)(XS + xe);
                        xo0 = (f32x4){__builtin_bit_cast(float, w.x << 16), __builtin_bit_cast(float, w.x & 0xffff0000u), __builtin_bit_cast(float, w.y << 16), __builtin_bit_cast(float, w.y & 0xffff0000u)} * rgv[bj][0];
                        xo1 = (f32x4){__builtin_bit_cast(float, w.z << 16), __builtin_bit_cast(float, w.z & 0xffff0000u), __builtin_bit_cast(float, w.w << 16), __builtin_bit_cast(float, w.w & 0xffff0000u)} * rgv[bj][1]; }
                    const f32x4 xn0 = xo0 + acc[ai][bj][m][0] * gg[bj][0], xn1 = xo1 + acc[ai][bj][m][1] * gg[bj][1];
                    if (NEXT) { const f32x4 y0 = xn0 * gsv[bj][0], y1 = xn1 * gsv[bj][1]; u32x4 w; w.x = cvt_pk_bf16(y0[0], y0[1]); w.y = cvt_pk_bf16(y0[2], y0[3]); w.z = cvt_pk_bf16(y1[0], y1[1]); w.w = cvt_pk_bf16(y1[2], y1[3]);
                        *(u32x4*)(XS + xe) = w; sq += ((xn0[0] * xn0[0] + xn0[1] * xn0[1]) + (xn0[2] * xn0[2] + xn0[3] * xn0[3])) + ((xn1[0] * xn1[0] + xn1[1] * xn1[1]) + (xn1[2] * xn1[2] + xn1[3] * xn1[3])); }
                    else { *(f32x4*)(X + eo) = xn0; *(f32x4*)(X + eo + 4) = xn1; } }
                if (NEXT) { sq += __shfl_xor(sq, 16); sq += __shfl_xor(sq, 32); if (fq == 0) SS[(size_t)r * 32 + u.pn * 4 + wc] = sq; }
                if (SRC32 && m == 3) asm volatile("" ::: "memory"); }
    }
};
struct EpiPartial {
    static constexpr bool PERM = false, AFTER_DRAIN = false; static constexpr int NSTORE = 32;
    float* P; int row0; size_t slice_stride;
    __device__ __forceinline__ void operator()(const f32x4 (&acc)[2][2][4][2], const Unit& u, int wr, int wc, int fr, int fq) const {
        const int sl = u.k0 < 25 * 128 ? u.k0 / (5 * 128) : 5 + (u.k0 - 25 * 128) / (6 * 128);
        float* base = P + (size_t)sl * slice_stride; const int col0 = u.pn * BM + wc * 32 + 4 * fq, r0 = u.pm * BM - row0 + wr * 64 + fr;
#pragma unroll
        for (int ai = 0; ai < 2; ++ai)
#pragma unroll
            for (int m = 0; m < 4; ++m) { float* rowp = base + (size_t)(r0 + ai * HALF + m * 16) * 2048 + col0;
#pragma unroll
                for (int bj = 0; bj < 2; ++bj)
#pragma unroll
                    for (int n = 0; n < 2; ++n) *(f32x4*)(rowp + bj * HALF + n * 16) = acc[ai][bj][m][n]; }
    }
};
template <bool FOLD> struct EpiMlstmInT {
    static constexpr bool PERM = true, AFTER_DRAIN = false; static constexpr int NSTORE = 0;
    bf16_t* O; float* G; const float* bgate; Fold F;
    __device__ __forceinline__ void operator()(const f32x4 (&acc)[2][2][4][2], const Unit& u, int wr, int wc, int fr, int fq) const {
        const int row0 = u.pm * BM + wr * 64 + fr;
        f32x4 bv[2][2];
#pragma unroll
        for (int bj = 0; bj < 2; ++bj)
#pragma unroll
            for (int n = 0; n < 2; ++n) bv[bj][n] = (f32x4){0.f, 0.f, 0.f, 0.f};
        if (FOLD) { const int bidx = (u.pm * BM >= MX) ? 5 : (u.pm >> 4); const float* bp = F.bias(bidx) + u.pn * BM + wc * 32 + 8 * fq;
#pragma unroll
            for (int bj = 0; bj < 2; ++bj)
#pragma unroll
                for (int n = 0; n < 2; ++n) bv[bj][n] = *(const f32x4*)(bp + bj * HALF + 4 * n); }
        if (u.pn < 24) {
            const bool isc = u.pm * BM >= MX; const int slot0 = isc ? CTX_SLOT0 + (u.pm - MX / BM) * 8 * 256 : (u.pm >> 4) * 8 * 4096 + (u.pm & 15) * 256, hstride = isc ? 256 : 4096, rr0 = wr * 64 + fr;
            bf16_t* pb[2];
#pragma unroll
            for (int bj = 0; bj < 2; ++bj) {
                if (u.pn < 4) pb[bj] = O + QH_OFF + ((size_t)slot0 + (size_t)(2 * u.pn + bj) * hstride) * 128 + wc * 32 + 8 * fq;
                else if (u.pn < 8) pb[bj] = O + KH_OFF + ((size_t)slot0 + (size_t)(2 * (u.pn - 4) + bj) * hstride) * 128 + wc * 32 + 8 * fq;
                else if (u.pn < 16) pb[bj] = O + VH_OFF + ((size_t)slot0 + (size_t)(u.pn - 8) * hstride) * 256 + bj * HALF + wc * 32 + 8 * fq;
                else pb[bj] = O + OG_OFF + (size_t)(u.pm * BM) * 2048 + (u.pn - 16) * BM + bj * HALF + wc * 32 + 8 * fq; }
            const int rpitch = u.pn < 8 ? 128 : (u.pn < 16 ? 256 : 2048);
#pragma unroll
            for (int ai = 0; ai < 2; ++ai) { float rs4[4];
#pragma unroll
                for (int m = 0; m < 4; ++m) rs4[m] = FOLD ? F.rstd()[u.pm * BM + rr0 + ai * HALF + m * 16] : 1.0f;
#pragma unroll
                for (int m = 0; m < 4; ++m) { const int rr = rr0 + ai * HALF + m * 16; const float rs = rs4[m];
#pragma unroll
                    for (int bj = 0; bj < 2; ++bj) { f32x4 v0 = acc[ai][bj][m][0], v1 = acc[ai][bj][m][1]; if (FOLD) { v0 = v0 * rs + bv[bj][0]; v1 = v1 * rs + bv[bj][1]; }
                        u32x4 w; w.x = cvt_pk_bf16(v0[0], v0[1]); w.y = cvt_pk_bf16(v0[2], v0[3]); w.z = cvt_pk_bf16(v1[0], v1[1]); w.w = cvt_pk_bf16(v1[2], v1[3]);
                        *(u32x4*)(pb[bj] + (size_t)rr * rpitch) = w; } } }
        } else if (wc == 0) {
            float rsv[2][4]; if (FOLD) F.rows8(row0, rsv);
            const f32x4 b0 = *(const f32x4*)(bgate + 8 * fq) + bv[0][0], b1 = *(const f32x4*)(bgate + 8 * fq + 4) + bv[0][1];
#pragma unroll
            for (int ai = 0; ai < 2; ++ai)
#pragma unroll
                for (int m = 0; m < 4; ++m) { const int r = row0 + ai * HALF + m * 16; float* rowp = G + (size_t)r * 32 + 8 * fq; const float rs = FOLD ? rsv[ai][m] : 1.0f;
                    *(f32x4*)rowp = acc[ai][0][m][0] * rs + b0; *(f32x4*)(rowp + 4) = acc[ai][0][m][1] * rs + b1; }
        }
    }
};
template <bool FOLD> struct EpiConvInT {
    static constexpr bool PERM = true, AFTER_DRAIN = false; static constexpr int NSTORE = 8;
    bf16_t* BG; bf16_t* Z; Fold F;
    __device__ __forceinline__ void operator()(const f32x4 (&acc)[2][2][4][2], const Unit& u, int wr, int wc, int fr, int fq) const {
        const int row0 = u.pm * BM + wr * 64 + fr;
        f32x4 bv[2][2];
#pragma unroll
        for (int bj = 0; bj < 2; ++bj)
#pragma unroll
            for (int n = 0; n < 2; ++n) bv[bj][n] = (f32x4){0.f, 0.f, 0.f, 0.f};
        if (FOLD) { const int bidx = (u.pm * BM >= MX) ? 5 : (u.pm >> 4); const float* bp = F.bias(bidx) + u.pn * BM + wc * 32 + 8 * fq;
#pragma unroll
            for (int bj = 0; bj < 2; ++bj)
#pragma unroll
                for (int n = 0; n < 2; ++n) bv[bj][n] = *(const f32x4*)(bp + bj * HALF + 4 * n); }
        float rsv[2][4]; if (FOLD) F.rows8(row0, rsv);
        if (u.pn < 8) {
            const int col0 = u.pn * BM + wc * 32 + 8 * fq;
#pragma unroll
            for (int ai = 0; ai < 2; ++ai)
#pragma unroll
                for (int m = 0; m < 4; ++m) { const int r = row0 + ai * HALF + m * 16; bf16_t* rowp = BG + (size_t)r * 2048 + col0; const float rs = FOLD ? rsv[ai][m] : 1.0f;
#pragma unroll
                    for (int bj = 0; bj < 2; ++bj) { f32x4 v0 = acc[ai][bj][m][0], v1 = acc[ai][bj][m][1]; if (FOLD) { v0 = v0 * rs + bv[bj][0]; v1 = v1 * rs + bv[bj][1]; }
                        u32x4 w; w.x = cvt_pk_bf16(v0[0], v0[1]); w.y = cvt_pk_bf16(v0[2], v0[3]); w.z = cvt_pk_bf16(v1[0], v1[1]); w.w = cvt_pk_bf16(v1[2], v1[3]);
                        *(u32x4*)(rowp + bj * HALF) = w; } }
        } else {
            const int col0 = (u.pn - 8) * HALF + wc * 32 + 8 * fq;
#pragma unroll
            for (int ai = 0; ai < 2; ++ai)
#pragma unroll
                for (int m = 0; m < 4; ++m) { const int r = row0 + ai * HALF + m * 16; bf16_t* rowp = Z + (size_t)r * 2048 + col0; const float rs = FOLD ? rsv[ai][m] : 1.0f;
                    f32x4 c0 = acc[ai][0][m][0], c1 = acc[ai][0][m][1], u0 = acc[ai][1][m][0], u1 = acc[ai][1][m][1];
                    if (FOLD) { c0 = c0 * rs + bv[0][0]; c1 = c1 * rs + bv[0][1]; u0 = u0 * rs + bv[1][0]; u1 = u1 * rs + bv[1][1]; }
                    const f32x4 v0 = c0 * u0, v1 = c1 * u1;
                    u32x4 w; w.x = cvt_pk_bf16(v0[0], v0[1]); w.y = cvt_pk_bf16(v0[2], v0[3]); w.z = cvt_pk_bf16(v1[0], v1[1]); w.w = cvt_pk_bf16(v1[2], v1[3]);
                    *(u32x4*)rowp = w; }
        }
    }
};

template <class Epi, class Sched, bool ALIGN_EPI = false, bool SP2 = false, bool TILED = false>
__device__ __forceinline__ void gemm_phase(PG8_LAS unsigned char* lds, const Gemm g, const Sched& S, const Epi& E) {
    const int tid = threadIdx.x, wid = __builtin_amdgcn_readfirstlane(tid >> 6), lane = tid & 63, wr = wid >> 2, wc = wid & 3, fr = lane & 15, fq = lane >> 4;
    const int K = g.K;
    unsigned voffA[2], voffB[2];
#pragma unroll
    for (int i = 0; i < 2; ++i) { int R, C; stage_rc(tid * 16 + i * 8192, R, C); const int Rb = Epi::PERM ? ((R & ~31) + perm32(R & 31)) : R;
        const int KP = TILED ? BK : K; voffA[i] = (unsigned)(R * KP + C) * 2u; voffB[i] = (unsigned)(Rb * KP + C) * 2u; }
    const size_t kstep = TILED ? (size_t)(BM * BK * 2) : (size_t)(BK * 2);
    const size_t hstep = TILED ? (size_t)(HALF * BK * 2) : (size_t)HALF * K * 2;
    const size_t tstep = TILED ? (size_t)(K / BK) * (BM * BK * 2) : 2 * hstep;
#define PG8_K0OFF(k0) (TILED ? (size_t)((k0) / BK) * (BM * BK * 2) : (size_t)(k0) * 2)
    const unsigned ldsw = (unsigned)wid * 1024u;
    const int aoff = lds_byte(wr * 64 + fr, fq * 8), boff = lds_byte(wc * 32 + fr, fq * 8);
#define PG8_SA(b, h) (((b) * 2 + (h)) * HTB)
#define PG8_SB(b, h) ((4 + (b) * 2 + (h)) * HTB)
#define PG8_STAGE(bufoff, gbase, voff) do { _Pragma("unroll") for (int _i = 0; _i < 2; ++_i) \
        __builtin_amdgcn_global_load_lds((const unsigned*)((const char*)(gbase) + (voff)[_i]), (PG8_LAS unsigned*)(lds + (bufoff) + ldsw + _i * 8192), 16, 0, 0); } while (0)
#define PG8_LDA(dst, b, h) do { _Pragma("unroll") for (int m = 0; m < 4; ++m) _Pragma("unroll") for (int k = 0; k < 2; ++k) dst[m][k] = *(const PG8_LAS bf16x8*)(lds + PG8_SA(b, h) + aoff + m * 2048 + k * 1024); } while (0)
#define PG8_LDB(dst, b, h) do { _Pragma("unroll") for (int n = 0; n < 2; ++n) _Pragma("unroll") for (int k = 0; k < 2; ++k) dst[n][k] = *(const PG8_LAS bf16x8*)(lds + PG8_SB(b, h) + boff + n * 2048 + k * 1024); } while (0)
#define PG8_MMA(ai, bj, At, Bt) do { __builtin_amdgcn_s_setprio(1); _Pragma("unroll") for (int m = 0; m < 4; ++m) _Pragma("unroll") for (int n = 0; n < 2; ++n) _Pragma("unroll") for (int k = 0; k < 2; ++k) \
        acc[ai][bj][m][n] = __builtin_amdgcn_mfma_f32_16x16x32_bf16(Bt[n][k], At[m][k], acc[ai][bj][m][n], 0, 0, 0); __builtin_amdgcn_s_setprio(0); } while (0)
#define PG8_WAIT_V(n) asm volatile("s_waitcnt vmcnt(" #n ")" ::: "memory")
#define PG8_WAIT_L(n) asm volatile("s_waitcnt lgkmcnt(" #n ")" ::: "memory")
#define PG8_WAIT_VR do { if constexpr (Epi::NSTORE == 8) PG8_WAIT_V(16); else if constexpr (Epi::NSTORE == 16) PG8_WAIT_V(24); else if constexpr (Epi::NSTORE == 32) PG8_WAIT_V(40); else PG8_WAIT_V(8); } while (0)
#define PG8_BAR __builtin_amdgcn_s_barrier()
#define PG8_SCHED __builtin_amdgcn_sched_barrier(0)
    Unit cur, nxt; int ui = 0;
    if (!S.next(0, cur)) return;
    f32x4 acc[2][2][4][2];
#pragma unroll
    for (int a = 0; a < 2; ++a)
#pragma unroll
        for (int b = 0; b < 2; ++b)
#pragma unroll
            for (int m = 0; m < 4; ++m)
#pragma unroll
                for (int n = 0; n < 2; ++n) acc[a][b][m][n] = (f32x4){0.f, 0.f, 0.f, 0.f};
    bf16x8 At[4][2], B0[2][2], B1[2][2];
    const char* cA = (const char*)g.A + (size_t)cur.pm * tstep + PG8_K0OFF(cur.k0); const char* cB = (const char*)g.Bt + (size_t)cur.pn * tstep + PG8_K0OFF(cur.k0);
    S.a_ready(cur);
    if constexpr (SP2) {
        PG8_STAGE(PG8_SB(0, 0), cB, voffB); PG8_STAGE(PG8_SB(0, 1), cB + hstep, voffB); PG8_STAGE(PG8_SA(0, 0), cA, voffA); PG8_STAGE(PG8_SA(0, 1), cA + hstep, voffA);
        if (wr == 1) PG8_BAR;
        PG8_WAIT_V(2); PG8_BAR;
        PG8_STAGE(PG8_SB(1, 0), cB + kstep, voffB); PG8_STAGE(PG8_SA(1, 0), cA + kstep, voffA); PG8_STAGE(PG8_SB(1, 1), cB + hstep + kstep, voffB);
        PG8_WAIT_V(6); PG8_BAR;
    } else {
        PG8_STAGE(PG8_SB(0, 0), cB, voffB); PG8_STAGE(PG8_SA(0, 0), cA, voffA); PG8_STAGE(PG8_SB(0, 1), cB + hstep, voffB); PG8_STAGE(PG8_SA(0, 1), cA + hstep, voffA);
        if (wr == 1) PG8_BAR;
        PG8_WAIT_V(4); PG8_BAR;
        PG8_STAGE(PG8_SB(1, 0), cB + kstep, voffB); PG8_STAGE(PG8_SA(1, 0), cA + kstep, voffA); PG8_STAGE(PG8_SB(1, 1), cB + hstep + kstep, voffB);
        PG8_WAIT_V(6); PG8_BAR;
    }
    for (;;) {
        const bool has_next = S.next(ui + 1, nxt);
        const char* nA = has_next ? (const char*)g.A + (size_t)nxt.pm * tstep + PG8_K0OFF(nxt.k0) : cA; const char* nB = has_next ? (const char*)g.Bt + (size_t)nxt.pn * tstep + PG8_K0OFF(nxt.k0) : cB;
        const int nt = cur.nt;
        static_assert(SP2, "this build keeps only the two-super-phase K-loop");
        for (int t = 0; t < nt; t += 2) {
            const bool last = (t == nt - 2);
            const char* a1 = cA + (size_t)(t + 1) * kstep;
            const char* a2 = last ? nA : cA + (size_t)(t + 2) * kstep; const char* b2 = last ? nB : cB + (size_t)(t + 2) * kstep;
            const char* a3 = a2 + kstep; const char* b3 = b2 + kstep;
            if (last && has_next) S.a_ready(nxt);
            const unsigned relax = (unsigned)__builtin_amdgcn_readfirstlane((Epi::NSTORE > 0 && t == 0 && ui > 0) ? 1 : 0);
#define PG8_WAIT_V8R do { if constexpr (Epi::NSTORE == 8) asm volatile("s_cmp_lg_u32 %0, 0\n\ts_cbranch_scc1 .Lpg8r%=\n\ts_waitcnt vmcnt(8)\n.Lpg8r%=:\n\ts_waitcnt vmcnt(16)" :: "s"(relax) : "memory", "scc"); \
        else if constexpr (Epi::NSTORE == 16) asm volatile("s_cmp_lg_u32 %0, 0\n\ts_cbranch_scc1 .Lpg8r%=\n\ts_waitcnt vmcnt(8)\n.Lpg8r%=:\n\ts_waitcnt vmcnt(24)" :: "s"(relax) : "memory", "scc"); \
        else if constexpr (Epi::NSTORE == 32) asm volatile("s_cmp_lg_u32 %0, 0\n\ts_cbranch_scc1 .Lpg8r%=\n\ts_waitcnt vmcnt(8)\n.Lpg8r%=:\n\ts_waitcnt vmcnt(40)" :: "s"(relax) : "memory", "scc"); \
        else PG8_WAIT_V(8); } while (0)
            PG8_LDB(B0, 0, 0); PG8_LDB(B1, 0, 1); PG8_SCHED; PG8_LDA(At, 0, 0); PG8_STAGE(PG8_SA(1, 1), a1 + hstep, voffA);
            PG8_WAIT_V8R; PG8_WAIT_L(0); PG8_BAR; PG8_MMA(0, 0, At, B0); PG8_MMA(0, 1, At, B1); PG8_BAR; PG8_SCHED;
            PG8_LDA(At, 0, 1); PG8_STAGE(PG8_SB(0, 0), b2, voffB); PG8_STAGE(PG8_SB(0, 1), b2 + hstep, voffB); PG8_STAGE(PG8_SA(0, 0), a2, voffA);
            PG8_WAIT_V8R; PG8_WAIT_L(0); PG8_BAR; PG8_MMA(1, 0, At, B0); PG8_MMA(1, 1, At, B1); PG8_BAR; PG8_SCHED;
            PG8_LDB(B0, 1, 0); PG8_LDB(B1, 1, 1); PG8_SCHED; PG8_LDA(At, 1, 0); PG8_STAGE(PG8_SA(0, 1), a2 + hstep, voffA);
            PG8_WAIT_V8R; PG8_WAIT_L(0); PG8_BAR; PG8_MMA(0, 0, At, B0); PG8_MMA(0, 1, At, B1); PG8_BAR; PG8_SCHED;
            PG8_LDA(At, 1, 1); PG8_STAGE(PG8_SB(1, 0), b3, voffB); PG8_STAGE(PG8_SB(1, 1), b3 + hstep, voffB); PG8_STAGE(PG8_SA(1, 0), a3, voffA);
            PG8_WAIT_V(8); PG8_WAIT_L(0); PG8_BAR; PG8_MMA(1, 0, At, B0); PG8_MMA(1, 1, At, B1); PG8_BAR; PG8_SCHED;
#undef PG8_WAIT_V8R
        }
        if constexpr (SP2 && Epi::NSTORE > 0) { if (has_next) { PG8_STAGE(PG8_SA(1, 1), nA + kstep + hstep, voffA); asm volatile("" ::: "memory"); } }
        if constexpr (ALIGN_EPI) { if (wr == 0) PG8_BAR; }
        if constexpr (!Epi::AFTER_DRAIN) { E(acc, cur, wr, wc, fr, fq); S.done(cur); }
        if (!has_next) break;
#pragma unroll
        for (int a = 0; a < 2; ++a)
#pragma unroll
            for (int b = 0; b < 2; ++b)
#pragma unroll
                for (int m = 0; m < 4; ++m)
#pragma unroll
                    for (int n = 0; n < 2; ++n) acc[a][b][m][n] = (f32x4){0.f, 0.f, 0.f, 0.f};
        cur = nxt; cA = nA; cB = nB; ++ui;
        if constexpr (ALIGN_EPI) { if (wr == 1) PG8_BAR; }
    }
    PG8_WAIT_V(0);
    if constexpr (!ALIGN_EPI) { if (wr == 0) PG8_BAR; }
    PG8_BAR;
#undef PG8_K0OFF
#undef PG8_SA
#undef PG8_SB
#undef PG8_STAGE
#undef PG8_LDA
#undef PG8_LDB
#undef PG8_MMA
#undef PG8_WAIT_V
#undef PG8_WAIT_L
#undef PG8_WAIT_VR
#undef PG8_BAR
#undef PG8_SCHED
}
}

constexpr int RING_BYTES = 131072;
constexpr int SCR_BYTES = 8 * 64 * 65 * 4;
constexpr int LDSCTL_OFF = 159744, LDS_BYTES = 163840;

#define GAS __attribute__((address_space(1)))
#define LAS __attribute__((address_space(3)))
typedef unsigned short bf16;
typedef unsigned v4u __attribute__((ext_vector_type(4)));
typedef unsigned v2u __attribute__((ext_vector_type(2)));
typedef float f32x4 __attribute__((ext_vector_type(4)));
typedef short bf16x8 __attribute__((ext_vector_type(8)));
typedef short s16x4 __attribute__((ext_vector_type(4)));
#define LDS_WAIT() asm volatile("s_waitcnt lgkmcnt(0)" ::: "memory")
__device__ __forceinline__ unsigned f2bf(float f) { unsigned u = __builtin_bit_cast(unsigned, f); return (u + 0x7fffu + ((u >> 16) & 1u)) >> 16; }
__device__ __forceinline__ unsigned pk2(float lo, float hi) { return pg8::cvt_pk_bf16(lo, hi); }
__device__ __forceinline__ float bflo(unsigned w) { return __builtin_bit_cast(float, w << 16); }
__device__ __forceinline__ float bfhi(unsigned w) { return __builtin_bit_cast(float, w & 0xffff0000u); }

#define XB_TMO      128
#define XB_XCNT(j)  (256  + 64 * (j))
#define XB_XSUB(j)  (1280 + 64 * (j))
#define XB_XGEN(j)  (2304 + 64 * (j))
#define XB_TOP      3328
#define XB_TOPGEN   3392
#define XCD_BAR_WORDS 3456
#define XB_SPIN_CAP (1u << 18)
__device__ __forceinline__ unsigned xb_ld(unsigned* p)              { return __hip_atomic_load(p, __ATOMIC_RELAXED, __HIP_MEMORY_SCOPE_AGENT); }
__device__ __forceinline__ unsigned xb_add(unsigned* p, unsigned v) { return __hip_atomic_fetch_add(p, v, __ATOMIC_RELAXED, __HIP_MEMORY_SCOPE_AGENT); }
__device__ __forceinline__ unsigned xb_xcc_id() { return (unsigned)__builtin_amdgcn_s_getreg((3 << 11) | 20) & 0xFu; }
#define XB_SPIN(cond, bar) do { unsigned _sp = 0; while (cond) { __builtin_amdgcn_s_sleep(1); \
    if ((++_sp & 255u) == 0u) { if (xb_ld(&(bar)[XB_TMO])) break; if (_sp > XB_SPIN_CAP) { atomicAdd(&(bar)[XB_TMO], 1u); break; } } } } while (0)
struct XcdBarrier { unsigned* bar; unsigned x; volatile LAS unsigned* st; };
__device__ __forceinline__ XcdBarrier xcd_barrier_post(unsigned* bar, volatile LAS unsigned* st) {
    XcdBarrier b; b.bar = bar; b.x = xb_xcc_id(); b.st = st;
    if (threadIdx.x == 0) (void)xb_add(&bar[XB_XCNT(b.x)], 1u);
    return b;
}
__device__ __forceinline__ void xcd_barrier_complete(unsigned* bar, unsigned x, unsigned& nloc, unsigned& nx) {
    const unsigned G = gridDim.x * gridDim.y * gridDim.z;
    unsigned sum, cnt, mine, sp = 0u;
    for (;;) {
        sum = 0u; cnt = 0u; mine = 0u;
#pragma unroll
        for (unsigned j = 0; j < 16; ++j) { const unsigned c = xb_ld(&bar[XB_XCNT(j)]); sum += c; cnt += (c > 0u) ? 1u : 0u; mine = (j == x) ? c : mine; }
        if (sum == G) break;
        __builtin_amdgcn_s_sleep(1);
        if ((++sp & 255u) == 0u) { if (xb_ld(&bar[XB_TMO])) break; if (sp > XB_SPIN_CAP) { atomicAdd(&bar[XB_TMO], 1u); break; } }
    }
    nloc = mine > 0u ? mine : 1u; nx = cnt > 0u ? cnt : 1u;
}
__device__ __forceinline__ void xcd_barrier(const XcdBarrier& b) {
    asm volatile("s_waitcnt vmcnt(0)" ::: "memory");
    __syncthreads();
    if (threadIdx.x == 0) {
        unsigned* bar = b.bar;
        __builtin_amdgcn_s_waitcnt(0);
        unsigned nloc = b.st[0], nx = b.st[1];
        if (nloc == 0u) { xcd_barrier_complete(bar, b.x, nloc, nx); b.st[0] = nloc; b.st[1] = nx; }
        const unsigned old = xb_add(&bar[XB_XSUB(b.x)], 1u);
        const unsigned gen = old / nloc;
        if (old + 1u == (gen + 1u) * nloc) {
            __builtin_amdgcn_fence(__ATOMIC_RELEASE, "agent");
            asm volatile("s_waitcnt vmcnt(0)" ::: "memory");
            const unsigned og = xb_add(&bar[XB_TOP], 1u);
            const unsigned tg = og / nx;
            if (og + 1u == (tg + 1u) * nx) xb_add(&bar[XB_TOPGEN], 1u);
            else XB_SPIN(xb_ld(&bar[XB_TOPGEN]) == tg, bar);
            __builtin_amdgcn_fence(__ATOMIC_ACQUIRE, "agent");
            xb_add(&bar[XB_XGEN(b.x)], 1u);
            asm volatile("s_waitcnt vmcnt(0)" ::: "memory");
        } else {
            XB_SPIN(xb_ld(&bar[XB_XGEN(b.x)]) == gen, bar);
            __builtin_amdgcn_fence(__ATOMIC_ACQUIRE, "agent");
            asm volatile("s_waitcnt vmcnt(0)" ::: "memory");
        }
    }
    __syncthreads();
}

__device__ __forceinline__ float wave_sum(float v) {
#pragma unroll
    for (int o = 1; o < 64; o <<= 1) v += __shfl_xor(v, o);
    return v;
}
template <int MAPK> __device__ __forceinline__ int wmap(int n) {
    if (MAPK == 1) { const int pn = n >> 8, r = n & 255; return ((r < 128) ? 0 : DFF) + 128 * pn + (r & 127); }
    if (MAPK == 2) { return n < 4096 ? n : (n < 6144 ? n + 32 : (n < 6176 ? n - 2048 : -1)); }
    if (MAPK == 3) { if (n < 2048) return n; const int q = n - 2048, pn = q >> 8, r = q & 255; return ((r < 128) ? 2048 : 4096) + 128 * pn + (r & 127); }
    return n;
}
template <int MAPK, bool BIAS = false> __device__ __forceinline__ void transpose_item(const float* W, int K, int Nsrc, bf16* WT, int nblk, LAS float* scr, int item, int lane, const float* shift = nullptr, float* biasp = nullptr) {
    const int kb = item / nblk, nb = item - kb * nblk, k0 = 64 * kb, n0 = 64 * nb;
    const int n = n0 + lane, sc = wmap<MAPK>(n);
    const float scale = (MAPK == 2 && n < 1024) ? 0.08838834764831845f : 1.0f;
    const float* src = W + (size_t)k0 * Nsrc + (sc >= 0 ? sc : 0);
#pragma unroll
    for (int hb = 0; hb < 2; ++hb) { float v[32];
#pragma unroll
        for (int i = 0; i < 32; ++i) v[i] = src[(size_t)(32 * hb + i) * Nsrc];
#pragma unroll
        for (int i = 0; i < 32; ++i) scr[(32 * hb + i) * 65 + lane] = (sc >= 0) ? v[i] * scale : 0.f; }
    LDS_WAIT(); asm volatile("" ::: "memory");
    if (BIAS) {
        const int fn = lane & 15, fk = lane >> 4;
        bf16x8 Af[2];
#pragma unroll
        for (int ks = 0; ks < 2; ++ks) { f32x4 s0 = (f32x4){0.f, 0.f, 0.f, 0.f}, s1 = s0; if (fn < 5) { const float* sp = shift + (size_t)fn * MODW + k0 + 32 * ks + 8 * fk; s0 = *(const f32x4*)sp; s1 = *(const f32x4*)(sp + 4); }
            const v4u w = (v4u){pk2(s0[0], s0[1]), pk2(s0[2], s0[3]), pk2(s1[0], s1[1]), pk2(s1[2], s1[3])}; Af[ks] = __builtin_bit_cast(bf16x8, w); }
#pragma unroll
        for (int nt = 0; nt < 4; ++nt) { f32x4 bacc = (f32x4){0.f, 0.f, 0.f, 0.f};
#pragma unroll
            for (int ks = 0; ks < 2; ++ks) { const LAS float* sp = scr + (32 * ks + 8 * fk) * 65 + 16 * nt + fn;
                const v4u o = (v4u){pk2(sp[0 * 65], sp[1 * 65]), pk2(sp[2 * 65], sp[3 * 65]), pk2(sp[4 * 65], sp[5 * 65]), pk2(sp[6 * 65], sp[7 * 65])};
                *(GAS v4u*)(WT + (size_t)(n0 + 16 * nt + fn) * K + k0 + 32 * ks + 8 * fk) = o;
                bacc = __builtin_amdgcn_mfma_f32_16x16x32_bf16(Af[ks], __builtin_bit_cast(bf16x8, o), bacc, 0, 0, 0); }
            float* bo = biasp + (size_t)kb * 5 * NBCOL + n0 + 16 * nt + fn;
            if (fk == 0) { bo[0] = bacc[0]; bo[NBCOL] = bacc[1]; bo[2 * (size_t)NBCOL] = bacc[2]; bo[3 * (size_t)NBCOL] = bacc[3]; } else if (fk == 1) bo[4 * (size_t)NBCOL] = bacc[0]; }
    } else {
    const int c = lane & 7;
#pragma unroll
    for (int j = 0; j < 8; ++j) { const int nn = (lane >> 3) + 8 * j; const LAS float* s = scr + (8 * c) * 65 + nn;
        v4u o; o.x = pk2(s[0 * 65], s[1 * 65]); o.y = pk2(s[2 * 65], s[3 * 65]); o.z = pk2(s[4 * 65], s[5 * 65]); o.w = pk2(s[6 * 65], s[7 * 65]);
        *(GAS v4u*)(WT + (size_t)(n0 + nn) * K + k0 + 8 * c) = o; }
    }
    LDS_WAIT(); asm volatile("" ::: "memory");
}

constexpr int TI2_STR = 272, TI2_BYTES = 64 * TI2_STR;
__device__ __forceinline__ bf16x8 tr_frag_g(LAS unsigned char* p0, LAS unsigned char* p1) {
    const s16x4 a = __builtin_amdgcn_ds_read_tr16_b64_v4i16((LAS s16x4*)p0), b = __builtin_amdgcn_ds_read_tr16_b64_v4i16((LAS s16x4*)p1);
    return (bf16x8){a[0], a[1], a[2], a[3], b[0], b[1], b[2], b[3]};
}
template <int MAPK, bool BIAS, bool TILEDW = false> __device__ __forceinline__ void transpose_item2(const float* W, int K, int Nsrc, bf16* WT, int nblk, LAS unsigned char* tile, int item, int lane, const float* shift = nullptr, float* biasp = nullptr) {
    typedef float f32x2v __attribute__((ext_vector_type(2)));
    const int kb = item / nblk, nb = item - kb * nblk, k0 = 64 * kb, n0 = 128 * nb;
    const int n = n0 + 2 * lane, sc = wmap<MAPK>(n);
    const float scale = (MAPK == 2 && n < 1024) ? 0.08838834764831845f : 1.0f;
    const float* src = W + (size_t)k0 * Nsrc + (sc >= 0 ? sc : 0);
#pragma unroll
    for (int hb = 0; hb < 2; ++hb) { f32x2v v[32];
#pragma unroll
        for (int i = 0; i < 32; ++i) v[i] = __builtin_nontemporal_load((const f32x2v*)(src + (size_t)(32 * hb + i) * Nsrc));
#pragma unroll
        for (int i = 0; i < 32; ++i) *(LAS unsigned*)(tile + (32 * hb + i) * TI2_STR + 4 * lane) = (sc >= 0) ? pk2(v[i][0] * scale, v[i][1] * scale) : 0u; }
    LDS_WAIT(); asm volatile("" ::: "memory");
    const int fn = lane & 15, fk = lane >> 4, tq = (lane & 15) >> 2, tp = lane & 3;
    bf16x8 Af[2];
    if (BIAS) {
#pragma unroll
        for (int ks = 0; ks < 2; ++ks) { f32x4 s0 = (f32x4){0.f, 0.f, 0.f, 0.f}, s1 = s0; if (fn < 5) { const float* sp = shift + (size_t)fn * MODW + k0 + 32 * ks + 8 * fk; s0 = *(const f32x4*)sp; s1 = *(const f32x4*)(sp + 4); }
            const v4u w = (v4u){pk2(s0[0], s0[1]), pk2(s0[2], s0[3]), pk2(s1[0], s1[1]), pk2(s1[2], s1[3])}; Af[ks] = __builtin_bit_cast(bf16x8, w); } }
#pragma unroll
    for (int nt = 0; nt < 8; ++nt) { f32x4 bacc = (f32x4){0.f, 0.f, 0.f, 0.f};
#pragma unroll
        for (int ks = 0; ks < 2; ++ks) { LAS unsigned char* p = tile + (32 * ks + 8 * fk + tq) * TI2_STR + (16 * nt + 4 * tp) * 2; const bf16x8 fr = tr_frag_g(p, p + 4 * TI2_STR);
            { const int nn = n0 + 16 * nt + fn; const size_t doff = TILEDW ? ((((size_t)(nn >> 8) * (K / 64) + kb) * 256 + (nn & 255)) * 64 + 32 * ks + 8 * fk) : ((size_t)nn * K + k0 + 32 * ks + 8 * fk);
              *(GAS bf16x8*)(WT + doff) = fr; }
            if (BIAS) bacc = __builtin_amdgcn_mfma_f32_16x16x32_bf16(Af[ks], fr, bacc, 0, 0, 0); }
        if (BIAS) { float* bo = biasp + (size_t)kb * 5 * NBCOL + n0 + 16 * nt + fn;
            if (fk == 0) { bo[0] = bacc[0]; bo[NBCOL] = bacc[1]; bo[2 * (size_t)NBCOL] = bacc[2]; bo[3 * (size_t)NBCOL] = bacc[3]; } else if (fk == 1) bo[4 * (size_t)NBCOL] = bacc[0]; } }
    LDS_WAIT(); asm volatile("" ::: "memory");
}

struct KArgs { const float* in[17]; float* out; unsigned char* ws; int ph_lo, ph_hi; };

__device__ __forceinline__ void normmod_phase(const float* xx, const float* xc, int rows, const float* ng, const float* modl, int j, bf16* HB, int gw, int NGW, int lane, const float* ctxP = nullptr, const float* cgate = nullptr, int first_row = 0) {
    for (int r = first_row + gw; r < rows; r += NGW) {
        const bool isc = r >= MX; const int b = isc ? 4 : (r >> 12);
        const float* src = isc ? xc + (size_t)(r - MX) * D : xx + (size_t)r * D;
        const float* shift = modl + (size_t)b * MODW + (3 * j) * D; const float* scale = shift + D;
        f32x4 v[8]; float ss = 0.f;
#pragma unroll
        for (int q = 0; q < 8; ++q) v[q] = __builtin_nontemporal_load((const f32x4*)(src + 4 * (lane + 64 * q)));
        if (ctxP && isc) {
#pragma unroll
            for (int q0 = 0; q0 < 8; q0 += 4) { f32x4 pp[4][8];
#pragma unroll
                for (int j = 0; j < 4; ++j)
#pragma unroll
                    for (int sl = 0; sl < 8; ++sl) pp[j][sl] = *(const f32x4*)(ctxP + ((size_t)sl * MC + (r - MX)) * D + 4 * (lane + 64 * (q0 + j)));
#pragma unroll
                for (int j = 0; j < 4; ++j) { const int c = 4 * (lane + 64 * (q0 + j)); f32x4 p = pp[j][0];
#pragma unroll
                    for (int sl = 1; sl < 8; ++sl) p += pp[j][sl];
                    v[q0 + j] += p * (*(const f32x4*)(cgate + c)) * 0.5f; } } }
#pragma unroll
        for (int q = 0; q < 8; ++q) ss += (v[q][0] * v[q][0] + v[q][1] * v[q][1]) + (v[q][2] * v[q][2] + v[q][3] * v[q][3]);
        const float rstd = 1.0f / sqrtf(wave_sum(ss) * (1.0f / D) + RMS_EPS);
#pragma unroll
        for (int q = 0; q < 8; ++q) { const int c = 4 * (lane + 64 * q);
            const f32x4 g4 = *(const f32x4*)(ng + c), s4 = *(const f32x4*)(scale + c), h4 = *(const f32x4*)(shift + c);
            const f32x4 y = v[q] * rstd * g4 * (s4 + 1.0f) + h4;
            v2u o; o.x = pk2(y[0], y[1]); o.y = pk2(y[2], y[3]); *(v2u*)(HB + hb_off(r, c)) = o; }
    }
}
__device__ __forceinline__ void final_norm_phase(const bf16* XS, const float* SS, float* out, int gw, int NGW, int lane) {
    for (int r = gw; r < MX; r += NGW) {
        float t = lane < 32 ? SS[(size_t)r * 32 + lane] : 0.f;
        t = wave_sum(t);
        const float rstd = 1.0f / sqrtf(t * (1.0f / D) + RMS_EPS);
        float* orow = out + (size_t)r * D;
#pragma unroll
        for (int q = 0; q < 4; ++q) { const int c = 8 * (lane + 64 * q); const v4u w = __builtin_nontemporal_load((const v4u*)(XS + hb_off(r, c)));
            __builtin_nontemporal_store((f32x4){bflo(w.x), bfhi(w.x), bflo(w.y), bfhi(w.y)} * rstd, (f32x4*)(orow + c)); __builtin_nontemporal_store((f32x4){bflo(w.z), bfhi(w.z), bflo(w.w), bfhi(w.w)} * rstd, (f32x4*)(orow + c + 4)); }
    }
}
__device__ __forceinline__ void unpack8(const v4u w, float (&f)[8]) { f[0] = bflo(w.x); f[1] = bfhi(w.x); f[2] = bflo(w.y); f[3] = bfhi(w.y); f[4] = bflo(w.z); f[5] = bfhi(w.z); f[6] = bflo(w.w); f[7] = bfhi(w.w); }
__device__ __forceinline__ void headnorm_phase(const bf16* HF, const bf16* HBW, const bf16* QKVO, const float* ng, bf16* Y, int gw, int NGW, int lane) {
    for (int r = gw; r < MX; r += NGW) {
#pragma unroll
        for (int q = 0; q < 4; ++q) { const int c = 8 * (lane + 64 * q);
            const v4u a = __builtin_nontemporal_load((const v4u*)(HF + (size_t)r * D + c)), b = __builtin_nontemporal_load((const v4u*)(HBW + (size_t)r * D + c)), o = __builtin_nontemporal_load((const v4u*)(QKVO + OG_OFF + (size_t)r * 2048 + c));
            float fa[8], fb[8], fo[8]; unpack8(a, fa); unpack8(b, fb); unpack8(o, fo);
            float s[8], ss = 0.f;
#pragma unroll
            for (int i = 0; i < 8; ++i) { s[i] = fa[i] + fb[i]; ss += s[i] * s[i]; }
#pragma unroll
            for (int of = 1; of < 32; of <<= 1) ss += __shfl_xor(ss, of);
            const float rstd = 1.0f / sqrtf(ss * (1.0f / DVH) + RMS_EPS);
            const f32x4 g0 = *(const f32x4*)(ng + c), g1 = *(const f32x4*)(ng + c + 4);
            float y[8];
#pragma unroll
            for (int i = 0; i < 8; ++i) { const float g = i < 4 ? g0[i] : g1[i - 4]; y[i] = s[i] * rstd * g * __builtin_amdgcn_rcpf(1.0f + __builtin_amdgcn_exp2f(-1.44269504f * fo[i])); }
            v4u w; w.x = pk2(y[0], y[1]); w.y = pk2(y[2], y[3]); w.z = pk2(y[4], y[5]); w.w = pk2(y[6], y[7]);
            *(v4u*)(Y + hb_off(r, c)) = w; }
    }
}
__device__ __forceinline__ void convmix_phase(const bf16* BG, const bf16* Z, const float* cw, bf16* Y, int gw, int NGW, int lane) {
    for (int r = gw; r < MX; r += NGW) { const int t = r & 63;
#pragma unroll
        for (int q = 0; q < 4; ++q) { const int c = 8 * (lane + 64 * q);
            const v4u zero = (v4u){0u, 0u, 0u, 0u};
            const v4u zc = *(const v4u*)(Z + (size_t)r * D + c), zp = t > 0 ? *(const v4u*)(Z + (size_t)(r - 1) * D + c) : zero, zn = t < 63 ? *(const v4u*)(Z + (size_t)(r + 1) * D + c) : zero;
            const v4u bg = __builtin_nontemporal_load((const v4u*)(BG + (size_t)r * D + c));
            float fc[8], fp[8], fn[8], fb[8]; unpack8(zc, fc); unpack8(zp, fp); unpack8(zn, fn); unpack8(bg, fb);
            float y[8];
#pragma unroll
            for (int h = 0; h < 2; ++h) { const f32x4 w0 = *(const f32x4*)(cw + c + 4 * h), w1 = *(const f32x4*)(cw + D + c + 4 * h), w2 = *(const f32x4*)(cw + 2 * D + c + 4 * h);
#pragma unroll
                for (int i = 0; i < 4; ++i) y[4 * h + i] = fb[4 * h + i] * (w0[i] * fp[4 * h + i] + w1[i] * fc[4 * h + i] + w2[i] * fn[4 * h + i]); }
            v4u w; w.x = pk2(y[0], y[1]); w.y = pk2(y[2], y[3]); w.z = pk2(y[4], y[5]); w.w = pk2(y[6], y[7]);
            *(v4u*)(Y + hb_off(r, c)) = w; }
    }
}

__device__ __forceinline__ void mod_partials(const KArgs& a, int l, int wv, int nwv, int lane) {
    float* modp = (float*)(a.ws + WS_MODP);
    constexpr int NCG = MODW / 256, NKS = D / 64, NIT = NCG * NKS;
    for (int it = wv; it < NIT; it += nwv) {
        const int cg = it / NKS, ks = it - cg * NKS, k0 = 64 * ks, col = 256 * cg + 4 * lane;
        float sv[5];
#pragma unroll
        for (int b = 0; b < 5; ++b) { const float cv = (b < 4) ? a.in[1][b * D + k0 + lane] : a.in[3][k0 + lane]; sv[b] = pg8::silu_f(cv); }
        f32x4 acc[5];
#pragma unroll
        for (int b = 0; b < 5; ++b) acc[b] = (f32x4){0.f, 0.f, 0.f, 0.f};
        const float* wp = a.in[4] + ((size_t)l * D + k0) * MODW + col;
#pragma unroll 8
        for (int k = 0; k < 64; ++k) { const f32x4 w = __builtin_nontemporal_load((const f32x4*)(wp + (size_t)k * MODW));
#pragma unroll
            for (int b = 0; b < 5; ++b) { const float s = __builtin_bit_cast(float, __builtin_amdgcn_readlane(__builtin_bit_cast(int, sv[b]), k)); acc[b] += w * s; } }
#pragma unroll
        for (int b = 0; b < 5; ++b) *(f32x4*)(modp + (((size_t)ks * 2 + l) * 5 + b) * MODW + col) = acc[b];
    }
}
template <int LIST> __device__ __forceinline__ void convert_list(const KArgs& a, LAS unsigned char* lds, int wv, int nwv, int wave, int lane) {
    unsigned char* ws = a.ws;
    LAS unsigned char* scr = lds + wave * TI2_BYTES;
    const float* mod = (const float*)(ws + WS_MOD); float* bp = (float*)(ws + WS_BIASP);
    constexpr int I_FI = (D / 64) * (NFI / 128), I_FO = (DFF / 64) * (D / 128), I_MI = (D / 64) * (NML / 128), I_SQ = (D / 64) * (D / 128), I_CI = (D / 64) * (NCV / 128);
    if (LIST == 0) {
        for (int it = wv; it < I_FI + I_FO; it += nwv) { int r = it;
            if (r < I_FI) { transpose_item2<1, false, true>(a.in[7], D, NFI, (bf16*)(ws + WS_WFI), NFI / 128, scr, r, lane); continue; } r -= I_FI;
            transpose_item2<0, false, true>(a.in[8], DFF, D, (bf16*)(ws + WS_WFO), D / 128, scr, r, lane); }
    } else if (LIST == 1) {
        for (int it = wv; it < I_MI + I_SQ; it += nwv) { int r = it;
            if (r < I_MI) { transpose_item2<2, true, true>(a.in[9], D, NMLSRC, (bf16*)(ws + WS_WMI), NML / 128, scr, r, lane, mod + 3 * D, bp + BOFF_MI); continue; } r -= I_MI;
            transpose_item2<0, false, true>(a.in[12], D, D, (bf16*)(ws + WS_WMO), D / 128, scr, r, lane); }
    } else {
        for (int it = wv; it < 3 * I_FI + 3 * I_FO + I_CI + I_SQ; it += nwv) { int r = it;
            if (r < 3 * I_FI) { const int mi = 1 + r / I_FI; r -= (mi - 1) * I_FI;
                const float* sh = mi == 1 ? mod + 6 * D : (mi == 2 ? mod + (size_t)5 * MODW : mod + (size_t)5 * MODW + 6 * D); float* bq = bp + (mi == 1 ? BOFF_F1 : (mi == 2 ? BOFF_F2 : BOFF_F3));
                transpose_item2<1, true, true>(a.in[7] + (size_t)mi * D * NFI, D, NFI, (bf16*)(ws + WS_WFI) + (size_t)mi * NFI * D, NFI / 128, scr, r, lane, sh, bq); continue; } r -= 3 * I_FI;
            if (r < 3 * I_FO) { const int mi = 1 + r / I_FO; r -= (mi - 1) * I_FO; transpose_item2<0, false, true>(a.in[8] + (size_t)mi * DFF * D, DFF, D, (bf16*)(ws + WS_WFO) + (size_t)mi * D * DFF, D / 128, scr, r, lane); continue; } r -= 3 * I_FO;
            if (r < I_CI) { transpose_item2<3, true, true>(a.in[13], D, NCV, (bf16*)(ws + WS_WCI), NCV / 128, scr, r, lane, mod + (size_t)5 * MODW + 3 * D, bp + BOFF_CI); continue; } r -= I_CI;
            transpose_item2<0, false, true>(a.in[15], D, D, (bf16*)(ws + WS_WCO), D / 128, scr, r, lane); }
    }
}
__device__ __forceinline__ bool tail_rank(int nwg, int G, int bx, int& rank, int& cnt) { const int rem = nwg % G; if (rem == 0) { rank = bx; cnt = G; return true; } rank = bx - rem; cnt = G - rem; return bx >= rem; }

__device__ __forceinline__ void modreduce_phase(const float* modp, const float* bmod, const float* normg, const float* fng, float* mod, float* gs, float* rgs, int gtid, int NGT) {
    constexpr int NV = 5 * MODW / 4;
    for (int i2 = gtid; i2 < 2 * NV; i2 += NGT) { const int l = i2 / NV, i = i2 - l * NV, b = i / (MODW / 4), c4 = i - b * (MODW / 4), lb = l * 5 + b;
        f32x4 pv[D / 64];
#pragma unroll
        for (int ks = 0; ks < D / 64; ++ks) pv[ks] = *(const f32x4*)(modp + ((size_t)ks * 10 + lb) * MODW + 4 * c4);
        f32x4 s = *(const f32x4*)(bmod + (size_t)l * MODW + 4 * c4);
#pragma unroll
        for (int ks = 0; ks < D / 64; ++ks) s += pv[ks];
        *(f32x4*)(mod + (size_t)lb * MODW + 4 * c4) = s;
        if (l == 1 && c4 < D / 4) *(f32x4*)(gs + ((size_t)6 * 5 + b) * D + 4 * c4) = *(const f32x4*)(fng + 4 * c4);
        const int seg = (4 * c4) / D, col = 4 * c4 - seg * D;
        if (seg % 3 == 1) { const int j = seg / 3; const f32x4 gv = *(const f32x4*)(normg + (size_t)(l * 3 + j) * D + col) * (s + 1.0f); const size_t o = ((size_t)(l * 3 + j) * 5 + b) * D + col;
            *(f32x4*)(gs + o) = gv; *(f32x4*)(rgs + o) = (f32x4){gv[0] != 0.f ? 1.0f / gv[0] : 0.f, gv[1] != 0.f ? 1.0f / gv[1] : 0.f, gv[2] != 0.f ? 1.0f / gv[2] : 0.f, gv[3] != 0.f ? 1.0f / gv[3] : 0.f}; } }
}
__device__ __forceinline__ void rowstat_phase(const float* SS, float* rstd, bool ctx_ones, int gtid, int NGT) {
    for (int r = gtid; r < MX; r += NGT) { float t = 0.f;
#pragma unroll
        for (int q = 0; q < 8; ++q) { const f32x4 v = *(const f32x4*)(SS + (size_t)r * 32 + 4 * q); t += (v[0] + v[1]) + (v[2] + v[3]); }
        rstd[r] = 1.0f / sqrtf(t * (1.0f / D) + RMS_EPS); }
    if (ctx_ones) for (int r = MX + gtid; r < MT; r += NGT) rstd[r] = 1.0f;
}
__device__ __forceinline__ void panel_rstd(const pg8::StaticOrder& S, const float* SS, float* rstd, int tid) {
    pg8::Unit u; int last = -1;
    for (int i = 0; S.next(i, u); ++i) { if (u.pm == last) continue; last = u.pm;
        if (tid < 256) { const int r = u.pm * 256 + tid; float t = 0.f;
#pragma unroll
            for (int q = 0; q < 8; ++q) { const f32x4 v = *(const f32x4*)(SS + (size_t)r * 32 + 4 * q); t += (v[0] + v[1]) + (v[2] + v[3]); }
            rstd[r] = 1.0f / sqrtf(t * (1.0f / D) + RMS_EPS); } }
    asm volatile("s_waitcnt vmcnt(0)" ::: "memory"); __syncthreads();
}
__device__ __forceinline__ void biasreduce_phase(const float* biasp, float* bias, int gtid, int NGT) {
    constexpr int NV = NBCOL / 4;
    for (int i = gtid; i < 6 * NV; i += NGT) { const int b = i / NV, c4 = i - b * NV; f32x4 s = (f32x4){0.f, 0.f, 0.f, 0.f};
        if (b < 5) for (int kb = 0; kb < D / 64; ++kb) s += *(const f32x4*)(biasp + ((size_t)kb * 5 + b) * NBCOL + 4 * c4);
        *(f32x4*)(bias + (size_t)b * NBCOL + 4 * c4) = s; }
}

constexpr int SQ_OFF = 0, SK_OFF = 18432, SKW_OFF = 36864, SV_OFF = 54272, SCB_OFF = 65536, SP_OFF = 87296, STAB_OFF = 96512, SCH_OFF = 148736, SHS_OFF = 149824;
constexpr int QSTR = 272, QKSTR = 288, VSTR = 160, PSTR = 144, CBSZ = 21760, NTOK = 68 * 64;
static_assert(SCH_OFF + 4 * 68 * 4 <= SHS_OFF && SHS_OFF + 64 * 144 <= LDSCTL_OFF, "scan LDS");

#define VROW(r) ((r) * VSTR + ((r) >> 3) * 128)
#define SCAN_BAR() do { asm volatile("s_waitcnt lgkmcnt(0)" ::: "memory"); __builtin_amdgcn_s_barrier(); asm volatile("" ::: "memory"); } while (0)
__device__ __forceinline__ bf16x8 tr_frag(LAS unsigned char* p0, LAS unsigned char* p1) {
    const s16x4 a = __builtin_amdgcn_ds_read_tr16_b64_v4i16((LAS s16x4*)p0), b = __builtin_amdgcn_ds_read_tr16_b64_v4i16((LAS s16x4*)p1);
    return (bf16x8){a[0], a[1], a[2], a[3], b[0], b[1], b[2], b[3]};
}
__device__ __forceinline__ float fexp(float x) { return __builtin_amdgcn_exp2f(1.44269504f * x); }

template <int PROBE> __device__ __forceinline__ void scan_phase(LAS unsigned char* lds, const bf16* QKVO, const float* GATES, bf16* HF, bf16* HBW, int vcu, int G, int tid, int lane, int wave) {
    const int fr = lane & 15, fq = lane >> 4, tq = (lane & 15) >> 2, tp = lane & 3;
    LAS float* cjA = (LAS float*)(lds + STAB_OFF); LAS float* cmA = cjA + NTOK; LAS float* bsA = cmA + NTOK;
    LAS float* chM = (LAS float*)(lds + SCH_OFF); LAS float* chML = chM + 68; LAS float* chBE = chML + 68; LAS float* chMC = chBE + 68;
    for (int u = vcu; u < 256; u += G) {
        const int sl = u & 3, dir = (u >> 2) & 1, h = (u >> 3) & 7, b = u >> 6, e0 = 64 * sl;
        bf16* HO = dir ? HBW : HF;
        const int prow = tid >> 4, pch = tid & 15, vrow = tid >> 3, vch = tid & 7;
        auto row_of = [&](int st) { const bool isc = st < 4; const int ci = isc ? st : st - 4, n = isc ? 4 : 64, ch = dir ? (n - 1 - ci) : ci; return (isc ? MX + b * CTXL : b * SEQ) + ch * 64; };
        f32x4 Cacc[5];
#pragma unroll
        for (int e = 0; e < 5; ++e) Cacc[e] = (f32x4){0.f, 0.f, 0.f, 0.f};
        SCAN_BAR();
        {
            float gi[9], gf[9];
#pragma unroll
            for (int q = 0; q < 9; ++q) { const int st = wave + NWAVES * q; if (st < 68) { const float* gp = GATES + (size_t)(row_of(st) + lane) * 32 + (2 * dir) * 8 + h; gi[q] = gp[0]; gf[q] = gp[8]; } else { gi[q] = 0.f; gf[q] = 0.f; } }
#pragma unroll
            for (int q = 0; q < 9; ++q) { const int st = wave + NWAVES * q; if (st < 68) {
                const float ax = fabsf(gf[q]), ee = fexp(-ax), l1p = (ee < 1e-3f) ? ee * (1.0f - 0.5f * ee) : __logf(1.0f + ee);
                const float f = fminf(gf[q], 0.f) - l1p;
                float bs = f;
#pragma unroll
                for (int o = 1; o < 64; o <<= 1) { const float t = dir ? __shfl_down(bs, o) : __shfl_up(bs, o); const bool ok = dir ? (lane + o < 64) : (lane >= o); bs += ok ? t : 0.f; }
                const float cj = gi[q] - bs; float cm = cj;
#pragma unroll
                for (int o = 1; o < 64; o <<= 1) { const float t = dir ? __shfl_down(cm, o) : __shfl_up(cm, o); const bool ok = dir ? (lane + o < 64) : (lane >= o); cm = ok ? fmaxf(cm, t) : cm; }
                cjA[st * 64 + lane] = cj; cmA[st * 64 + lane] = cm; bsA[st * 64 + lane] = bs;
                if (lane == (dir ? 0 : 63)) { chBE[st] = bs; chMC[st] = cm; } } }
        }
        for (int i = tid; i < CBSZ / 16; i += 512) *(LAS v4u*)(lds + SCB_OFF + 16 * i) = (v4u){0u, 0u, 0u, 0u};
        if (tid < 128) { const int r = tid >> 1; *(LAS v4u*)(lds + SV_OFF + VROW(r) + (8 + (tid & 1)) * 16) = (tid & 1) ? (v4u){0u, 0u, 0u, 0u} : (v4u){0x3F80u, 0u, 0u, 0u}; }
        v4u rq[2][2], rk[2][2], rv[2];
        auto slot_of = [&](int st) { const bool isc = st < 4; const int ci = isc ? st : st - 4, n = isc ? 4 : 64, ch = dir ? (n - 1 - ci) : ci; return (isc ? CTX_SLOT0 + (b * 8 + h) * CTXL : (b * 8 + h) * SEQ) + ch * 64; };
        auto load_qk = [&](int st_, v4u (&q)[2], v4u (&k)[2]) { { const int st = st_ < 68 ? st_ : 67; const size_t e0q = (size_t)slot_of(st) * DKH;
#pragma unroll
            for (int i = 0; i < 2; ++i) { q[i] = *(const v4u*)(QKVO + QH_OFF + e0q + (size_t)(tid + 512 * i) * 8); k[i] = *(const v4u*)(QKVO + KH_OFF + e0q + (size_t)(tid + 512 * i) * 8); } } };
        auto load_v = [&](int st_, v4u& v) { const int st = st_ < 68 ? st_ : 67; v = __builtin_nontemporal_load((const v4u*)(QKVO + VH_OFF + ((size_t)slot_of(st) + vrow) * DVH + e0 + vch * 8)); };
        { v4u q0[2], k0[2];
          load_qk(0, q0, k0); load_qk(1, rq[1], rk[1]); load_qk(2, rq[0], rk[0]);
          load_v(0, rv[0]); load_v(1, rv[1]);
#pragma unroll
          for (int i = 0; i < 2; ++i) { *(LAS v4u*)(lds + SQ_OFF + (prow + 32 * i) * QKSTR + pch * 16) = q0[i]; *(LAS v4u*)(lds + SK_OFF + (prow + 32 * i) * QKSTR + pch * 16) = k0[i]; } }
        SCAN_BAR();
        if (wave == 0) {
            int ln = lane; asm volatile("" : "+v"(ln));
            const float mc0 = chMC[ln], be0 = chBE[ln], mc1 = chMC[64 + (ln & 3)], be1 = chBE[64 + (ln & 3)];
            float m = -1e30f;
#pragma unroll 1
            for (int st = 0; st < 64; ++st) {
                const float c = __builtin_bit_cast(float, __builtin_amdgcn_readlane(__builtin_bit_cast(int, mc0), st)), e = __builtin_bit_cast(float, __builtin_amdgcn_readlane(__builtin_bit_cast(int, be0), st));
                const float ML = fmaxf(m, c); if (ln == st) { chM[st] = m; chML[st] = ML; } m = e + ML; }
#pragma unroll 1
            for (int st = 0; st < 4; ++st) {
                const float c = __builtin_bit_cast(float, __builtin_amdgcn_readlane(__builtin_bit_cast(int, mc1), st)), e = __builtin_bit_cast(float, __builtin_amdgcn_readlane(__builtin_bit_cast(int, be1), st));
                const float ML = fmaxf(m, c); if (ln == st) { chM[64 + st] = m; chML[64 + st] = ML; } m = e + ML; } }
        SCAN_BAR();
        const int sb = wave & 3, hf = wave >> 2, s_pos = 16 * sb + fr, cbh = ((fr >> 2) ^ (fr >> 3)) & 1;
        auto step = [&](const int st, const bool isc, v4u (&RQ)[2], v4u (&RK)[2], v4u& RV) {
            const float m_t = chM[st], ML_t = chML[st];
            if (!isc) { const v4u hw = *(const LAS v4u*)(lds + SHS_OFF + (tid >> 3) * PSTR + (tid & 7) * 16); *(v4u*)(HO + (size_t)(row_of(st > 4 ? st - 1 : st) + (tid >> 3)) * D + h * DVH + e0 + (tid & 7) * 8) = hw; }
            bf16x8 Yq[4], Xk[2][4]; f32x4 c4[2]; float cms = 0.f;
            if (!isc) {
#pragma unroll
                for (int ks = 0; ks < 4; ++ks) Yq[ks] = *(const LAS bf16x8*)(lds + SQ_OFF + s_pos * QKSTR + (32 * ks + 8 * fq) * 2);
#pragma unroll
                for (int jj = 0; jj < 2; ++jj)
#pragma unroll
                    for (int ks = 0; ks < 4; ++ks) Xk[jj][ks] = *(const LAS bf16x8*)(lds + SK_OFF + (16 * (2 * hf + jj) + fr) * QKSTR + (32 * ks + 8 * fq) * 2);
#pragma unroll
                for (int jj = 0; jj < 2; ++jj) c4[jj] = *(const LAS f32x4*)(cjA + st * 64 + 16 * (2 * hf + jj) + 4 * fq);
                cms = cmA[st * 64 + s_pos];
            }
            __builtin_amdgcn_sched_barrier(0);
            auto kwblock = [&]() {
                v4u kraw[2]; float cjw[2];
#pragma unroll
                for (int i = 0; i < 2; ++i) { const int r = prow + 32 * i; kraw[i] = *(const LAS v4u*)(lds + SK_OFF + r * QKSTR + pch * 16); cjw[i] = cjA[st * 64 + r]; }
#pragma unroll
                for (int i = 0; i < 2; ++i) { const int r = prow + 32 * i; const float wj = fexp(cjw[i] - ML_t);
                    float kf[8]; unpack8(kraw[i], kf); v4u kw; kw.x = pk2(kf[0] * wj, kf[1] * wj); kw.y = pk2(kf[2] * wj, kf[3] * wj); kw.z = pk2(kf[4] * wj, kf[5] * wj); kw.w = pk2(kf[6] * wj, kf[7] * wj);
                    *(LAS v4u*)(lds + SKW_OFF + r * QSTR + pch * 16) = kw; }
                };
            *(LAS v4u*)(lds + SV_OFF + VROW(vrow) + vch * 16) = RV;
            load_v(st + 2, RV);
            if (isc || hf == 0) { kwblock(); __builtin_amdgcn_sched_barrier(0); }
            f32x4 a2[3]; float Ms = 0.f;
            if (!isc) {
                Ms = fmaxf(m_t, cms);
                f32x4 sacc[2];
#pragma unroll
                for (int jj = 0; jj < 2; ++jj) { sacc[jj] = (f32x4){0.f, 0.f, 0.f, 0.f};
#pragma unroll
                    for (int ks = 0; ks < 4; ++ks) sacc[jj] = __builtin_amdgcn_mfma_f32_16x16x32_bf16(Xk[jj][ks], Yq[ks], sacc[jj], 0, 0, 0); }
                __builtin_amdgcn_sched_barrier(0);
                auto pmath = [&]() {
#pragma unroll
                    for (int jj = 0; jj < 2; ++jj) { const int jb = 2 * hf + jj; float p[4];
#pragma unroll
                        for (int r = 0; r < 4; ++r) { const int j_pos = 16 * jb + 4 * fq + r; const bool ok = dir ? (j_pos >= s_pos) : (j_pos <= s_pos); p[r] = sacc[jj][r] * fexp(ok ? (c4[jj][r] - Ms) : -1e30f); }
                        v2u pw; pw.x = pk2(p[0], p[1]); pw.y = pk2(p[2], p[3]);
                        *(LAS v2u*)(lds + SP_OFF + s_pos * PSTR + (16 * jb + 4 * fq) * 2) = pw; } };
                auto qcmma = [&]() {
                    bf16x8 Xc[3][4];
#pragma unroll
                    for (int ti = 0; ti < 3; ++ti) { const int e = (ti == 2) ? 4 : 2 * hf + ti;
#pragma unroll
                        for (int ks = 0; ks < 4; ++ks) Xc[ti][ks] = *(const LAS bf16x8*)(lds + SCB_OFF + (16 * e + fr) * QSTR + 64 * ks + ((fq ^ cbh) * 16)); }
                    __builtin_amdgcn_sched_barrier(0);
#pragma unroll
                    for (int ti = 0; ti < 3; ++ti) { a2[ti] = (f32x4){0.f, 0.f, 0.f, 0.f};
#pragma unroll
                        for (int ks = 0; ks < 4; ++ks) a2[ti] = __builtin_amdgcn_mfma_f32_16x16x32_bf16(Xc[ti][ks], Yq[ks], a2[ti], 0, 0, 0); } };
                if (hf == 0) { pmath(); qcmma(); } else { qcmma(); __builtin_amdgcn_sched_barrier(0); pmath(); kwblock(); }
            }
            SCAN_BAR();
            {
                const float decay = fexp(m_t - ML_t);
                bf16x8 Xkw[2], Yp[2], Yv[5][2]; float bss = 0.f;
#pragma unroll
                for (int ks = 0; ks < 2; ++ks) { LAS unsigned char* p = lds + SKW_OFF + (32 * ks + 8 * fq + tq) * QSTR + (16 * wave + 4 * tp) * 2; Xkw[ks] = tr_frag(p, p + 4 * QSTR); }
#pragma unroll
                for (int e = 0; e < 5; ++e)
#pragma unroll
                    for (int ks = 0; ks < 2; ++ks) { LAS unsigned char* p = lds + SV_OFF + VROW(32 * ks + 8 * fq + tq) + (16 * e + 4 * tp) * 2; Yv[e][ks] = tr_frag(p, p + 4 * VSTR); }
                if (!isc) {
#pragma unroll
                    for (int ks = 0; ks < 2; ++ks) Yp[ks] = *(const LAS bf16x8*)(lds + SP_OFF + s_pos * PSTR + (32 * ks + 8 * fq) * 2);
                    bss = bsA[st * 64 + s_pos];
                }
                __builtin_amdgcn_sched_barrier(0);
                f32x4 o[3];
#pragma unroll
                for (int e = 0; e < 5; ++e) {
                    if (!isc && (e == 4 || hf == (e >> 1))) { const int ti = (e == 4) ? 2 : (e & 1); f32x4 a1 = (f32x4){0.f, 0.f, 0.f, 0.f};
#pragma unroll
                        for (int ks = 0; ks < 2; ++ks) a1 = __builtin_amdgcn_mfma_f32_16x16x32_bf16(Yv[e][ks], Yp[ks], a1, 0, 0, 0);
                        o[ti] = a1; }
                    Cacc[e] = Cacc[e] * decay;
#pragma unroll
                    for (int ks = 0; ks < 2; ++ks) Cacc[e] = __builtin_amdgcn_mfma_f32_16x16x32_bf16(Xkw[ks], Yv[e][ks], Cacc[e], 0, 0, 0); }
#pragma unroll
                for (int e = 0; e < 5; ++e) { v2u cw; cw.x = pk2(Cacc[e][0], Cacc[e][1]); cw.y = pk2(Cacc[e][2], Cacc[e][3]);
                    *(LAS v2u*)(lds + SCB_OFF + (16 * e + fr) * QSTR + (((2 * wave + (fq >> 1)) ^ cbh) * 16) + (fq & 1) * 8) = cw; }
#pragma unroll
                for (int i = 0; i < 2; ++i) { *(LAS v4u*)(lds + SQ_OFF + (prow + 32 * i) * QKSTR + pch * 16) = RQ[i]; *(LAS v4u*)(lds + SK_OFF + (prow + 32 * i) * QKSTR + pch * 16) = RK[i]; }
                load_qk(st + 3, RQ, RK);
                if (!isc) {
                    const float wint = fexp(m_t - Ms), hden = fexp(-(bss + Ms));
#pragma unroll
                    for (int ti = 0; ti < 3; ++ti) o[ti] = o[ti] + a2[ti] * wint;
                    const float den = __shfl(o[2][0], fr);
                    const float inv = 1.0f / fmaxf(fabsf(den), hden);
#pragma unroll
                    for (int ti = 0; ti < 2; ++ti) { const int e = 2 * hf + ti; const f32x4 hv = o[ti] * inv; v2u w; w.x = pk2(hv[0], hv[1]); w.y = pk2(hv[2], hv[3]);
                        *(LAS v2u*)(lds + SHS_OFF + s_pos * PSTR + (16 * e + 4 * fq) * 2) = w; }
                }
            }
            SCAN_BAR();
        };
        step(0, true, rq[1], rk[1], rv[0]); step(1, true, rq[0], rk[0], rv[1]); step(2, true, rq[1], rk[1], rv[0]); step(3, true, rq[0], rk[0], rv[1]);
        for (int g = 1; g < 17; ++g) { const int st = 4 * g;
            step(st, false, rq[1], rk[1], rv[0]); step(st + 1, false, rq[0], rk[0], rv[1]); step(st + 2, false, rq[1], rk[1], rv[0]); step(st + 3, false, rq[0], rk[0], rv[1]); }
        { const v4u hw = *(const LAS v4u*)(lds + SHS_OFF + (tid >> 3) * PSTR + (tid & 7) * 16); *(v4u*)(HO + (size_t)(row_of(67) + (tid >> 3)) * D + h * DVH + e0 + (tid & 7) * 8) = hw; }
    }
}

constexpr int NPHASES = 24;
__global__ void __launch_bounds__(NWAVES * 64, 2) fwd_kernel(KArgs a) {
    extern __shared__ __attribute__((aligned(16))) unsigned char lds_raw[];
    LAS unsigned char* lds = (LAS unsigned char*)lds_raw;
    const int tid = threadIdx.x, lane = tid & 63, wave = __builtin_amdgcn_readfirstlane(tid >> 6);
    const int G = gridDim.x, bx = blockIdx.x, vcu = (G % 8 == 0) ? (bx % 8) * (G / 8) + bx / 8 : bx;
    const int gw = vcu * NWAVES + wave, NGW = G * NWAVES;
    unsigned char* ws = a.ws;
    unsigned* ctl = (unsigned*)(ws + WS_CTL);
    volatile LAS unsigned* MISC = (volatile LAS unsigned*)(lds + LDSCTL_OFF);
    for (int u = tid; u < (LDS_BYTES - LDSCTL_OFF) / 4; u += NWAVES * 64) ((LAS unsigned*)(lds + LDSCTL_OFF))[u] = 0u;
    __syncthreads();
    XcdBarrier bar; bar.bar = ctl + CW_BAR; bar.x = 0; bar.st = nullptr;
#if !MK_PER_PHASE
    bar = xcd_barrier_post(ctl + CW_BAR, MISC + 8);
#endif
    const int lo = a.ph_lo, hi = a.ph_hi;
#define IN(k) (lo <= (k) && (k) < hi)
#if MK_PER_PHASE
#define SEAM(k) do { } while (0)
#else
#define SEAM(k) do { if (IN(k) && IN((k) + 1)) xcd_barrier(bar); } while (0)
#endif
#define x_in (a.in[0])
#define ctx_in (a.in[2])
#define X ((float*)(ws + WS_X))
#define HB ((bf16*)(ws + WS_HB))
#define ACT ((bf16*)(ws + WS_ACT))
#define QKVO ((bf16*)(ws + WS_QKVO))
#define GATES ((float*)(ws + WS_GATES))
#define HF ((bf16*)(ws + WS_HF))
#define HBW ((bf16*)(ws + WS_HBW))
#define mod ((const float*)(ws + WS_MOD))
#define WFI ((const bf16*)(ws + WS_WFI))
#define WFO ((const bf16*)(ws + WS_WFO))
#define normg (a.in[6])
#define GS ((float*)(ws + WS_GS))
#define SS ((float*)(ws + WS_SS))
#define RSTD ((float*)(ws + WS_RSTD))
#define BIAS ((float*)(ws + WS_BIAS))
#define YB ((bf16*)(ws + WS_ACT))
#define BG ((bf16*)(ws + WS_QKVO))
#define ZB ((bf16*)(ws + WS_QKVO) + (size_t)MX * D)
    const int gtid = bx * NWAVES * 64 + tid, NGT = G * NWAVES * 64;
    if (IN(0)) { mod_partials(a, 0, gw, NGW, lane); mod_partials(a, 1, gw, NGW, lane); convert_list<0>(a, lds, gw, NGW, wave, lane); }
    SEAM(0);
    if (IN(1)) modreduce_phase((const float*)(ws + WS_MODP), a.in[5], normg, a.in[16], (float*)(ws + WS_MOD), GS, (float*)(ws + WS_RGS), gtid, NGT);
    SEAM(1);
#define FFN_UP(p, wi, rows, FOLDV, boff) do { if (IN(p)) { pg8::Gemm g{HB, WFI + (size_t)(wi) * NFI * D, rows, NFI, D}; pg8::StaticOrder S; S.init(rows, NFI, G, bx, D); if (FOLDV) panel_rstd(S, SS, RSTD, tid); \
        pg8::EpiSwigluT<FOLDV> E{ACT, DFF, pg8::Fold{ws, (boff)}}; pg8::gemm_phase<pg8::EpiSwigluT<FOLDV>, pg8::StaticOrder, true, true, true>(lds, g, S, E); } SEAM(p); } while (0)
#define FFN_DOWN(p, wi, l, j, SRCV, NEXTV, nsub) do { if (IN(p)) { pg8::Gemm g{ACT, WFO + (size_t)(wi) * D * DFF, MX, D, DFF}; pg8::StaticOrder S; S.init(MX, D, G, bx, DFF, 4); \
        pg8::EpiResidT<SRCV, NEXTV, true> E{x_in, ctx_in, ws, (l) * 5 * MODW + (3 * (j) + 2) * D, (l) * 3 + (j), (nsub)}; \
        pg8::gemm_phase<pg8::EpiResidT<SRCV, NEXTV, true>, pg8::StaticOrder, true, true, true>(lds, g, S, E); } } while (0)

    if (IN(2)) { normmod_phase(x_in, ctx_in, MT, normg + (0 * 3 + 0) * D, mod, 0, HB, gw, NGW, lane);
        convert_list<1>(a, lds, gw, NGW, wave, lane); convert_list<2>(a, lds, gw, NGW, wave, lane); }
    SEAM(2);
    if (IN(3)) { pg8::Gemm g{HB, WFI, MT, NFI, D}; pg8::StaticOrder S; S.init(MT, NFI, G, bx, D);
        pg8::EpiSwigluT<false> E{ACT, DFF, pg8::Fold{ws, 0}}; pg8::gemm_phase<pg8::EpiSwigluT<false>, pg8::StaticOrder, true, true, true>(lds, g, S, E);
        { int rank, cnt; if (tail_rank((MT / 256) * (NFI / 256), G, bx, rank, cnt)) biasreduce_phase((const float*)(ws + WS_BIASP), BIAS, rank * NWAVES * 64 + tid, cnt * NWAVES * 64); } }
    SEAM(3);
    if (IN(4)) { FFN_DOWN(4, 0, 0, 0, true, true, 1);
        { pg8::Gemm g{ACT, WFO, MT, D, DFF}; pg8::SplitKOrder S{G, bx, MX / 256};
          pg8::EpiPartial E{(float*)(ws + WS_CTXP), MX, (size_t)MC * D};
          pg8::gemm_phase<pg8::EpiPartial, pg8::SplitKOrder, true, true, true>(lds, g, S, E); } }
    SEAM(4);
    if (IN(5)) { rowstat_phase(SS, RSTD, true, gtid, NGT);
        normmod_phase(X, ctx_in, MT, normg + (0 * 3 + 1) * D, mod, 1, HB, gw, NGW, lane, (const float*)(ws + WS_CTXP), mod + (size_t)4 * MODW + (3 * 0 + 2) * D, MX); }
    SEAM(5);
    if (IN(6)) { pg8::Gemm g{HB, (const bf16*)(ws + WS_WMI), MT, NML, D}; pg8::StaticOrder S; S.init(MT, NML, G, bx, D); pg8::EpiMlstmInT<true> E{QKVO, GATES, a.in[10], pg8::Fold{ws, BOFF_MI}};
        pg8::gemm_phase<pg8::EpiMlstmInT<true>, pg8::StaticOrder, true, true, true>(lds, g, S, E); }
    SEAM(6);
    if (PROBE_DUP == 6) { pg8::Gemm g{HB, (const bf16*)(ws + WS_WMI), MT, NML, D}; pg8::StaticOrder S; S.init(MT, NML, G, bx, D); pg8::EpiMlstmInT<true> E{QKVO, GATES, a.in[10], pg8::Fold{ws, BOFF_MI}};
        pg8::gemm_phase<pg8::EpiMlstmInT<true>, pg8::StaticOrder, true, true, true>(lds, g, S, E); xcd_barrier(bar); }
    if (IN(7)) scan_phase<0>(lds, QKVO, GATES, HF, HBW, vcu, G, tid, lane, wave);
    SEAM(7);
    if (IN(8)) headnorm_phase(HF, HBW, QKVO, a.in[11], YB, gw, NGW, lane);
    SEAM(8);
    if (PROBE_DUP == 8) { headnorm_phase(HF, HBW, QKVO, a.in[11], YB, gw, NGW, lane); xcd_barrier(bar); }
    if (IN(9)) { pg8::Gemm g{YB, (const bf16*)(ws + WS_WMO), MX, D, D}; pg8::StaticOrder S; S.init(MX, D, G, bx, D, 4);
        pg8::EpiResidT<false, true, false> E{x_in, ctx_in, ws, (3 * 1 + 2) * D, 1, 2};
        pg8::gemm_phase<pg8::EpiResidT<false, true, false>, pg8::StaticOrder, true, true, true>(lds, g, S, E); }
    SEAM(9);
    FFN_UP(11, 1, MX, true, BOFF_F1);
    FFN_DOWN(12, 1, 0, 2, false, true, 3); SEAM(12);
    if (PROBE_DUP == 12) { pg8::Gemm g{ACT, WFO + (size_t)1 * D * DFF, MX, D, DFF}; pg8::StaticOrder S; S.init(MX, D, G, bx, DFF); pg8::EpiPartial E{(float*)(ws + WS_QKVO), 0, (size_t)0};
        pg8::gemm_phase<pg8::EpiPartial, pg8::StaticOrder, true, true, true>(lds, g, S, E); xcd_barrier(bar); }
    FFN_UP(14, 2, MX, true, BOFF_F2);
    FFN_DOWN(15, 2, 1, 0, false, true, 4); SEAM(15);
    if (IN(17)) { pg8::Gemm g{HB, (const bf16*)(ws + WS_WCI), MX, NCV, D}; pg8::StaticOrder S; S.init(MX, NCV, G, bx, D); panel_rstd(S, SS, RSTD, tid); pg8::EpiConvInT<true> E{BG, ZB, pg8::Fold{ws, BOFF_CI}};
        pg8::gemm_phase<pg8::EpiConvInT<true>, pg8::StaticOrder, true, true, true>(lds, g, S, E); }
    SEAM(17);
    if (IN(18)) convmix_phase(BG, ZB, a.in[14], YB, gw, NGW, lane);
    SEAM(18);
    if (IN(19)) { pg8::Gemm g{YB, (const bf16*)(ws + WS_WCO), MX, D, D}; pg8::StaticOrder S; S.init(MX, D, G, bx, D, 4);
        pg8::EpiResidT<false, true, false> E{x_in, ctx_in, ws, 5 * MODW + (3 * 1 + 2) * D, 4, 5};
        pg8::gemm_phase<pg8::EpiResidT<false, true, false>, pg8::StaticOrder, true, true, true>(lds, g, S, E); }
    SEAM(19);
    FFN_UP(21, 3, MX, true, BOFF_F3);
    FFN_DOWN(22, 3, 1, 2, false, true, 6); SEAM(22);
    if (IN(23)) final_norm_phase(HB, SS, a.out, gw, NGW, lane);
#undef FFN_UP
#undef FFN_DOWN
#undef x_in
#undef ctx_in
#undef X
#undef HB
#undef ACT
#undef QKVO
#undef GATES
#undef HF
#undef HBW
#undef mod
#undef WFI
#undef WFO
#undef normg
#undef GS
#undef SS
#undef RSTD
#undef BIAS
#undef YB
#undef BG
#undef ZB
#undef IN
#undef SEAM
}

extern "C" void kernel_launch(void* const* d_in, const int* in_sizes, int n_in, void* d_out, int out_size, void* d_ws, size_t ws_size, hipStream_t stream) {
    static int grid = 0;
    if (grid == 0) {
        if (n_in != 17 || in_sizes[0] != MX * D || out_size != MX * D || ws_size < WS_END) { fprintf(stderr, "kernel_launch: unexpected shapes (n_in %d, in0 %d, out %d, ws %zu)\n", n_in, n_in > 0 ? in_sizes[0] : -1, out_size, ws_size); grid = -1; return; }
        int dev = 0, cus = 0, per_cu = 0;
        if (hipGetDevice(&dev) != hipSuccess || hipDeviceGetAttribute(&cus, hipDeviceAttributeMultiprocessorCount, dev) != hipSuccess) { fprintf(stderr, "kernel_launch: device query failed\n"); grid = -1; return; }
        if (hipFuncSetAttribute((const void*)fwd_kernel, hipFuncAttributeMaxDynamicSharedMemorySize, LDS_BYTES) != hipSuccess) { fprintf(stderr, "kernel_launch: hipFuncSetAttribute failed\n"); grid = -1; return; }
        if (hipOccupancyMaxActiveBlocksPerMultiprocessor(&per_cu, (const void*)fwd_kernel, NWAVES * 64, LDS_BYTES) != hipSuccess || per_cu < 1) { fprintf(stderr, "kernel_launch: occupancy query reports %d workgroups per CU\n", per_cu); }
        (void)hipGetLastError();
        grid = cus;
    }
    if (grid < 0) return;
    if (hipMemsetAsync((char*)d_ws + WS_CTL, 0, CTL_ZERO_BYTES, stream) != hipSuccess) { fprintf(stderr, "kernel_launch: memset failed\n"); return; }
    KArgs a{};
    for (int i = 0; i < 17; ++i) a.in[i] = (const float*)d_in[i];
    a.out = (float*)d_out; a.ws = (unsigned char*)d_ws;
#if MK_PER_PHASE
    for (int p = 0; p < NPHASES; ++p) { a.ph_lo = p; a.ph_hi = p + 1; hipLaunchKernelGGL(fwd_kernel, dim3(grid), dim3(NWAVES * 64), LDS_BYTES, stream, a); }
#else
    a.ph_lo = 0; a.ph_hi = NPHASES;
    hipLaunchKernelGGL(fwd_kernel, dim3(grid), dim3(NWAVES * 64), LDS_BYTES, stream, a);
#endif
    const hipError_t le = hipPeekAtLastError();
    if (le != hipSuccess) fprintf(stderr, "kernel_launch: launch failed: %s\n", hipGetErrorName(le));
}
```
